# Optimizing an MI355X kernel written in HIP

```python
import math
import jax
import jax.numpy as jnp
from jax import lax
import numpy as np

D_MODEL = 2048
BATCH = 4
SEQ = 8192
DEPTH = 1

A_HEADS = 4
A_QK_DIM = 256
A_V_DIM = 512
A_CONV = 4
CHUNK = 128
B_HEADS = 8
B_HEAD_DIM = 128
Q_BLOCK = 128
D_FF = 5632
FFN_CONV = 3
EPS = 1e-6

A_QK = A_HEADS * A_QK_DIM
A_V = A_HEADS * A_V_DIM
B_QK = B_HEADS * 2 * B_HEAD_DIM
B_V = B_HEADS * 2 * B_HEAD_DIM
SPLIT_SIZES = (2 * A_QK, A_V, A_V, 2 * A_HEADS, B_QK, B_QK, B_V, D_MODEL, D_MODEL)
P_IN = sum(SPLIT_SIZES)

kernel_name = 'hybrid_mlstm_diffattn_convffn'


def rmsnorm(x, g):
    xf = x.astype(jnp.float32)
    y = xf * lax.rsqrt(jnp.mean(xf * xf, axis=-1, keepdims=True) + EPS)
    return (y * g.astype(jnp.float32)).astype(x.dtype)


def causal_dwconv(x, w, b):
    k_w = w.shape[0]
    s = x.shape[1]
    xp = jnp.pad(x, ((0, 0), (k_w - 1, 0), (0, 0)))
    y = b + xp[:, 0:s, :] * w[0]
    for j in range(1, k_w):
        y = y + xp[:, j:j + s, :] * w[j]
    return y


def alibi_slopes(n):
    return jnp.asarray(2.0 ** (-8.0 * np.arange(1, n + 1) / n), dtype=jnp.float32)


def mlstm_chunkwise(q, k, v, i_pre, f_pre):
    bsz, nh, s, dk = q.shape
    dv = v.shape[-1]
    nc = s // CHUNK

    def to_chunks(a):
        a = a.reshape((bsz, nh, nc, CHUNK) + a.shape[3:])
        return jnp.moveaxis(a, 2, 0)

    logf = jax.nn.log_sigmoid(f_pre)
    logi = i_pre
    tril = jnp.tril(jnp.ones((CHUNK, CHUNK), dtype=bool))

    def step(carry, inp):
        c_st, n_st, m_st = carry
        qc, kc, vc, li, lf = inp
        b = jnp.cumsum(lf, axis=-1)
        dmat = jnp.where(tril, b[..., :, None] - b[..., None, :] + li[..., None, :], -jnp.inf)
        inter = b + m_st[..., None]
        m_t = jnp.maximum(jnp.max(dmat, axis=-1), inter)
        w_in = jnp.exp(dmat - m_t[..., None])
        g_inter = jnp.exp(inter - m_t)
        p = jnp.einsum('bhtd,bhsd->bhts', qc, kc) * w_in
        num = jnp.einsum('bhts,bhsv->bhtv', p, vc) + g_inter[..., None] * jnp.einsum('bhtd,bhdv->bhtv', qc, c_st)
        den = jnp.sum(p, axis=-1) + g_inter * jnp.einsum('bhtd,bhd->bht', qc, n_st)
        h = num / jnp.maximum(jnp.abs(den), jnp.exp(-m_t))[..., None]
        b_last = b[..., -1]
        ws = b_last[..., None] - b + li
        m_new = jnp.maximum(b_last + m_st, jnp.max(ws, axis=-1))
        decay = jnp.exp(b_last + m_st - m_new)
        ws = jnp.exp(ws - m_new[..., None])
        c_new = decay[..., None, None] * c_st + jnp.einsum('bhs,bhsd,bhsv->bhdv', ws, kc, vc)
        n_new = decay[..., None] * n_st + jnp.einsum('bhs,bhsd->bhd', ws, kc)
        return (c_new, n_new, m_new), h

    init = (jnp.zeros((bsz, nh, dk, dv), jnp.float32),
            jnp.zeros((bsz, nh, dk), jnp.float32),
            jnp.zeros((bsz, nh), jnp.float32))
    _, h = lax.scan(step, init, (to_chunks(q), to_chunks(k), to_chunks(v), to_chunks(logi), to_chunks(logf)))
    h = jnp.moveaxis(h, 0, 2)
    return h.reshape(bsz, nh, s, dv)


def diff_attention(q, k, v, lam, lam_init, subln_g):
    bsz, nh, s = q.shape[:3]
    nb = s // Q_BLOCK
    slopes = alibi_slopes(nh)[:, None, None, None]
    pos = jnp.arange(s)
    scale = B_HEAD_DIM ** -0.5
    qb = jnp.moveaxis(q.reshape(bsz, nh, nb, Q_BLOCK, 2, B_HEAD_DIM), 2, 0)

    def block(args):
        qblk, i = args
        t = i * Q_BLOCK + jnp.arange(Q_BLOCK)
        dist = t[:, None] - pos[None, :]
        logits = jnp.einsum('bhqcd,bhkcd->bhcqk', qblk, k) * scale - slopes * dist.astype(jnp.float32)
        logits = jnp.where(dist >= 0, logits, -jnp.inf)
        p = jax.nn.softmax(logits, axis=-1)
        a = p[:, :, 0] - lam * p[:, :, 1]
        return jnp.einsum('bhqk,bhkv->bhqv', a, v)

    o = lax.map(block, (qb, jnp.arange(nb)))
    o = rmsnorm(o, subln_g) * (1.0 - lam_init)
    o = jnp.transpose(o, (1, 0, 3, 2, 4))
    return o.reshape(bsz, s, nh * 2 * B_HEAD_DIM)


def setup_inputs(seed: int = 0) -> dict:
    key = jax.random.key(seed)
    ks = jax.random.split(key, 20)
    f32 = jnp.float32
    nrm = lambda kk, shape: jax.random.normal(kk, shape, dtype=f32)
    x = nrm(ks[0], (BATCH, SEQ, D_MODEL))
    norm1_g = 1.0 + 0.02 * nrm(ks[1], (DEPTH, D_MODEL))
    w_in = nrm(ks[2], (DEPTH, D_MODEL, P_IN)) * D_MODEL ** -0.5
    i_bias = 0.1 * nrm(ks[3], (DEPTH, A_HEADS))
    f_bias = jnp.linspace(3.0, 6.0, A_HEADS, dtype=f32)[None, :] + 0.1 * nrm(ks[4], (DEPTH, A_HEADS))
    if_bias = jnp.concatenate([i_bias, f_bias], axis=-1)
    qk_conv_w = nrm(ks[5], (DEPTH, A_CONV, 2 * A_QK)) * A_CONV ** -0.5
    qk_conv_b = 0.02 * nrm(ks[6], (DEPTH, 2 * A_QK))
    mlstm_norm_g = 1.0 + 0.02 * nrm(ks[7], (DEPTH, A_V))
    q_norm_g = 1.0 + 0.02 * nrm(ks[8], (DEPTH, B_HEAD_DIM))
    k_norm_g = 1.0 + 0.02 * nrm(ks[9], (DEPTH, B_HEAD_DIM))
    diff_lambda = 0.1 * nrm(ks[10], (DEPTH, 4, B_HEAD_DIM))
    subln_g = 1.0 + 0.02 * nrm(ks[11], (DEPTH, 2 * B_HEAD_DIM))
    w_out = nrm(ks[12], (DEPTH, D_MODEL, D_MODEL)) * D_MODEL ** -0.5
    norm2_g = 1.0 + 0.02 * nrm(ks[13], (DEPTH, D_MODEL))
    w_up = nrm(ks[14], (DEPTH, D_MODEL, 2 * D_FF)) * D_MODEL ** -0.5
    ffn_conv_w = nrm(ks[15], (DEPTH, FFN_CONV, 2 * D_FF)) * FFN_CONV ** -0.5
    ffn_conv_b = 0.02 * nrm(ks[16], (DEPTH, 2 * D_FF))
    w_down = nrm(ks[17], (DEPTH, D_FF, D_MODEL)) * D_FF ** -0.5
    return {'x': x, 'norm1_g': norm1_g, 'w_in': w_in, 'if_bias': if_bias,
            'qk_conv_w': qk_conv_w, 'qk_conv_b': qk_conv_b, 'mlstm_norm_g': mlstm_norm_g,
            'q_norm_g': q_norm_g, 'k_norm_g': k_norm_g, 'diff_lambda': diff_lambda,
            'subln_g': subln_g, 'w_out': w_out, 'norm2_g': norm2_g, 'w_up': w_up,
            'ffn_conv_w': ffn_conv_w, 'ffn_conv_b': ffn_conv_b, 'w_down': w_down}


def reference(x, norm1_g, w_in, if_bias, qk_conv_w, qk_conv_b, mlstm_norm_g, q_norm_g, k_norm_g,
              diff_lambda, subln_g, w_out, norm2_g, w_up, ffn_conv_w, ffn_conv_b, w_down):
    f32 = jnp.float32
    bsz, s, _ = x.shape
    split_idx = np.cumsum(SPLIT_SIZES)[:-1].tolist()
    for l in range(DEPTH):
        h = rmsnorm(x, norm1_g[l])
        proj = h @ w_in[l]
        a_qk, a_v, a_o, a_if, b_q, b_k, b_v, g_a, g_b = jnp.split(proj, split_idx, axis=-1)

        qk = jax.nn.silu(causal_dwconv(a_qk, qk_conv_w[l], qk_conv_b[l]))
        a_q, a_k = jnp.split(qk, 2, axis=-1)
        q_m = a_q.reshape(bsz, s, A_HEADS, A_QK_DIM).transpose(0, 2, 1, 3).astype(f32) * (A_QK_DIM ** -0.5)
        k_m = a_k.reshape(bsz, s, A_HEADS, A_QK_DIM).transpose(0, 2, 1, 3).astype(f32)
        v_m = a_v.reshape(bsz, s, A_HEADS, A_V_DIM).transpose(0, 2, 1, 3).astype(f32)
        gates = (a_if + if_bias[l]).astype(f32).reshape(bsz, s, 2, A_HEADS)
        i_pre = gates[:, :, 0].transpose(0, 2, 1)
        f_pre = gates[:, :, 1].transpose(0, 2, 1)
        h_m = mlstm_chunkwise(q_m, k_m, v_m, i_pre, f_pre)
        h_m = rmsnorm(h_m, mlstm_norm_g[l].reshape(A_HEADS, 1, A_V_DIM))
        h_m = h_m.transpose(0, 2, 1, 3).reshape(bsz, s, A_V)
        y_a = jax.nn.sigmoid(a_o) * h_m.astype(x.dtype)

        q_d = rmsnorm(b_q.reshape(bsz, s, B_HEADS, 2, B_HEAD_DIM).astype(f32), q_norm_g[l]).transpose(0, 2, 1, 3, 4)
        k_d = rmsnorm(b_k.reshape(bsz, s, B_HEADS, 2, B_HEAD_DIM).astype(f32), k_norm_g[l]).transpose(0, 2, 1, 3, 4)
        v_d = b_v.reshape(bsz, s, B_HEADS, 2 * B_HEAD_DIM).transpose(0, 2, 1, 3).astype(f32)
        lam_init = 0.8 - 0.6 * math.exp(-0.3 * l)
        lp = diff_lambda[l].astype(f32)
        lam = jnp.exp(jnp.sum(lp[0] * lp[1])) - jnp.exp(jnp.sum(lp[2] * lp[3])) + lam_init
        y_b = diff_attention(q_d, k_d, v_d, lam, lam_init, subln_g[l]).astype(x.dtype)

        y = jax.nn.sigmoid(g_a) * y_a + jax.nn.sigmoid(g_b) * y_b
        x = x + y @ w_out[l]

        h = rmsnorm(x, norm2_g[l])
        u = causal_dwconv(h @ w_up[l], ffn_conv_w[l], ffn_conv_b[l])
        u_g, u_v = jnp.split(u, 2, axis=-1)
        x = x + (jax.nn.silu(u_g) * u_v) @ w_down[l]
    return x
```

```cpp
#include <hip/hip_runtime.h>
#include <hip/hip_cooperative_groups.h>
#include <cstdio>
#include <cstdint>
namespace cg = cooperative_groups;
namespace pg8 {
#define PG8_LAS __attribute__((address_space(3)))
typedef unsigned short bf16_t;
typedef short bf16x8 __attribute__((ext_vector_type(8)));
typedef float f32x4 __attribute__((ext_vector_type(4)));
typedef unsigned u32x4 __attribute__((ext_vector_type(4)));
constexpr int BM = 256, BK = 64, HALF = 128, HTB = HALF * BK * 2  , STAGE_BYTES = 8 * HTB, NXCD = 8, WGM = 8;

__host__ __device__ __forceinline__ int lds_byte(int r, int c) { const int st = (r >> 4) * 2 + (c >> 5), rr = r & 15, cc = c & 31, ob = rr * 64 + cc * 2; return st * 1024 + (ob ^ (((ob >> 9) & 1) << 5)); }
__host__ __device__ __forceinline__ void stage_rc(int b, int& R, int& C) { const int st = b / 1024, sb = b % 1024, swz = sb ^ (((sb >> 9) & 1) << 5); R = (st >> 1) * 16 + swz / 64; C = (st & 1) * 32 + (swz % 64) / 2; }
__host__ __device__ __forceinline__ int perm32(int rho) { const int n = rho >> 4, i = rho & 15; return 8 * (i >> 2) + 4 * n + (i & 3); }

struct Unit { int pm, pn; };
struct Gemm { const bf16_t* A; const bf16_t* Bt; int M, N, K; };

struct StaticOrder {
    int nM, nN, nwg, G, c;
    __host__ __device__ void init(int M, int N, int G_, int c_) { nM = M / BM; nN = N / BM; nwg = nM * nN; G = G_; c = c_; }
    __host__ __device__ bool next(int i, Unit& u) const {
        const long L = (long)i * G + c; if (L >= nwg) return false;
        int wgid = (int)L; { const int q = nwg / NXCD, r = nwg % NXCD, xcd = wgid % NXCD, off = wgid / NXCD; wgid = (xcd < r ? xcd * (q + 1) : r * (q + 1) + (xcd - r) * q) + off; }
        const int nig = WGM * nN, gid = wgid / nig, fm = gid * WGM, gsz = (nM - fm) < WGM ? (nM - fm) : WGM;
        u.pm = fm + ((wgid % nig) % gsz); u.pn = (wgid % nig) / gsz; return true;
    }
    __device__ __forceinline__ void a_ready(const Unit&) const {}
    __device__ __forceinline__ void done(const Unit&) const {}
};
__device__ __forceinline__ unsigned cvt_pk_bf16(float lo, float hi) { unsigned r; asm volatile("v_cvt_pk_bf16_f32 %0, %1, %2" : "=v"(r) : "v"(lo), "v"(hi)); return r; }
template <class Epi, class Sched, bool STAMP = false>
__device__ __forceinline__ void gemm_phase(PG8_LAS unsigned char* lds, const Gemm g, const Sched& S, const Epi& E, unsigned long long* stamps) {
    const int tid = threadIdx.x, wid = __builtin_amdgcn_readfirstlane(tid >> 6), lane = tid & 63, wr = wid >> 2, wc = wid & 3, fr = lane & 15, fq = lane >> 4;
    const int K = g.K, nt = K / BK;
    int ts_lo = 0, ts_hi = 0, nts = 0; const unsigned long long rt_entry = STAMP ? (unsigned long long)wall_clock64() : 0ull;
#define PG8_STAMP() do { if (STAMP && wid == 0 && nts < 64) { const unsigned long long _c = (unsigned long long)clock64(); \
        ts_lo = (lane == nts) ? (int)(unsigned)_c : ts_lo; ts_hi = (lane == nts) ? (int)(unsigned)(_c >> 32) : ts_hi; ++nts; } } while (0)
    PG8_STAMP();
    unsigned voffA[2], voffB[2];
#pragma unroll
    for (int i = 0; i < 2; ++i) { int R, C; stage_rc(tid * 16 + i * 8192, R, C); const int Rb = Epi::PERM ? ((R & ~31) + perm32(R & 31)) : R;
        voffA[i] = (unsigned)(R * K + C) * 2u; voffB[i] = (unsigned)(Rb * K + C) * 2u; }
    const size_t kstep = (size_t)(BK * 2);
    const size_t hstep = (size_t)HALF * K * 2;
    const size_t tstep = 2 * hstep;
    const unsigned ldsw = (unsigned)wid * 1024u;
    const int aoff = lds_byte(wr * 64 + fr, fq * 8), boff = lds_byte(wc * 32 + fr, fq * 8);
#define PG8_SA(b, h) (((b) * 2 + (h)) * HTB)
#define PG8_SB(b, h) ((4 + (b) * 2 + (h)) * HTB)
#define PG8_STAGE(bufoff, gbase, voff) do { _Pragma("unroll") for (int _i = 0; _i < 2; ++_i) \
        __builtin_amdgcn_global_load_lds((const unsigned*)((const char*)(gbase) + (voff)[_i]), (PG8_LAS unsigned*)(lds + (bufoff) + ldsw + _i * 8192), 16, 0, 0); } while (0)
#define PG8_LDA(dst, b, h) do { _Pragma("unroll") for (int m = 0; m < 4; ++m) _Pragma("unroll") for (int k = 0; k < 2; ++k) dst[m][k] = *(const PG8_LAS bf16x8*)(lds + PG8_SA(b, h) + aoff + m * 2048 + k * 1024); } while (0)
#define PG8_LDB(dst, b, h) do { _Pragma("unroll") for (int n = 0; n < 2; ++n) _Pragma("unroll") for (int k = 0; k < 2; ++k) dst[n][k] = *(const PG8_LAS bf16x8*)(lds + PG8_SB(b, h) + boff + n * 2048 + k * 1024); } while (0)
#define PG8_MMA(ai, bj, At, Bt) do { __builtin_amdgcn_s_setprio(1); _Pragma("unroll") for (int m = 0; m < 4; ++m) _Pragma("unroll") for (int n = 0; n < 2; ++n) _Pragma("unroll") for (int k = 0; k < 2; ++k) \
        acc[ai][bj][m][n] = __builtin_amdgcn_mfma_f32_16x16x32_bf16(Bt[n][k], At[m][k], acc[ai][bj][m][n], 0, 0, 0); __builtin_amdgcn_s_setprio(0); } while (0)
#define PG8_WAIT_V(n) asm volatile("s_waitcnt vmcnt(" #n ")" ::: "memory")
#define PG8_WAIT_L(n) asm volatile("s_waitcnt lgkmcnt(" #n ")" ::: "memory")
#define PG8_BAR __builtin_amdgcn_s_barrier()
#define PG8_SCHED __builtin_amdgcn_sched_barrier(0)
    Unit cur, nxt; int ui = 0;
    if (!S.next(0, cur)) return;
    f32x4 acc[2][2][4][2];
#pragma unroll
    for (int a = 0; a < 2; ++a)
#pragma unroll
        for (int b = 0; b < 2; ++b)
#pragma unroll
            for (int m = 0; m < 4; ++m)
#pragma unroll
                for (int n = 0; n < 2; ++n) acc[a][b][m][n] = (f32x4){0.f, 0.f, 0.f, 0.f};
    bf16x8 At[4][2], B0[2][2], B1[2][2];
    const char* cA = (const char*)g.A + (size_t)cur.pm * tstep; const char* cB = (const char*)g.Bt + (size_t)cur.pn * tstep;
    S.a_ready(cur);
    PG8_STAGE(PG8_SB(0, 0), cB, voffB); PG8_STAGE(PG8_SA(0, 0), cA, voffA); PG8_STAGE(PG8_SB(0, 1), cB + hstep, voffB); PG8_STAGE(PG8_SA(0, 1), cA + hstep, voffA);
    if (wr == 1) PG8_BAR;
    PG8_WAIT_V(4); PG8_BAR;
    PG8_STAGE(PG8_SB(1, 0), cB + kstep, voffB); PG8_STAGE(PG8_SA(1, 0), cA + kstep, voffA); PG8_STAGE(PG8_SB(1, 1), cB + hstep + kstep, voffB);
    PG8_WAIT_V(6); PG8_BAR;
    PG8_STAMP();
    for (;;) {
        const bool has_next = S.next(ui + 1, nxt);
        const char* nA = has_next ? (const char*)g.A + (size_t)nxt.pm * tstep : cA; const char* nB = has_next ? (const char*)g.Bt + (size_t)nxt.pn * tstep : cB;
        for (int t = 0; t < nt; t += 2) {
            const bool last = (t == nt - 2);
            const char* a1 = cA + (size_t)(t + 1) * kstep;
            const char* a2 = last ? nA : cA + (size_t)(t + 2) * kstep; const char* b2 = last ? nB : cB + (size_t)(t + 2) * kstep;
            const char* a3 = a2 + kstep; const char* b3 = b2 + kstep;
            if (last && has_next) S.a_ready(nxt);
            PG8_LDB(B0, 0, 0); PG8_SCHED; PG8_LDA(At, 0, 0); PG8_STAGE(PG8_SA(1, 1), a1 + hstep, voffA);
            PG8_WAIT_L(8); PG8_BAR; PG8_WAIT_L(0); PG8_MMA(0, 0, At, B0); PG8_BAR; PG8_SCHED;
            PG8_LDB(B1, 0, 1); PG8_STAGE(PG8_SB(0, 0), b2, voffB);
            PG8_BAR; PG8_WAIT_L(0); PG8_MMA(0, 1, At, B1); PG8_BAR;
            PG8_LDA(At, 0, 1); PG8_STAGE(PG8_SA(0, 0), a2, voffA);
            PG8_BAR; PG8_WAIT_L(0); PG8_MMA(1, 0, At, B0); PG8_BAR; PG8_SCHED;
            PG8_STAGE(PG8_SB(0, 1), b2 + hstep, voffB);
            PG8_WAIT_V(6); PG8_BAR; PG8_MMA(1, 1, At, B1); PG8_BAR;
            PG8_LDB(B0, 1, 0); PG8_SCHED; PG8_LDA(At, 1, 0); PG8_STAGE(PG8_SA(0, 1), a2 + hstep, voffA);
            PG8_WAIT_L(8); PG8_BAR; PG8_WAIT_L(0); PG8_MMA(0, 0, At, B0); PG8_BAR; PG8_SCHED;
            PG8_LDB(B1, 1, 1); PG8_STAGE(PG8_SB(1, 0), b3, voffB);
            PG8_BAR; PG8_WAIT_L(0); PG8_MMA(0, 1, At, B1); PG8_BAR;
            PG8_LDA(At, 1, 1); PG8_STAGE(PG8_SA(1, 0), a3, voffA);
            PG8_BAR; PG8_WAIT_L(0); PG8_MMA(1, 0, At, B0); PG8_BAR; PG8_SCHED;
            PG8_STAGE(PG8_SB(1, 1), b3 + hstep, voffB);
            PG8_WAIT_V(6); PG8_BAR; PG8_MMA(1, 1, At, B1); PG8_BAR;
        }
        PG8_STAMP();
        if constexpr (!Epi::AFTER_DRAIN) { E(acc, cur, wr, wc, fr, fq); S.done(cur); }
        PG8_STAMP();
        if (!has_next) break;
#pragma unroll
        for (int a = 0; a < 2; ++a)
#pragma unroll
            for (int b = 0; b < 2; ++b)
#pragma unroll
                for (int m = 0; m < 4; ++m)
#pragma unroll
                    for (int n = 0; n < 2; ++n) acc[a][b][m][n] = (f32x4){0.f, 0.f, 0.f, 0.f};
        cur = nxt; cA = nA; cB = nB; ++ui;
    }
    PG8_WAIT_V(0);
    if (wr == 0) PG8_BAR;
    PG8_BAR;
    if constexpr (Epi::AFTER_DRAIN) { E.fused(acc, cur, wr, wc, fr, fq, lds, wid, lane); S.done(cur); }
    PG8_STAMP();
    if (STAMP && wid == 0) { stamps[lane] = lane < nts ? (((unsigned long long)(unsigned)ts_hi << 32) | (unsigned)ts_lo) : 0ull;
        if (lane == 62) stamps[62] = rt_entry; if (lane == 63) stamps[63] = (unsigned long long)wall_clock64(); }
#undef PG8_STAMP
#undef PG8_SA
#undef PG8_SB
#undef PG8_STAGE
#undef PG8_LDA
#undef PG8_LDB
#undef PG8_MMA
#undef PG8_WAIT_V
#undef PG8_WAIT_L
#undef PG8_BAR
#undef PG8_SCHED
}
}
using pg8::bf16_t; using pg8::bf16x8; using pg8::f32x4; using pg8::u32x4; using pg8::cvt_pk_bf16;
typedef unsigned u32x2 __attribute__((ext_vector_type(2)));
typedef float f32x16 __attribute__((ext_vector_type(16)));

constexpr int T = 32768, D = 2048, SEQ = 8192, PIN = 16392, DFF = 5632, TH = 16384;
constexpr float EPS = 1e-6f, LOG2E = 1.4426950408889634f;
constexpr size_t MiB = (size_t)1 << 20;
constexpr size_t WS_CTL = 0, WS_GIF = 1 * MiB, WS_KT = 2 * MiB, WS_AQK = 66 * MiB, WS_VTM = 194 * MiB, WS_GA = 322 * MiB, WS_BQ = 450 * MiB, WS_BK = 578 * MiB,
                 WS_VTD = 706 * MiB, WS_GB = 834 * MiB, WS_END = 962 * MiB;
constexpr size_t WS_HM = WS_AQK, WS_H2 = WS_AQK, WS_WOUT = WS_VTM, WS_WUP = WS_VTM + 8 * MiB, WS_WDN = WS_VTM + 52 * MiB, WS_UP = WS_GA, WS_ACT = 674 * MiB;
constexpr size_t DO_H = 0, DO_Q2 = 0, DO_K2 = 64 * MiB, DO_WIN = 128 * MiB;
constexpr int LDS_BYTES = 147456;

struct Params {
    const float *x, *norm1_g, *w_in, *if_bias, *qk_conv_w, *qk_conv_b, *mlstm_norm_g, *q_norm_g, *k_norm_g, *diff_lambda, *subln_g, *w_out, *norm2_g, *w_up, *ffn_conv_w, *ffn_conv_b, *w_down;
    float* out; unsigned char* ws; int ph_lo, ph_hi;
};

__device__ __forceinline__ void lds_wait() { asm volatile("s_waitcnt lgkmcnt(0)" ::: "memory"); }
__device__ __forceinline__ float bflo(unsigned u) { return __uint_as_float(u << 16); }
__device__ __forceinline__ float bfhi(unsigned u) { return __uint_as_float(u & 0xffff0000u); }
__device__ __forceinline__ float fsig(float v) { return __builtin_amdgcn_rcpf(1.f + __expf(-v)); }
__device__ __forceinline__ float wave_sum(float v) {
#pragma unroll
    for (int o = 1; o < 64; o <<= 1) v += __shfl_xor(v, o);
    return v;
}
__device__ __forceinline__ void unpack8(u32x4 u, float (&f)[8]) {
    f[0] = bflo(u.x); f[1] = bfhi(u.x); f[2] = bflo(u.y); f[3] = bfhi(u.y); f[4] = bflo(u.z); f[5] = bfhi(u.z); f[6] = bflo(u.w); f[7] = bfhi(u.w);
}
__device__ __forceinline__ u32x4 pack8(const float (&f)[8]) {
    u32x4 o; o.x = cvt_pk_bf16(f[0], f[1]); o.y = cvt_pk_bf16(f[2], f[3]); o.z = cvt_pk_bf16(f[4], f[5]); o.w = cvt_pk_bf16(f[6], f[7]); return o;
}

__device__ __forceinline__ void transpose_item(const float* __restrict__ W, size_t ldw, int K, bf16_t* WT, int k0, int srcn0, int dstn0, float* scr, int lane) {
#pragma unroll 8
    for (int i = 0; i < 32; ++i) { const int kk = 2 * i + (lane >> 5); scr[kk * 33 + (lane & 31)] = W[(size_t)(k0 + kk) * ldw + srcn0 + (lane & 31)]; }
    lds_wait();
    const int c = lane & 7;
#pragma unroll
    for (int j = 0; j < 4; ++j) { const int n = (lane >> 3) + 8 * j; const float* s = scr + (8 * c) * 33 + n;
        u32x4 o; o.x = cvt_pk_bf16(s[0], s[33]); o.y = cvt_pk_bf16(s[66], s[99]); o.z = cvt_pk_bf16(s[132], s[165]); o.w = cvt_pk_bf16(s[198], s[231]);
        *(u32x4*)(WT + (size_t)(dstn0 + n) * K + k0 + 8 * c) = o; }
    lds_wait();
}
__device__ __forceinline__ int win_src(int n) {
    if (n < 4096) return n;
    if (n < 8192) { const int p = (n - 4096) >> 8, j = (n - 4096) & 255; return j < 128 ? 4096 + 128 * p + j : 12296 + 128 * p + (j - 128); }
    if (n < 10240) return 6152 + (n - 8192);
    if (n < 12288) return 8200 + (n - 10240);
    if (n < 14336) return 10248 + (n - 12288);
    return 14344 + (n - 14336);
}
__device__ __forceinline__ void transpose_plain(const float* W, int K, int N, bf16_t* WT, float* scr, int gw, int ngw, int lane) {
    const int nblk = N / 32, nitems = (K / 64) * nblk;
    for (int it = gw; it < nitems; it += ngw) { const int kb = it / nblk, nb = it % nblk; transpose_item(W, (size_t)N, K, WT, 64 * kb, 32 * nb, 32 * nb, scr, lane); }
}

__device__ __forceinline__ void phase0(const Params& p, unsigned char* shm) {
    const int tid = threadIdx.x, lane = tid & 63, wave = tid >> 6, gw = blockIdx.x * 8 + wave, ngw = gridDim.x * 8;
    float* scr = (float*)(shm + wave * 8448);
    bf16_t* WinT = (bf16_t*)((unsigned char*)p.out + DO_WIN);
    { const int nblk = 16384 / 32, nitems = (D / 64) * nblk;
      for (int it = gw; it < nitems; it += ngw) { const int kb = it / nblk, nb = it % nblk; transpose_item(p.w_in, (size_t)PIN, D, WinT, 64 * kb, win_src(32 * nb), 32 * nb, scr, lane); } }
    float* wifT = (float*)(shm + 69632);
    for (int idx = tid; idx < 8 * D; idx += 512) { const int k = idx >> 3, j = idx & 7; wifT[j * D + k] = p.w_in[(size_t)k * PIN + 6144 + j]; }
    __syncthreads();
    bf16_t* H = (bf16_t*)((unsigned char*)p.out + DO_H);
    float* GIF = (float*)(p.ws + WS_GIF);
    for (int row = gw; row < T; row += ngw) {
        const f32x4* xr = (const f32x4*)(p.x + (size_t)row * D) + lane;
        f32x4 v[8]; float ss = 0.f;
#pragma unroll
        for (int j = 0; j < 8; ++j) { v[j] = xr[64 * j]; ss += (v[j].x * v[j].x + v[j].y * v[j].y) + (v[j].z * v[j].z + v[j].w * v[j].w); }
        const float rinv = rsqrtf(wave_sum(ss) * (1.f / D) + EPS);
        float ga[8];
#pragma unroll
        for (int j = 0; j < 8; ++j) ga[j] = 0.f;
        u32x2* o8 = (u32x2*)(H + (size_t)row * D) + lane;
#pragma unroll
        for (int j = 0; j < 8; ++j) {
            const f32x4 g = *((const f32x4*)p.norm1_g + lane + 64 * j);
            f32x4 h; h.x = v[j].x * rinv * g.x; h.y = v[j].y * rinv * g.y; h.z = v[j].z * rinv * g.z; h.w = v[j].w * rinv * g.w;
            u32x2 o; o.x = cvt_pk_bf16(h.x, h.y); o.y = cvt_pk_bf16(h.z, h.w); o8[64 * j] = o;
#pragma unroll
            for (int q = 0; q < 8; ++q) { const f32x4 w = *((const f32x4*)(wifT + q * D) + lane + 64 * j); ga[q] += (h.x * w.x + h.y * w.y) + (h.z * w.z + h.w * w.w); }
        }
#pragma unroll
        for (int q = 0; q < 8; ++q) ga[q] = wave_sum(ga[q]);
        if (lane < 8) {
            float val = 0.f;
#pragma unroll
            for (int q = 0; q < 8; ++q) val = (lane == q) ? ga[q] : val;
            val += p.if_bias[lane];
            if (lane >= 4) val = fminf(val, 0.f) - log1pf(expf(-fabsf(val)));
            GIF[(size_t)row * 8 + lane] = val;
        }
    }
}

struct Epi1 {
    static constexpr bool PERM = true, AFTER_DRAIN = false;
    bf16_t *aqk, *vtm, *ga, *bq, *bk, *vtd, *gb;
    __device__ __forceinline__ void operator()(const f32x4 (&acc)[2][2][4][2], const pg8::Unit& u, int wr, int wc, int fr, int fq) const {
        const int pn = u.pn, row0 = u.pm * 256 + wr * 64 + fr, cw = wc * 32 + 8 * fq;
        if (pn >= 16 && pn < 32) {
            const int cb = 128 * (pn - 16) + cw;
#pragma unroll
            for (int ai = 0; ai < 2; ++ai)
#pragma unroll
                for (int m = 0; m < 4; ++m) {
                    const size_t row = (size_t)(row0 + ai * 128 + m * 16);
                    float f[8];
#pragma unroll
                    for (int j = 0; j < 4; ++j) { f[j] = fsig(acc[ai][0][m][0][j]) * fsig(acc[ai][1][m][0][j]); f[4 + j] = fsig(acc[ai][0][m][1][j]) * fsig(acc[ai][1][m][1][j]); }
                    *(u32x4*)(ga + row * D + cb) = pack8(f);
                }
            return;
        }
        bf16_t* dst; int col0; int mode;
        if (pn < 8) { dst = aqk; col0 = 256 * pn; mode = 0; }
        else if (pn < 16) { dst = vtm; col0 = 256 * (pn - 8); mode = 1; }
        else if (pn < 40) { dst = bq; col0 = 256 * (pn - 32); mode = 0; }
        else if (pn < 48) { dst = bk; col0 = 256 * (pn - 40); mode = 0; }
        else if (pn < 56) { dst = vtd; col0 = 256 * (pn - 48); mode = 1; }
        else { dst = gb; col0 = 256 * (pn - 56); mode = 2; }
#pragma unroll
        for (int ai = 0; ai < 2; ++ai)
#pragma unroll
            for (int m = 0; m < 4; ++m) {
                const int row = row0 + ai * 128 + m * 16;
#pragma unroll
                for (int bj = 0; bj < 2; ++bj) {
                    const int col = col0 + bj * 128 + cw;
                    float f[8];
#pragma unroll
                    for (int j = 0; j < 4; ++j) { f[j] = acc[ai][bj][m][0][j]; f[4 + j] = acc[ai][bj][m][1][j]; }
                    if (mode == 2) {
#pragma unroll
                        for (int j = 0; j < 8; ++j) f[j] = fsig(f[j]);
                    }
                    const u32x4 w = pack8(f);
                    if (mode == 1) {
                        bf16_t* d = dst + ((size_t)((row >> 13) * D + col)) * SEQ + (row & (SEQ - 1));
                        d[0 * (size_t)SEQ] = (bf16_t)(w.x & 0xffff); d[1 * (size_t)SEQ] = (bf16_t)(w.x >> 16); d[2 * (size_t)SEQ] = (bf16_t)(w.y & 0xffff); d[3 * (size_t)SEQ] = (bf16_t)(w.y >> 16);
                        d[4 * (size_t)SEQ] = (bf16_t)(w.z & 0xffff); d[5 * (size_t)SEQ] = (bf16_t)(w.z >> 16); d[6 * (size_t)SEQ] = (bf16_t)(w.w & 0xffff); d[7 * (size_t)SEQ] = (bf16_t)(w.w >> 16);
                    } else {
                        *(u32x4*)(dst + (size_t)row * D + col) = w;
                    }
                }
            }
    }
};
struct EpiRes {
    static constexpr bool PERM = false, AFTER_DRAIN = false;
    float* C; const float* R; int ldc;
    __device__ __forceinline__ void operator()(const f32x4 (&acc)[2][2][4][2], const pg8::Unit& u, int wr, int wc, int fr, int fq) const {
        const int row0 = u.pm * 256 + wr * 64 + fr, col0 = u.pn * 256 + wc * 32 + 4 * fq;
#pragma unroll
        for (int ai = 0; ai < 2; ++ai)
#pragma unroll
            for (int m = 0; m < 4; ++m) {
                const size_t off = (size_t)(row0 + ai * 128 + m * 16) * ldc + col0;
#pragma unroll
                for (int bj = 0; bj < 2; ++bj)
#pragma unroll
                    for (int n = 0; n < 2; ++n) { const f32x4 r = *(const f32x4*)(R + off + bj * 128 + n * 16); *(f32x4*)(C + off + bj * 128 + n * 16) = acc[ai][bj][m][n] + r; }
            }
    }
};
struct EpiB {
    static constexpr bool PERM = true, AFTER_DRAIN = false;
    bf16_t* O; int ldc;
    __device__ __forceinline__ void operator()(const f32x4 (&acc)[2][2][4][2], const pg8::Unit& u, int wr, int wc, int fr, int fq) const {
        const int row0 = u.pm * 256 + wr * 64 + fr, col0 = u.pn * 256 + wc * 32 + 8 * fq;
#pragma unroll
        for (int ai = 0; ai < 2; ++ai)
#pragma unroll
            for (int m = 0; m < 4; ++m) {
                bf16_t* rowp = O + (size_t)(row0 + ai * 128 + m * 16) * ldc + col0;
#pragma unroll
                for (int bj = 0; bj < 2; ++bj) {
                    u32x4 w; w.x = cvt_pk_bf16(acc[ai][bj][m][0][0], acc[ai][bj][m][0][1]); w.y = cvt_pk_bf16(acc[ai][bj][m][0][2], acc[ai][bj][m][0][3]);
                    w.z = cvt_pk_bf16(acc[ai][bj][m][1][0], acc[ai][bj][m][1][1]); w.w = cvt_pk_bf16(acc[ai][bj][m][1][2], acc[ai][bj][m][1][3]);
                    *(u32x4*)(rowp + bj * 128) = w;
                }
            }
    }
};
template <class Epi> __device__ __forceinline__ void run_gemm(unsigned char* shm, const bf16_t* A, const bf16_t* Bt, int M, int N, int K, const Epi& E) {
    pg8::Gemm g{A, Bt, M, N, K};
    pg8::StaticOrder S; S.init(M, N, (int)gridDim.x, (int)blockIdx.x);
    pg8::gemm_phase<Epi, pg8::StaticOrder, false>((PG8_LAS unsigned char*)shm, g, S, E, nullptr);
}

__device__ __forceinline__ void phase2a(const Params& p, unsigned char* shm) {
    const int tid = threadIdx.x, lane = tid & 63, wave = tid >> 6;
    const bf16_t* AQK = (const bf16_t*)(p.ws + WS_AQK);
    bf16_t* Q2 = (bf16_t*)((unsigned char*)p.out + DO_Q2); bf16_t* K2 = (bf16_t*)((unsigned char*)p.out + DO_K2); bf16_t* KT = (bf16_t*)(p.ws + WS_KT);
    bf16_t* tl = (bf16_t*)shm;
    for (int item = blockIdx.x; item < 256 * 32; item += gridDim.x) {
        const int ch = item >> 5, cgp = item & 31, t0 = ch * 128, oct = tid & 7, rg = tid >> 3, c0 = 64 * cgp + 8 * oct;
        float w[4][8], bias[8];
#pragma unroll
        for (int j = 0; j < 4; ++j) { const f32x4 a = *(const f32x4*)(p.qk_conv_w + j * D + c0), b = *(const f32x4*)(p.qk_conv_w + j * D + c0 + 4);
            w[j][0] = a.x; w[j][1] = a.y; w[j][2] = a.z; w[j][3] = a.w; w[j][4] = b.x; w[j][5] = b.y; w[j][6] = b.z; w[j][7] = b.w; }
        { const f32x4 a = *(const f32x4*)(p.qk_conv_b + c0), b = *(const f32x4*)(p.qk_conv_b + c0 + 4);
          bias[0] = a.x; bias[1] = a.y; bias[2] = a.z; bias[3] = a.w; bias[4] = b.x; bias[5] = b.y; bias[6] = b.z; bias[7] = b.w; }
        float in[5][8];
        const int rl0 = 2 * rg;
#pragma unroll
        for (int k = 0; k < 5; ++k) {
            const int rl = rl0 - 3 + k; const int sp = (t0 & (SEQ - 1)) + rl;
            if (sp >= 0) { const u32x4 u = *(const u32x4*)(AQK + (size_t)(t0 + rl) * D + c0); unpack8(u, in[k]); }
            else {
#pragma unroll
                for (int e = 0; e < 8; ++e) in[k][e] = 0.f; }
        }
        const bool isq = cgp < 16;
#pragma unroll
        for (int rr = 0; rr < 2; ++rr) {
            float y[8];
#pragma unroll
            for (int e = 0; e < 8; ++e) { float a = bias[e]; a += w[0][e] * in[rr][e]; a += w[1][e] * in[rr + 1][e]; a += w[2][e] * in[rr + 2][e]; a += w[3][e] * in[rr + 3][e];
                a = a * fsig(a); y[e] = isq ? a * 0.0625f : a; }
            const u32x4 o = pack8(y);
            const size_t row = (size_t)(t0 + rl0 + rr);
            if (isq) *(u32x4*)(Q2 + row * 1024 + c0) = o;
            else {
                *(u32x4*)(K2 + row * 1024 + (c0 - 1024)) = o;
                bf16_t* tp = tl + (8 * oct) * 136 + rl0 + rr;
                tp[0 * 136] = (bf16_t)(o.x & 0xffff); tp[1 * 136] = (bf16_t)(o.x >> 16); tp[2 * 136] = (bf16_t)(o.y & 0xffff); tp[3 * 136] = (bf16_t)(o.y >> 16);
                tp[4 * 136] = (bf16_t)(o.z & 0xffff); tp[5 * 136] = (bf16_t)(o.z >> 16); tp[6 * 136] = (bf16_t)(o.w & 0xffff); tp[7 * 136] = (bf16_t)(o.w >> 16);
            }
        }
        if (!isq) {
            __syncthreads();
            const int col = tid >> 3, seg = tid & 7, kc = 64 * (cgp - 16) + col, hA = kc >> 8, d = kc & 255, b = t0 >> 13, s0 = t0 & (SEQ - 1);
            const u32x4 a0 = *(const u32x4*)(tl + col * 136 + 16 * seg), a1 = *(const u32x4*)(tl + col * 136 + 16 * seg + 8);
            bf16_t* dst = KT + ((size_t)((b * 4 + hA) * 256 + d)) * SEQ + s0 + 16 * seg;
            *(u32x4*)dst = a0; *(u32x4*)(dst + 8) = a1;
            __syncthreads();
        }
    }
    {
        bf16_t* BQ = (bf16_t*)(p.ws + WS_BQ); bf16_t* BK = (bf16_t*)(p.ws + WS_BK);
        const int e16 = lane & 15, sub = lane >> 4;
        const float qs = 0.08838834764831845f * LOG2E;
        const f32x4 gq0 = *(const f32x4*)(p.q_norm_g + 8 * e16), gq1 = *(const f32x4*)(p.q_norm_g + 8 * e16 + 4);
        const f32x4 gk0 = *(const f32x4*)(p.k_norm_g + 8 * e16), gk1 = *(const f32x4*)(p.k_norm_g + 8 * e16 + 4);
        const int gwv = blockIdx.x * 8 + wave, ngw = gridDim.x * 8;
        for (int it = gwv; it < T * 32 / 4; it += ngw) {
            const int gid = it * 4 + sub, t = gid >> 5, grp = gid & 31;
            const bool isq = grp < 16;
            bf16_t* ptr = (isq ? BQ : BK) + (size_t)t * D + 128 * (grp & 15) + 8 * e16;
            float f[8]; unpack8(*(const u32x4*)ptr, f);
            float ss = 0.f;
#pragma unroll
            for (int e = 0; e < 8; ++e) ss += f[e] * f[e];
            ss += __shfl_xor(ss, 1); ss += __shfl_xor(ss, 2); ss += __shfl_xor(ss, 4); ss += __shfl_xor(ss, 8);
            const float rinv = rsqrtf(ss * (1.f / 128.f) + EPS) * (isq ? qs : 1.f);
            const f32x4 g0 = isq ? gq0 : gk0, g1 = isq ? gq1 : gk1;
            f[0] *= rinv * g0.x; f[1] *= rinv * g0.y; f[2] *= rinv * g0.z; f[3] *= rinv * g0.w; f[4] *= rinv * g1.x; f[5] *= rinv * g1.y; f[6] *= rinv * g1.z; f[7] *= rinv * g1.w;
            *(u32x4*)ptr = pack8(f);
        }
    }
}

constexpr int ML_KL = 0, ML_CT = 67584, ML_VT = 101376, ML_A = 118784, ML_MM = 119296, ML_BB = 119808, ML_WS = 120320, ML_N = 120832, ML_MISC = 121856;
__device__ __forceinline__ void mlstm_item(const Params& p, unsigned char* shm, int item) {
    const int tid = threadIdx.x, lane = tid & 63, w = __builtin_amdgcn_readfirstlane(tid >> 6), l15 = lane & 15, qq = lane >> 4;
    const int sl = item & 7, hA = (item >> 3) & 3, b = item >> 5;
    const bf16_t* Q2 = (const bf16_t*)((const unsigned char*)p.out + DO_Q2); const bf16_t* K2 = (const bf16_t*)((const unsigned char*)p.out + DO_K2);
    const bf16_t* KT = (const bf16_t*)(p.ws + WS_KT); const bf16_t* VTM = (const bf16_t*)(p.ws + WS_VTM); const float* GIF = (const float*)(p.ws + WS_GIF);
    bf16_t* HM = (bf16_t*)(p.ws + WS_HM);
    float* sA = (float*)(shm + ML_A); float* sMM = (float*)(shm + ML_MM); float* sBB = (float*)(shm + ML_BB); float* sWS = (float*)(shm + ML_WS); float* sN = (float*)(shm + ML_N); float* sMisc = (float*)(shm + ML_MISC);
    f32x4 Cacc[2][4];
#pragma unroll
    for (int a = 0; a < 2; ++a)
#pragma unroll
        for (int c = 0; c < 4; ++c) Cacc[a][c] = (f32x4){0.f, 0.f, 0.f, 0.f};
    float n_reg = 0.f, m_st = 0.f;
    const bf16_t* ktrow0 = KT + ((size_t)((b * 4 + hA) * 256)) * SEQ;
    const bf16_t* vtrow0 = VTM + ((size_t)((b * 4 + hA) * 512 + 64 * sl)) * SEQ;
    for (int c = 0; c < 64; ++c) {
        const int s0 = 128 * c; const size_t t0 = (size_t)b * SEQ + s0;
        bf16x8 qf[8];
        { const bf16_t* qp = Q2 + (t0 + 16 * w + l15) * 1024 + hA * 256 + 64 * qq;
#pragma unroll
          for (int ks = 0; ks < 8; ++ks) qf[ks] = *(const bf16x8*)(qp + 8 * ks); }
        { const int row = tid >> 2, part = tid & 3; const bf16_t* src = K2 + (t0 + row) * 1024 + hA * 256 + part * 64; unsigned char* dst = shm + ML_KL + row * 528 + part * 128;
#pragma unroll
          for (int e = 0; e < 8; ++e) *(u32x4*)(dst + 16 * e) = *(const u32x4*)(src + 8 * e); }
        { const int dv = tid >> 3, part = tid & 7; const bf16_t* src = vtrow0 + (size_t)dv * SEQ + s0 + part * 16; unsigned char* dst = shm + ML_VT + dv * 272 + part * 32;
          *(u32x4*)dst = *(const u32x4*)src; *(u32x4*)(dst + 16) = *(const u32x4*)(src + 8); }
#pragma unroll
        for (int dkb = 0; dkb < 2; ++dkb)
#pragma unroll
            for (int dvb = 0; dvb < 4; ++dvb) {
                u32x2 o; o.x = cvt_pk_bf16(Cacc[dkb][dvb][0], Cacc[dkb][dvb][1]); o.y = cvt_pk_bf16(Cacc[dkb][dvb][2], Cacc[dkb][dvb][3]);
                *(u32x2*)(shm + ML_CT + (16 * dvb + l15) * 528 + (32 * w + 16 * dkb + 4 * qq) * 2) = o;
            }
        if ((tid & 1) == 0) sN[tid >> 1] = n_reg;
        if (w == 0) {
            const float li0 = GIF[(t0 + 2 * lane) * 8 + hA], li1 = GIF[(t0 + 2 * lane + 1) * 8 + hA], lf0 = GIF[(t0 + 2 * lane) * 8 + 4 + hA], lf1 = GIF[(t0 + 2 * lane + 1) * 8 + 4 + hA];
            float cs = lf0 + lf1;
#pragma unroll
            for (int o = 1; o < 64; o <<= 1) { const float v = __shfl_up(cs, o); if (lane >= o) cs += v; }
            const float b1 = cs, b0 = cs - lf1;
            const float a0 = li0 - b0, a1 = li1 - b1;
            float pmx = fmaxf(a0, a1);
#pragma unroll
            for (int o = 1; o < 64; o <<= 1) { const float v = __shfl_up(pmx, o); if (lane >= o) pmx = fmaxf(pmx, v); }
            float ex = __shfl_up(pmx, 1); if (lane == 0) ex = -3.0e38f;
            const float pm0 = fmaxf(ex, a0), pm1 = pmx;
            const float mm0 = fmaxf(pm0, m_st), mm1 = fmaxf(pm1, m_st);
            const float mml = __shfl(mm1, 63), bl = __shfl(b1, 63);
            sA[2 * lane] = a0; sA[2 * lane + 1] = a1; sMM[2 * lane] = mm0; sMM[2 * lane + 1] = mm1; sBB[2 * lane] = b0; sBB[2 * lane + 1] = b1;
            sWS[2 * lane] = __expf(a0 - mml); sWS[2 * lane + 1] = __expf(a1 - mml);
            if (lane == 0) { sMisc[0] = bl; sMisc[1] = mml; }
        }
        __syncthreads();
        const int tl = 16 * w + l15;
        const float mm_t = sMM[tl], b_t = sBB[tl], gi = __expf(m_st - mm_t);
        bf16x8 pf[4]; float den = 0.f;
#pragma unroll
        for (int a = 0; a < 4; ++a) {
            pf[a] = (bf16x8){0, 0, 0, 0, 0, 0, 0, 0};
            if (2 * a <= w) {
                float pv[8];
#pragma unroll
                for (int e = 0; e < 2; ++e) {
                    {
                        f32x4 S = (f32x4){0.f, 0.f, 0.f, 0.f};
                        const int krow = 32 * a + 8 * (l15 >> 2) + 4 * e + (l15 & 3);
                        const unsigned char* kp = shm + ML_KL + krow * 528 + 128 * qq;
#pragma unroll
                        for (int ks = 0; ks < 8; ++ks) { const bf16x8 kf = *(const bf16x8*)(kp + 16 * ks); S = __builtin_amdgcn_mfma_f32_16x16x32_bf16(kf, qf[ks], S, 0, 0, 0); }
                        const int key0 = 32 * a + 8 * qq + 4 * e;
                        const f32x4 av = *(const f32x4*)(sA + key0);
#pragma unroll
                        for (int i = 0; i < 4; ++i) { const float pw = (key0 + i <= tl) ? S[i] * __expf(av[i] - mm_t) : 0.f; pv[4 * e + i] = pw; den += pw; }
                    }
                }
                const u32x4 pk = pack8(pv);
                pf[a] = __builtin_bit_cast(bf16x8, pk);
            }
        }
        den += __shfl_xor(den, 16); den += __shfl_xor(den, 32);
        f32x4 num[4];
#pragma unroll
        for (int dvb = 0; dvb < 4; ++dvb) {
            f32x4 acc = (f32x4){0.f, 0.f, 0.f, 0.f};
            const unsigned char* cp = shm + ML_CT + (16 * dvb + l15) * 528 + 128 * qq;
#pragma unroll
            for (int ks = 0; ks < 8; ++ks) { const bf16x8 cf = *(const bf16x8*)(cp + 16 * ks); acc = __builtin_amdgcn_mfma_f32_16x16x32_bf16(cf, qf[ks], acc, 0, 0, 0); }
            num[dvb] = acc * gi;
        }
        float qn = 0.f;
#pragma unroll
        for (int ks = 0; ks < 8; ++ks) {
            float qv[8]; unpack8(__builtin_bit_cast(u32x4, qf[ks]), qv);
            const f32x4 n0 = *(const f32x4*)(sN + 64 * qq + 8 * ks), n1 = *(const f32x4*)(sN + 64 * qq + 8 * ks + 4);
            qn += (qv[0] * n0.x + qv[1] * n0.y) + (qv[2] * n0.z + qv[3] * n0.w) + (qv[4] * n1.x + qv[5] * n1.y) + (qv[6] * n1.z + qv[7] * n1.w);
        }
        qn += __shfl_xor(qn, 16); qn += __shfl_xor(qn, 32);
        den += gi * qn;
#pragma unroll
        for (int a = 0; a < 4; ++a) {
            if (2 * a <= w) {
#pragma unroll
                for (int dvb = 0; dvb < 4; ++dvb) {
                    const bf16x8 vf = *(const bf16x8*)(shm + ML_VT + (16 * dvb + l15) * 272 + (32 * a + 8 * qq) * 2);
                    num[dvb] = __builtin_amdgcn_mfma_f32_16x16x32_bf16(vf, pf[a], num[dvb], 0, 0, 0);
                }
            }
        }
        { const float dn = __builtin_amdgcn_rcpf(fmaxf(fabsf(den), __expf(-(b_t + mm_t))));
          bf16_t* hp = HM + (t0 + tl) * D + hA * 512 + 64 * sl + 4 * qq;
#pragma unroll
          for (int dvb = 0; dvb < 4; ++dvb) { u32x2 o; o.x = cvt_pk_bf16(num[dvb][0] * dn, num[dvb][1] * dn); o.y = cvt_pk_bf16(num[dvb][2] * dn, num[dvb][3] * dn); *(u32x2*)(hp + 16 * dvb) = o; } }
        const float b_last = sMisc[0], mm_last = sMisc[1], decay = __expf(m_st - mm_last);
#pragma unroll
        for (int dkb = 0; dkb < 2; ++dkb)
#pragma unroll
            for (int dvb = 0; dvb < 4; ++dvb) Cacc[dkb][dvb] = Cacc[dkb][dvb] * decay;
#pragma unroll
        for (int a = 0; a < 4; ++a) {
            const f32x4 w0 = *(const f32x4*)(sWS + 32 * a + 8 * qq), w1 = *(const f32x4*)(sWS + 32 * a + 8 * qq + 4);
            bf16x8 kt[2];
#pragma unroll
            for (int dkb = 0; dkb < 2; ++dkb) kt[dkb] = *(const bf16x8*)(ktrow0 + (size_t)(32 * w + 16 * dkb + l15) * SEQ + s0 + 32 * a + 8 * qq);
#pragma unroll
            for (int dvb = 0; dvb < 4; ++dvb) {
                float vv[8]; unpack8(*(const u32x4*)(shm + ML_VT + (16 * dvb + l15) * 272 + (32 * a + 8 * qq) * 2), vv);
                vv[0] *= w0.x; vv[1] *= w0.y; vv[2] *= w0.z; vv[3] *= w0.w; vv[4] *= w1.x; vv[5] *= w1.y; vv[6] *= w1.z; vv[7] *= w1.w;
                const bf16x8 wv = __builtin_bit_cast(bf16x8, pack8(vv));
#pragma unroll
                for (int dkb = 0; dkb < 2; ++dkb) Cacc[dkb][dvb] = __builtin_amdgcn_mfma_f32_16x16x32_bf16(kt[dkb], wv, Cacc[dkb][dvb], 0, 0, 0);
            }
        }
        { const int dk = tid >> 1, hf = tid & 1; const bf16_t* kr = ktrow0 + (size_t)dk * SEQ + s0 + 64 * hf; float acc = 0.f;
#pragma unroll
          for (int e = 0; e < 8; ++e) { float kv[8]; unpack8(*(const u32x4*)(kr + 8 * e), kv); const f32x4 w0 = *(const f32x4*)(sWS + 64 * hf + 8 * e), w1 = *(const f32x4*)(sWS + 64 * hf + 8 * e + 4);
              acc += (kv[0] * w0.x + kv[1] * w0.y) + (kv[2] * w0.z + kv[3] * w0.w) + (kv[4] * w1.x + kv[5] * w1.y) + (kv[6] * w1.z + kv[7] * w1.w); }
          acc += __shfl_xor(acc, 1);
          n_reg = decay * n_reg + acc; }
        m_st = b_last + mm_last;
        __syncthreads();
    }
}

__device__ __forceinline__ void attn_item(const Params& p, unsigned char* shm, int item, float lam, float M2) {
    const int tid = threadIdx.x, lane = tid & 63, wave = __builtin_amdgcn_readfirstlane(tid >> 6), c = wave & 1, g = wave >> 1, r = lane & 31, hh = lane >> 5;
    const int qb = 63 - (item >> 5), bh = item & 31, b = bh >> 3, h = bh & 7;
    bf16_t* BQ = (bf16_t*)(p.ws + WS_BQ); const bf16_t* BK = (const bf16_t*)(p.ws + WS_BK); const bf16_t* VTD = (const bf16_t*)(p.ws + WS_VTD); const bf16_t* GB = (const bf16_t*)(p.ws + WS_GB);
    float* cmb = (float*)shm;
    const int tq = qb * 128 + 32 * g + r; const size_t rowq = (size_t)b * SEQ + tq;
    bf16x8 qf[8];
    { const bf16_t* qp = BQ + rowq * D + h * 256 + c * 128 + 64 * hh;
#pragma unroll
      for (int ks = 0; ks < 8; ++ks) qf[ks] = *(const bf16x8*)(qp + 8 * ks); }
    f32x16 O[8];
#pragma unroll
    for (int db = 0; db < 8; ++db)
#pragma unroll
        for (int i = 0; i < 16; ++i) O[db][i] = 0.f;
    float lsum = 0.f;
    const float slope2 = exp2f(-(float)(h + 1)) * LOG2E;
    float ci[16];
#pragma unroll
    for (int i = 0; i < 16; ++i) ci[i] = slope2 * (float)((i & 3) + 4 * ((i >> 2) & 1) + 8 * hh + 16 * (i >> 3));
    const int ntile = qb * 4 + g + 1;
    const int keyperm = (r & 19) | ((r & 4) << 1) | ((r & 8) >> 1);
    const bf16_t* kbase = BK + ((size_t)b * SEQ + keyperm) * D + h * 256 + c * 128 + 64 * hh;
    const bf16_t* vbase = VTD + ((size_t)(b * D + h * 256 + r)) * SEQ + 8 * hh;
    for (int kt = 0; kt < ntile; ++kt) {
        const int s0 = 32 * kt;
        const bf16_t* kp = kbase + (size_t)s0 * D;
        f32x16 S;
#pragma unroll
        for (int i = 0; i < 16; ++i) S[i] = 0.f;
#pragma unroll
        for (int ks = 0; ks < 8; ++ks) { const bf16x8 kf = *(const bf16x8*)(kp + 8 * ks); S = __builtin_amdgcn_mfma_f32_32x32x16_bf16(kf, qf[ks], S, 0, 0, 0); }
        const float base = slope2 * (float)(s0 - tq) - M2;
        float pv[16];
        if (kt == ntile - 1) {
#pragma unroll
            for (int i = 0; i < 16; ++i) { const int key = s0 + (i & 3) + 4 * ((i >> 2) & 1) + 8 * hh + 16 * (i >> 3); const float e = __builtin_amdgcn_exp2f(S[i] + (base + ci[i])); pv[i] = (key <= tq) ? e : 0.f; }
        } else {
#pragma unroll
            for (int i = 0; i < 16; ++i) pv[i] = __builtin_amdgcn_exp2f(S[i] + (base + ci[i]));
        }
#pragma unroll
        for (int i = 0; i < 16; ++i) lsum += pv[i];
        bf16x8 pf[2];
#pragma unroll
        for (int k2 = 0; k2 < 2; ++k2) { u32x4 u; u.x = cvt_pk_bf16(pv[8 * k2 + 0], pv[8 * k2 + 1]); u.y = cvt_pk_bf16(pv[8 * k2 + 2], pv[8 * k2 + 3]); u.z = cvt_pk_bf16(pv[8 * k2 + 4], pv[8 * k2 + 5]); u.w = cvt_pk_bf16(pv[8 * k2 + 6], pv[8 * k2 + 7]);
            pf[k2] = __builtin_bit_cast(bf16x8, u); }
        const bf16_t* vp = vbase + s0;
#pragma unroll
        for (int db = 0; db < 8; ++db)
#pragma unroll
            for (int k2 = 0; k2 < 2; ++k2) { const bf16x8 vf = *(const bf16x8*)(vp + (size_t)(32 * db) * SEQ + 16 * k2); O[db] = __builtin_amdgcn_mfma_f32_32x32x16_bf16(vf, pf[k2], O[db], 0, 0, 0); }
    }
    const float ltot = lsum + __shfl_xor(lsum, 32);
    const float inv = 1.f / ltot;
    __syncthreads();
    if (c == 1) {
#pragma unroll
        for (int db = 0; db < 8; ++db)
#pragma unroll
            for (int i = 0; i < 16; ++i) { const int dv = 32 * db + (i & 3) + 8 * (i >> 2) + 4 * hh; cmb[(g * 256 + dv) * 32 + r] = O[db][i] * inv; }
    }
    __syncthreads();
    if (c == 0) {
        float ss = 0.f;
#pragma unroll
        for (int db = 0; db < 8; ++db)
#pragma unroll
            for (int i = 0; i < 16; ++i) { const int dv = 32 * db + (i & 3) + 8 * (i >> 2) + 4 * hh; const float o = O[db][i] * inv - lam * cmb[(g * 256 + dv) * 32 + r]; O[db][i] = o; ss += o * o; }
        ss += __shfl_xor(ss, 32);
        const float rinv = rsqrtf(ss * (1.f / 256.f) + EPS) * 0.8f;
#pragma unroll
        for (int db = 0; db < 8; ++db)
#pragma unroll
            for (int ig = 0; ig < 4; ++ig) {
                const int dv0 = 32 * db + 8 * ig + 4 * hh; const size_t off = rowq * D + h * 256 + dv0;
                const u32x2 gbu = *(const u32x2*)(GB + off); const f32x4 sg = *(const f32x4*)(p.subln_g + dv0);
                u32x2 o; o.x = cvt_pk_bf16(O[db][4 * ig + 0] * rinv * sg.x * bflo(gbu.x), O[db][4 * ig + 1] * rinv * sg.y * bfhi(gbu.x));
                o.y = cvt_pk_bf16(O[db][4 * ig + 2] * rinv * sg.z * bflo(gbu.y), O[db][4 * ig + 3] * rinv * sg.w * bfhi(gbu.y));
                *(u32x2*)(BQ + off) = o;
            }
    }
}

__device__ __forceinline__ void phase2b(const Params& p, unsigned char* shm) {
    const int tid = threadIdx.x, lane = tid & 63;
    if (blockIdx.x < 128) mlstm_item(p, shm, blockIdx.x);
    float lam, M2;
    { const float a0 = p.diff_lambda[lane] * p.diff_lambda[128 + lane] + p.diff_lambda[64 + lane] * p.diff_lambda[192 + lane];
      const float a1 = p.diff_lambda[256 + lane] * p.diff_lambda[384 + lane] + p.diff_lambda[320 + lane] * p.diff_lambda[448 + lane];
      lam = expf(wave_sum(a0)) - expf(wave_sum(a1)) + 0.2f;
      float mq = fmaxf(fabsf(p.q_norm_g[lane]), fabsf(p.q_norm_g[64 + lane])), mk = fmaxf(fabsf(p.k_norm_g[lane]), fabsf(p.k_norm_g[64 + lane]));
#pragma unroll
      for (int o = 1; o < 64; o <<= 1) { mq = fmaxf(mq, __shfl_xor(mq, o)); mk = fmaxf(mk, __shfl_xor(mk, o)); }
      M2 = 128.f * mq * mk * 0.08838834764831845f * LOG2E * 1.02f; }
    unsigned* ctr = (unsigned*)(p.ws + WS_CTL);
    int* sItem = (int*)(shm + 147456 - 64);
    for (;;) {
        __syncthreads();
        if (tid == 0) *sItem = (int)atomicAdd(ctr, 1u);
        __syncthreads();
        const int item = *sItem;
        if (item >= 2048) break;
        attn_item(p, shm, item, lam, M2);
    }
}

__device__ __forceinline__ void phase3(const Params& p, unsigned char* shm) {
    const int tid = threadIdx.x, lane = tid & 63, wave = tid >> 6, gw = blockIdx.x * 8 + wave, ngw = gridDim.x * 8;
    float* scr = (float*)(shm + wave * 8448);
    transpose_plain(p.w_out, D, D, (bf16_t*)(p.ws + WS_WOUT), scr, gw, ngw, lane);
    transpose_plain(p.w_up, D, 2 * DFF, (bf16_t*)(p.ws + WS_WUP), scr, gw, ngw, lane);
    transpose_plain(p.w_down, DFF, D, (bf16_t*)(p.ws + WS_WDN), scr, gw, ngw, lane);
    const bf16_t* HM = (const bf16_t*)(p.ws + WS_HM); const bf16_t* GA = (const bf16_t*)(p.ws + WS_GA); bf16_t* Y = (bf16_t*)(p.ws + WS_BQ);
    for (int it = gw; it < T * 4; it += ngw) {
        const size_t off = (size_t)(it >> 2) * D + (it & 3) * 512 + 8 * lane;
        float hm[8], ga[8], yb[8]; unpack8(*(const u32x4*)(HM + off), hm); unpack8(*(const u32x4*)(GA + off), ga); unpack8(*(const u32x4*)(Y + off), yb);
        float ss = 0.f;
#pragma unroll
        for (int e = 0; e < 8; ++e) ss += hm[e] * hm[e];
        const float rinv = rsqrtf(wave_sum(ss) * (1.f / 512.f) + EPS);
        const f32x4 g0 = *(const f32x4*)(p.mlstm_norm_g + (it & 3) * 512 + 8 * lane), g1 = *(const f32x4*)(p.mlstm_norm_g + (it & 3) * 512 + 8 * lane + 4);
        float y[8];
        y[0] = ga[0] * hm[0] * rinv * g0.x + yb[0]; y[1] = ga[1] * hm[1] * rinv * g0.y + yb[1]; y[2] = ga[2] * hm[2] * rinv * g0.z + yb[2]; y[3] = ga[3] * hm[3] * rinv * g0.w + yb[3];
        y[4] = ga[4] * hm[4] * rinv * g1.x + yb[4]; y[5] = ga[5] * hm[5] * rinv * g1.y + yb[5]; y[6] = ga[6] * hm[6] * rinv * g1.z + yb[6]; y[7] = ga[7] * hm[7] * rinv * g1.w + yb[7];
        *(u32x4*)(Y + off) = pack8(y);
    }
}
__device__ __forceinline__ void phase5(const Params& p) {
    const int tid = threadIdx.x, lane = tid & 63, wave = tid >> 6, gw = blockIdx.x * 8 + wave, ngw = gridDim.x * 8;
    bf16_t* H2 = (bf16_t*)(p.ws + WS_H2);
    for (int row = gw; row < T; row += ngw) {
        const f32x4* xr = (const f32x4*)(p.out + (size_t)row * D) + lane;
        f32x4 v[8]; float ss = 0.f;
#pragma unroll
        for (int j = 0; j < 8; ++j) { v[j] = xr[64 * j]; ss += (v[j].x * v[j].x + v[j].y * v[j].y) + (v[j].z * v[j].z + v[j].w * v[j].w); }
        const float rinv = rsqrtf(wave_sum(ss) * (1.f / D) + EPS);
        u32x2* o8 = (u32x2*)(H2 + (size_t)row * D) + lane;
#pragma unroll
        for (int j = 0; j < 8; ++j) { const f32x4 g = *((const f32x4*)p.norm2_g + lane + 64 * j);
            u32x2 o; o.x = cvt_pk_bf16(v[j].x * rinv * g.x, v[j].y * rinv * g.y); o.y = cvt_pk_bf16(v[j].z * rinv * g.z, v[j].w * rinv * g.w); o8[64 * j] = o; }
    }
}
__device__ __forceinline__ void phase7(const Params& p, int half) {
    const bf16_t* UP = (const bf16_t*)(p.ws + WS_UP); bf16_t* ACT = (bf16_t*)(p.ws + WS_ACT);
    const int gt = blockIdx.x * 512 + threadIdx.x, ngt = gridDim.x * 512;
    for (int idx = gt; idx < (TH / 16) * 704; idx += ngt) {
        const int oct = idx % 704, rb = idx / 704, c0 = 8 * oct, r0 = 16 * rb;
        float wg[3][8], wv[3][8], bg[8], bv[8];
#pragma unroll
        for (int j = 0; j < 3; ++j) {
            const f32x4 a = *(const f32x4*)(p.ffn_conv_w + (size_t)j * 2 * DFF + c0), b = *(const f32x4*)(p.ffn_conv_w + (size_t)j * 2 * DFF + c0 + 4);
            const f32x4 c = *(const f32x4*)(p.ffn_conv_w + (size_t)j * 2 * DFF + DFF + c0), d = *(const f32x4*)(p.ffn_conv_w + (size_t)j * 2 * DFF + DFF + c0 + 4);
            wg[j][0] = a.x; wg[j][1] = a.y; wg[j][2] = a.z; wg[j][3] = a.w; wg[j][4] = b.x; wg[j][5] = b.y; wg[j][6] = b.z; wg[j][7] = b.w;
            wv[j][0] = c.x; wv[j][1] = c.y; wv[j][2] = c.z; wv[j][3] = c.w; wv[j][4] = d.x; wv[j][5] = d.y; wv[j][6] = d.z; wv[j][7] = d.w;
        }
        { const f32x4 a = *(const f32x4*)(p.ffn_conv_b + c0), b = *(const f32x4*)(p.ffn_conv_b + c0 + 4), c = *(const f32x4*)(p.ffn_conv_b + DFF + c0), d = *(const f32x4*)(p.ffn_conv_b + DFF + c0 + 4);
          bg[0] = a.x; bg[1] = a.y; bg[2] = a.z; bg[3] = a.w; bg[4] = b.x; bg[5] = b.y; bg[6] = b.z; bg[7] = b.w; bv[0] = c.x; bv[1] = c.y; bv[2] = c.z; bv[3] = c.w; bv[4] = d.x; bv[5] = d.y; bv[6] = d.z; bv[7] = d.w; }
        float g2[8], g1[8], v2[8], v1[8];
        const bool has_prev = ((half * TH + r0) & (SEQ - 1)) != 0;
        if (has_prev) {
            unpack8(*(const u32x4*)(UP + (size_t)(r0 - 2) * (2 * DFF) + c0), g2); unpack8(*(const u32x4*)(UP + (size_t)(r0 - 1) * (2 * DFF) + c0), g1);
            unpack8(*(const u32x4*)(UP + (size_t)(r0 - 2) * (2 * DFF) + DFF + c0), v2); unpack8(*(const u32x4*)(UP + (size_t)(r0 - 1) * (2 * DFF) + DFF + c0), v1);
        } else {
#pragma unroll
            for (int e = 0; e < 8; ++e) { g2[e] = 0.f; g1[e] = 0.f; v2[e] = 0.f; v1[e] = 0.f; }
        }
#pragma unroll 4
        for (int rr = 0; rr < 16; ++rr) {
            float g0[8], v0[8], y[8];
            unpack8(*(const u32x4*)(UP + (size_t)(r0 + rr) * (2 * DFF) + c0), g0); unpack8(*(const u32x4*)(UP + (size_t)(r0 + rr) * (2 * DFF) + DFF + c0), v0);
#pragma unroll
            for (int e = 0; e < 8; ++e) {
                const float ug = bg[e] + wg[0][e] * g2[e] + wg[1][e] * g1[e] + wg[2][e] * g0[e];
                const float uv = bv[e] + wv[0][e] * v2[e] + wv[1][e] * v1[e] + wv[2][e] * v0[e];
                y[e] = ug * fsig(ug) * uv; g2[e] = g1[e]; g1[e] = g0[e]; v2[e] = v1[e]; v1[e] = v0[e];
            }
            *(u32x4*)(ACT + (size_t)(r0 + rr) * DFF + c0) = pack8(y);
        }
    }
}

__global__ void __launch_bounds__(512, 2) mega(Params p) {
    extern __shared__ __attribute__((aligned(16))) unsigned char shm[];
    cg::grid_group grid = cg::this_grid();
    bf16_t* H = (bf16_t*)((unsigned char*)p.out + DO_H); bf16_t* WinT = (bf16_t*)((unsigned char*)p.out + DO_WIN);
    bf16_t* H2 = (bf16_t*)(p.ws + WS_H2); bf16_t* UPb = (bf16_t*)(p.ws + WS_UP); bf16_t* ACTb = (bf16_t*)(p.ws + WS_ACT);
    const bf16_t* WoT = (const bf16_t*)(p.ws + WS_WOUT); const bf16_t* WuT = (const bf16_t*)(p.ws + WS_WUP); const bf16_t* WdT = (const bf16_t*)(p.ws + WS_WDN);
#define PH(i) (p.ph_lo <= (i) && (i) < p.ph_hi)
#define SYNC(i) do { if (p.ph_lo <= (i) && (i) + 1 < p.ph_hi) grid.sync(); } while (0)
    if (PH(0)) phase0(p, shm);
    SYNC(0);
    if (PH(1)) { Epi1 E{(bf16_t*)(p.ws + WS_AQK), (bf16_t*)(p.ws + WS_VTM), (bf16_t*)(p.ws + WS_GA), (bf16_t*)(p.ws + WS_BQ), (bf16_t*)(p.ws + WS_BK), (bf16_t*)(p.ws + WS_VTD), (bf16_t*)(p.ws + WS_GB)};
        run_gemm(shm, H, WinT, T, 16384, D, E); }
    SYNC(1);
    if (PH(2)) phase2a(p, shm);
    SYNC(2);
    if (PH(3)) phase2b(p, shm);
    SYNC(3);
    if (PH(4)) phase3(p, shm);
    SYNC(4);
    if (PH(5)) { EpiRes E{p.out, p.x, D}; run_gemm(shm, (const bf16_t*)(p.ws + WS_BQ), WoT, T, D, D, E); }
    SYNC(5);
    if (PH(6)) phase5(p);
    SYNC(6);
    if (PH(7)) { EpiB E{UPb, 2 * DFF}; run_gemm(shm, H2, WuT, TH, 2 * DFF, D, E); }
    SYNC(7);
    if (PH(8)) phase7(p, 0);
    SYNC(8);
    if (PH(9)) { { EpiRes E{p.out, p.out, D}; run_gemm(shm, ACTb, WdT, TH, D, DFF, E); }
                 { EpiB E{UPb, 2 * DFF}; run_gemm(shm, H2 + (size_t)TH * D, WuT, TH, 2 * DFF, D, E); } }
    SYNC(9);
    if (PH(10)) phase7(p, 1);
    SYNC(10);
    if (PH(11)) { EpiRes E{p.out + (size_t)TH * D, p.out + (size_t)TH * D, D}; run_gemm(shm, ACTb, WdT, TH, D, DFF, E); }
#undef PH
#undef SYNC
}

#ifndef N_LAUNCHES
#define N_LAUNCHES 1
#endif
extern "C" void kernel_launch(void* const* d_in, const int* in_sizes, int n_in, void* d_out, int out_size, void* d_ws, size_t ws_size, hipStream_t stream) {
    static int grid = 0;
    if (grid == 0) {
        if (n_in != 17 || out_size != T * D || ws_size < WS_END) { fprintf(stderr, "kernel_launch: unexpected problem (n_in %d, out %d, ws %zu)\n", n_in, out_size, ws_size); grid = -1; return; }
        int dev = 0, cus = 0, per_cu = 0;
        if (hipGetDevice(&dev) != hipSuccess || hipDeviceGetAttribute(&cus, hipDeviceAttributeMultiprocessorCount, dev) != hipSuccess) { grid = -1; return; }
        if (hipFuncSetAttribute((const void*)mega, hipFuncAttributeMaxDynamicSharedMemorySize, LDS_BYTES) != hipSuccess) { fprintf(stderr, "kernel_launch: hipFuncSetAttribute failed\n"); grid = -1; return; }
        if (hipOccupancyMaxActiveBlocksPerMultiprocessor(&per_cu, (const void*)mega, 512, LDS_BYTES) != hipSuccess || per_cu < 1) { fprintf(stderr, "kernel_launch: occupancy query says %d\n", per_cu); per_cu = 1; }
        (void)hipGetLastError();
        grid = cus * per_cu;
    }
    if (grid < 0) return;
    if (hipMemsetAsync((char*)d_ws + WS_CTL, 0, 4096, stream) != hipSuccess) { fprintf(stderr, "kernel_launch: memset failed\n"); return; }
    Params p{};
    const float** pp = (const float**)&p;
    for (int i = 0; i < 17; ++i) pp[i] = (const float*)d_in[i];
    p.out = (float*)d_out; p.ws = (unsigned char*)d_ws;
    constexpr int NPH = 12;
    for (int li = 0; li < N_LAUNCHES; ++li) {
        p.ph_lo = (N_LAUNCHES == 1) ? 0 : li; p.ph_hi = (N_LAUNCHES == 1) ? NPH : li + 1;
        void* args[] = {&p};
        hipError_t e = hipLaunchCooperativeKernel((const void*)mega, dim3(grid), dim3(512), args, LDS_BYTES, stream);
        if (e != hipSuccess) { fprintf(stderr, "cooperative launch failed: %s (grid %d)\n", hipGetErrorString(e), grid); break; }
    }
}
```

```cpp
#include <hip/hip_runtime.h>
#include <hip/hip_cooperative_groups.h>
#include <cstdio>
#include <cstdint>
namespace cg = cooperative_groups;
namespace pg8 {
#define PG8_LAS __attribute__((address_space(3)))
typedef unsigned short bf16_t;
typedef short bf16x8 __attribute__((ext_vector_type(8)));
typedef float f32x4 __attribute__((ext_vector_type(4)));
typedef unsigned u32x4 __attribute__((ext_vector_type(4)));
constexpr int BM = 256, BK = 64, HALF = 128, HTB = HALF * BK * 2  , STAGE_BYTES = 8 * HTB, NXCD = 8, WGM = 8;

__host__ __device__ __forceinline__ int lds_byte(int r, int c) { const int st = (r >> 4) * 2 + (c >> 5), rr = r & 15, cc = c & 31, ob = rr * 64 + cc * 2; return st * 1024 + (ob ^ (((ob >> 9) & 1) << 5)); }
__host__ __device__ __forceinline__ void stage_rc(int b, int& R, int& C) { const int st = b / 1024, sb = b % 1024, swz = sb ^ (((sb >> 9) & 1) << 5); R = (st >> 1) * 16 + swz / 64; C = (st & 1) * 32 + (swz % 64) / 2; }
__host__ __device__ __forceinline__ int perm32(int rho) { const int n = rho >> 4, i = rho & 15; return 8 * (i >> 2) + 4 * n + (i & 3); }

struct Unit { int pm, pn; };
struct Gemm { const bf16_t* A; const bf16_t* Bt; int M, N, K; };

struct StaticOrder {
    int nM, nN, nwg, G, c;
    __host__ __device__ void init(int M, int N, int G_, int c_) { nM = M / BM; nN = N / BM; nwg = nM * nN; G = G_; c = c_; }
    __host__ __device__ bool next(int i, Unit& u) const {
        const long L = (long)i * G + c; if (L >= nwg) return false;
        int wgid = (int)L; { const int q = nwg / NXCD, r = nwg % NXCD, xcd = wgid % NXCD, off = wgid / NXCD; wgid = (xcd < r ? xcd * (q + 1) : r * (q + 1) + (xcd - r) * q) + off; }
        const int nig = WGM * nN, gid = wgid / nig, fm = gid * WGM, gsz = (nM - fm) < WGM ? (nM - fm) : WGM;
        u.pm = fm + ((wgid % nig) % gsz); u.pn = (wgid % nig) / gsz; return true;
    }
    __device__ __forceinline__ void a_ready(const Unit&) const {}
    __device__ __forceinline__ void done(const Unit&) const {}
};
__device__ __forceinline__ unsigned cvt_pk_bf16(float lo, float hi) { unsigned r; asm volatile("v_cvt_pk_bf16_f32 %0, %1, %2" : "=v"(r) : "v"(lo), "v"(hi)); return r; }
template <class Epi, class Sched, bool STAMP = false>
__device__ __forceinline__ void gemm_phase(PG8_LAS unsigned char* lds, const Gemm g, const Sched& S, const Epi& E, unsigned long long* stamps) {
    const int tid = threadIdx.x, wid = __builtin_amdgcn_readfirstlane(tid >> 6), lane = tid & 63, wr = wid >> 2, wc = wid & 3, fr = lane & 15, fq = lane >> 4;
    const int K = g.K, nt = K / BK;
    int ts_lo = 0, ts_hi = 0, nts = 0; const unsigned long long rt_entry = STAMP ? (unsigned long long)wall_clock64() : 0ull;
#define PG8_STAMP() do { if (STAMP && wid == 0 && nts < 64) { const unsigned long long _c = (unsigned long long)clock64(); \
        ts_lo = (lane == nts) ? (int)(unsigned)_c : ts_lo; ts_hi = (lane == nts) ? (int)(unsigned)(_c >> 32) : ts_hi; ++nts; } } while (0)
    PG8_STAMP();
    unsigned voffA[2], voffB[2];
#pragma unroll
    for (int i = 0; i < 2; ++i) { int R, C; stage_rc(tid * 16 + i * 8192, R, C); const int Rb = Epi::PERM ? ((R & ~31) + perm32(R & 31)) : R;
        voffA[i] = (unsigned)(R * K + C) * 2u; voffB[i] = (unsigned)(Rb * K + C) * 2u; }
    const size_t kstep = (size_t)(BK * 2);
    const size_t hstep = (size_t)HALF * K * 2;
    const size_t tstep = 2 * hstep;
    const unsigned ldsw = (unsigned)wid * 1024u;
    const int aoff = lds_byte(wr * 64 + fr, fq * 8), boff = lds_byte(wc * 32 + fr, fq * 8);
#define PG8_SA(b, h) (((b) * 2 + (h)) * HTB)
#define PG8_SB(b, h) ((4 + (b) * 2 + (h)) * HTB)
#define PG8_STAGE(bufoff, gbase, voff) do { _Pragma("unroll") for (int _i = 0; _i < 2; ++_i) \
        __builtin_amdgcn_global_load_lds((const unsigned*)((const char*)(gbase) + (voff)[_i]), (PG8_LAS unsigned*)(lds + (bufoff) + ldsw + _i * 8192), 16, 0, 0); } while (0)
#define PG8_LDA(dst, b, h) do { _Pragma("unroll") for (int m = 0; m < 4; ++m) _Pragma("unroll") for (int k = 0; k < 2; ++k) dst[m][k] = *(const PG8_LAS bf16x8*)(lds + PG8_SA(b, h) + aoff + m * 2048 + k * 1024); } while (0)
#define PG8_LDB(dst, b, h) do { _Pragma("unroll") for (int n = 0; n < 2; ++n) _Pragma("unroll") for (int k = 0; k < 2; ++k) dst[n][k] = *(const PG8_LAS bf16x8*)(lds + PG8_SB(b, h) + boff + n * 2048 + k * 1024); } while (0)
#define PG8_MMA(ai, bj, At, Bt) do { __builtin_amdgcn_s_setprio(1); _Pragma("unroll") for (int m = 0; m < 4; ++m) _Pragma("unroll") for (int n = 0; n < 2; ++n) _Pragma("unroll") for (int k = 0; k < 2; ++k) \
        acc[ai][bj][m][n] = __builtin_amdgcn_mfma_f32_16x16x32_bf16(Bt[n][k], At[m][k], acc[ai][bj][m][n], 0, 0, 0); __builtin_amdgcn_s_setprio(0); } while (0)
#define PG8_WAIT_V(n) asm volatile("s_waitcnt vmcnt(" #n ")" ::: "memory")
#define PG8_WAIT_L(n) asm volatile("s_waitcnt lgkmcnt(" #n ")" ::: "memory")
#define PG8_BAR __builtin_amdgcn_s_barrier()
#define PG8_SCHED __builtin_amdgcn_sched_barrier(0)
    Unit cur, nxt; int ui = 0;
    if (!S.next(0, cur)) return;
    f32x4 acc[2][2][4][2];
#pragma unroll
    for (int a = 0; a < 2; ++a)
#pragma unroll
        for (int b = 0; b < 2; ++b)
#pragma unroll
            for (int m = 0; m < 4; ++m)
#pragma unroll
                for (int n = 0; n < 2; ++n) acc[a][b][m][n] = (f32x4){0.f, 0.f, 0.f, 0.f};
    bf16x8 At[4][2], B0[2][2], B1[2][2];
    const char* cA = (const char*)g.A + (size_t)cur.pm * tstep; const char* cB = (const char*)g.Bt + (size_t)cur.pn * tstep;
    S.a_ready(cur);
    PG8_STAGE(PG8_SB(0, 0), cB, voffB); PG8_STAGE(PG8_SA(0, 0), cA, voffA); PG8_STAGE(PG8_SB(0, 1), cB + hstep, voffB); PG8_STAGE(PG8_SA(0, 1), cA + hstep, voffA);
    if (wr == 1) PG8_BAR;
    PG8_WAIT_V(4); PG8_BAR;
    PG8_STAGE(PG8_SB(1, 0), cB + kstep, voffB); PG8_STAGE(PG8_SA(1, 0), cA + kstep, voffA); PG8_STAGE(PG8_SB(1, 1), cB + hstep + kstep, voffB);
    PG8_WAIT_V(6); PG8_BAR;
    PG8_STAMP();
    for (;;) {
        const bool has_next = S.next(ui + 1, nxt);
        const char* nA = has_next ? (const char*)g.A + (size_t)nxt.pm * tstep : cA; const char* nB = has_next ? (const char*)g.Bt + (size_t)nxt.pn * tstep : cB;
        for (int t = 0; t < nt; t += 2) {
            const bool last = (t == nt - 2);
            const char* a1 = cA + (size_t)(t + 1) * kstep;
            const char* a2 = last ? nA : cA + (size_t)(t + 2) * kstep; const char* b2 = last ? nB : cB + (size_t)(t + 2) * kstep;
            const char* a3 = a2 + kstep; const char* b3 = b2 + kstep;
            if (last && has_next) S.a_ready(nxt);
            PG8_LDB(B0, 0, 0); PG8_SCHED; PG8_LDA(At, 0, 0); PG8_STAGE(PG8_SA(1, 1), a1 + hstep, voffA);
            PG8_WAIT_L(8); PG8_BAR; PG8_WAIT_L(0); PG8_MMA(0, 0, At, B0); PG8_BAR; PG8_SCHED;
            PG8_LDB(B1, 0, 1); PG8_STAGE(PG8_SB(0, 0), b2, voffB);
            PG8_BAR; PG8_WAIT_L(0); PG8_MMA(0, 1, At, B1); PG8_BAR;
            PG8_LDA(At, 0, 1); PG8_STAGE(PG8_SA(0, 0), a2, voffA);
            PG8_BAR; PG8_WAIT_L(0); PG8_MMA(1, 0, At, B0); PG8_BAR; PG8_SCHED;
            PG8_STAGE(PG8_SB(0, 1), b2 + hstep, voffB);
            PG8_WAIT_V(6); PG8_BAR; PG8_MMA(1, 1, At, B1); PG8_BAR;
            PG8_LDB(B0, 1, 0); PG8_SCHED; PG8_LDA(At, 1, 0); PG8_STAGE(PG8_SA(0, 1), a2 + hstep, voffA);
            PG8_WAIT_L(8); PG8_BAR; PG8_WAIT_L(0); PG8_MMA(0, 0, At, B0); PG8_BAR; PG8_SCHED;
            PG8_LDB(B1, 1, 1); PG8_STAGE(PG8_SB(1, 0), b3, voffB);
            PG8_BAR; PG8_WAIT_L(0); PG8_MMA(0, 1, At, B1); PG8_BAR;
            PG8_LDA(At, 1, 1); PG8_STAGE(PG8_SA(1, 0), a3, voffA);
            PG8_BAR; PG8_WAIT_L(0); PG8_MMA(1, 0, At, B0); PG8_BAR; PG8_SCHED;
            PG8_STAGE(PG8_SB(1, 1), b3 + hstep, voffB);
            PG8_WAIT_V(6); PG8_BAR; PG8_MMA(1, 1, At, B1); PG8_BAR;
        }
        PG8_STAMP();
        if constexpr (!Epi::AFTER_DRAIN) { E(acc, cur, wr, wc, fr, fq); S.done(cur); }
        PG8_STAMP();
        if (!has_next) break;
#pragma unroll
        for (int a = 0; a < 2; ++a)
#pragma unroll
            for (int b = 0; b < 2; ++b)
#pragma unroll
                for (int m = 0; m < 4; ++m)
#pragma unroll
                    for (int n = 0; n < 2; ++n) acc[a][b][m][n] = (f32x4){0.f, 0.f, 0.f, 0.f};
        cur = nxt; cA = nA; cB = nB; ++ui;
    }
    PG8_WAIT_V(0);
    if (wr == 0) PG8_BAR;
    PG8_BAR;
    if constexpr (Epi::AFTER_DRAIN) { E.fused(acc, cur, wr, wc, fr, fq, lds, wid, lane); S.done(cur); }
    PG8_STAMP();
    if (STAMP && wid == 0) { stamps[lane] = lane < nts ? (((unsigned long long)(unsigned)ts_hi << 32) | (unsigned)ts_lo) : 0ull;
        if (lane == 62) stamps[62] = rt_entry; if (lane == 63) stamps[63] = (unsigned long long)wall_clock64(); }
#undef PG8_STAMP
#undef PG8_SA
#undef PG8_SB
#undef PG8_STAGE
#undef PG8_LDA
#undef PG8_LDB
#undef PG8_MMA
#undef PG8_WAIT_V
#undef PG8_WAIT_L
#undef PG8_BAR
#undef PG8_SCHED
}
}
using pg8::bf16_t; using pg8::bf16x8; using pg8::f32x4; using pg8::u32x4; using pg8::cvt_pk_bf16;
typedef unsigned u32x2 __attribute__((ext_vector_type(2)));
typedef float f32x16 __attribute__((ext_vector_type(16)));

constexpr int T = 32768, D = 2048, SEQ = 8192, PIN = 16392, DFF = 5632, TH = 16384;
constexpr float EPS = 1e-6f, LOG2E = 1.4426950408889634f;
constexpr size_t MiB = (size_t)1 << 20;
constexpr size_t WS_CTL = 0, WS_GIF = 1 * MiB, WS_KT = 2 * MiB, WS_AQK = 66 * MiB, WS_VTM = 194 * MiB, WS_GA = 322 * MiB, WS_BQ = 450 * MiB, WS_BK = 578 * MiB,
                 WS_VTD = 706 * MiB, WS_GB = 834 * MiB, WS_END = 962 * MiB;
constexpr size_t WS_HM = WS_AQK, WS_H2 = WS_AQK, WS_WOUT = WS_VTM, WS_WUP = WS_VTM + 8 * MiB, WS_WDN = WS_VTM + 52 * MiB, WS_UP = WS_GA, WS_ACT = 674 * MiB;
constexpr size_t DO_H = 0, DO_Q2 = 0, DO_K2 = 64 * MiB, DO_WIN = 128 * MiB;
constexpr int LDS_BYTES = 147456;

struct Params {
    const float *x, *norm1_g, *w_in, *if_bias, *qk_conv_w, *qk_conv_b, *mlstm_norm_g, *q_norm_g, *k_norm_g, *diff_lambda, *subln_g, *w_out, *norm2_g, *w_up, *ffn_conv_w, *ffn_conv_b, *w_down;
    float* out; unsigned char* ws; int ph_lo, ph_hi;
};

__device__ __forceinline__ void lds_wait() { asm volatile("s_waitcnt lgkmcnt(0)" ::: "memory"); }
__device__ __forceinline__ float bflo(unsigned u) { return __uint_as_float(u << 16); }
__device__ __forceinline__ float bfhi(unsigned u) { return __uint_as_float(u & 0xffff0000u); }
__device__ __forceinline__ float fsig(float v) { return __builtin_amdgcn_rcpf(1.f + __expf(-v)); }
__device__ __forceinline__ float wave_sum(float v) {
#pragma unroll
    for (int o = 1; o < 64; o <<= 1) v += __shfl_xor(v, o);
    return v;
}
__device__ __forceinline__ void unpack8(u32x4 u, float (&f)[8]) {
    f[0] = bflo(u.x); f[1] = bfhi(u.x); f[2] = bflo(u.y); f[3] = bfhi(u.y); f[4] = bflo(u.z); f[5] = bfhi(u.z); f[6] = bflo(u.w); f[7] = bfhi(u.w);
}
__device__ __forceinline__ u32x4 pack8(const float (&f)[8]) {
    u32x4 o; o.x = cvt_pk_bf16(f[0], f[1]); o.y = cvt_pk_bf16(f[2], f[3]); o.z = cvt_pk_bf16(f[4], f[5]); o.w = cvt_pk_bf16(f[6], f[7]); return o;
}

__device__ __forceinline__ void transpose_item(const float* __restrict__ W, size_t ldw, int K, bf16_t* WT, int k0, int srcn0, int dstn0, float* scr, int lane) {
#pragma unroll 8
    for (int i = 0; i < 32; ++i) { const int kk = 2 * i + (lane >> 5); scr[kk * 33 + (lane & 31)] = W[(size_t)(k0 + kk) * ldw + srcn0 + (lane & 31)]; }
    lds_wait();
    const int c = lane & 7;
#pragma unroll
    for (int j = 0; j < 4; ++j) { const int n = (lane >> 3) + 8 * j; const float* s = scr + (8 * c) * 33 + n;
        u32x4 o; o.x = cvt_pk_bf16(s[0], s[33]); o.y = cvt_pk_bf16(s[66], s[99]); o.z = cvt_pk_bf16(s[132], s[165]); o.w = cvt_pk_bf16(s[198], s[231]);
        *(u32x4*)(WT + (size_t)(dstn0 + n) * K + k0 + 8 * c) = o; }
    lds_wait();
}
__device__ __forceinline__ int win_src(int n) {
    if (n < 4096) return n;
    if (n < 8192) { const int p = (n - 4096) >> 8, j = (n - 4096) & 255; return j < 128 ? 4096 + 128 * p + j : 12296 + 128 * p + (j - 128); }
    if (n < 10240) return 6152 + (n - 8192);
    if (n < 12288) return 8200 + (n - 10240);
    if (n < 14336) return 10248 + (n - 12288);
    return 14344 + (n - 14336);
}
__device__ __forceinline__ void transpose_plain(const float* W, int K, int N, bf16_t* WT, float* scr, int gw, int ngw, int lane) {
    const int nblk = N / 32, nitems = (K / 64) * nblk;
    for (int it = gw; it < nitems; it += ngw) { const int kb = it / nblk, nb = it % nblk; transpose_item(W, (size_t)N, K, WT, 64 * kb, 32 * nb, 32 * nb, scr, lane); }
}

__device__ __forceinline__ void phase0(const Params& p, unsigned char* shm) {
    const int tid = threadIdx.x, lane = tid & 63, wave = tid >> 6, gw = blockIdx.x * 8 + wave, ngw = gridDim.x * 8;
    float* scr = (float*)(shm + wave * 8448);
    bf16_t* WinT = (bf16_t*)((unsigned char*)p.out + DO_WIN);
    { const int nblk = 16384 / 32, nitems = (D / 64) * nblk;
      for (int it = gw; it < nitems; it += ngw) { const int kb = it / nblk, nb = it % nblk; transpose_item(p.w_in, (size_t)PIN, D, WinT, 64 * kb, win_src(32 * nb), 32 * nb, scr, lane); } }
    float* wifT = (float*)(shm + 69632);
    for (int idx = tid; idx < 8 * D; idx += 512) { const int k = idx >> 3, j = idx & 7; wifT[j * D + k] = p.w_in[(size_t)k * PIN + 6144 + j]; }
    __syncthreads();
    bf16_t* H = (bf16_t*)((unsigned char*)p.out + DO_H);
    float* GIF = (float*)(p.ws + WS_GIF);
    for (int row = gw; row < T; row += ngw) {
        const f32x4* xr = (const f32x4*)(p.x + (size_t)row * D) + lane;
        f32x4 v[8]; float ss = 0.f;
#pragma unroll
        for (int j = 0; j < 8; ++j) { v[j] = xr[64 * j]; ss += (v[j].x * v[j].x + v[j].y * v[j].y) + (v[j].z * v[j].z + v[j].w * v[j].w); }
        const float rinv = rsqrtf(wave_sum(ss) * (1.f / D) + EPS);
        float ga[8];
#pragma unroll
        for (int j = 0; j < 8; ++j) ga[j] = 0.f;
        u32x2* o8 = (u32x2*)(H + (size_t)row * D) + lane;
#pragma unroll
        for (int j = 0; j < 8; ++j) {
            const f32x4 g = *((const f32x4*)p.norm1_g + lane + 64 * j);
            f32x4 h; h.x = v[j].x * rinv * g.x; h.y = v[j].y * rinv * g.y; h.z = v[j].z * rinv * g.z; h.w = v[j].w * rinv * g.w;
            u32x2 o; o.x = cvt_pk_bf16(h.x, h.y); o.y = cvt_pk_bf16(h.z, h.w); o8[64 * j] = o;
#pragma unroll
            for (int q = 0; q < 8; ++q) { const f32x4 w = *((const f32x4*)(wifT + q * D) + lane + 64 * j); ga[q] += (h.x * w.x + h.y * w.y) + (h.z * w.z + h.w * w.w); }
        }
#pragma unroll
        for (int q = 0; q < 8; ++q) ga[q] = wave_sum(ga[q]);
        if (lane < 8) {
            float val = 0.f;
#pragma unroll
            for (int q = 0; q < 8; ++q) val = (lane == q) ? ga[q] : val;
            val += p.if_bias[lane];
            if (lane >= 4) val = fminf(val, 0.f) - log1pf(expf(-fabsf(val)));
            GIF[(size_t)row * 8 + lane] = val;
        }
    }
}

struct Epi1 {
    static constexpr bool PERM = true, AFTER_DRAIN = false;
    bf16_t *aqk, *vtm, *ga, *bq, *bk, *vtd, *gb;
    __device__ __forceinline__ void operator()(const f32x4 (&acc)[2][2][4][2], const pg8::Unit& u, int wr, int wc, int fr, int fq) const {
        const int pn = u.pn, row0 = u.pm * 256 + wr * 64 + fr, cw = wc * 32 + 8 * fq;
        if (pn >= 16 && pn < 32) {
            const int cb = 128 * (pn - 16) + cw;
#pragma unroll
            for (int ai = 0; ai < 2; ++ai)
#pragma unroll
                for (int m = 0; m < 4; ++m) {
                    const size_t row = (size_t)(row0 + ai * 128 + m * 16);
                    float f[8];
#pragma unroll
                    for (int j = 0; j < 4; ++j) { f[j] = fsig(acc[ai][0][m][0][j]) * fsig(acc[ai][1][m][0][j]); f[4 + j] = fsig(acc[ai][0][m][1][j]) * fsig(acc[ai][1][m][1][j]); }
                    *(u32x4*)(ga + row * D + cb) = pack8(f);
                }
            return;
        }
        bf16_t* dst; int col0; int mode;
        if (pn < 8) { dst = aqk; col0 = 256 * pn; mode = 0; }
        else if (pn < 16) { dst = vtm; col0 = 256 * (pn - 8); mode = 1; }
        else if (pn < 40) { dst = bq; col0 = 256 * (pn - 32); mode = 0; }
        else if (pn < 48) { dst = bk; col0 = 256 * (pn - 40); mode = 0; }
        else if (pn < 56) { dst = vtd; col0 = 256 * (pn - 48); mode = 3; }
        else { dst = gb; col0 = 256 * (pn - 56); mode = 2; }
#pragma unroll
        for (int ai = 0; ai < 2; ++ai)
#pragma unroll
            for (int m = 0; m < 4; ++m) {
                const int row = row0 + ai * 128 + m * 16;
#pragma unroll
                for (int bj = 0; bj < 2; ++bj) {
                    const int col = col0 + bj * 128 + cw;
                    float f[8];
#pragma unroll
                    for (int j = 0; j < 4; ++j) { f[j] = acc[ai][bj][m][0][j]; f[4 + j] = acc[ai][bj][m][1][j]; }
                    if (mode == 2) {
#pragma unroll
                        for (int j = 0; j < 8; ++j) f[j] = fsig(f[j]);
                    }
                    const u32x4 w = pack8(f);
                    if (mode == 3) {
                        bf16_t* d = dst + (((size_t)((row >> 13) * 8 + (col >> 8)) * 256 + ((row & (SEQ - 1)) >> 5)) * 256 + (col & 255)) * 32 + (row & 31);
                        d[0] = (bf16_t)(w.x & 0xffff); d[32] = (bf16_t)(w.x >> 16); d[64] = (bf16_t)(w.y & 0xffff); d[96] = (bf16_t)(w.y >> 16);
                        d[128] = (bf16_t)(w.z & 0xffff); d[160] = (bf16_t)(w.z >> 16); d[192] = (bf16_t)(w.w & 0xffff); d[224] = (bf16_t)(w.w >> 16);
                    } else if (mode == 1) {
                        bf16_t* d = dst + ((size_t)((row >> 13) * D + col)) * SEQ + (row & (SEQ - 1));
                        d[0 * (size_t)SEQ] = (bf16_t)(w.x & 0xffff); d[1 * (size_t)SEQ] = (bf16_t)(w.x >> 16); d[2 * (size_t)SEQ] = (bf16_t)(w.y & 0xffff); d[3 * (size_t)SEQ] = (bf16_t)(w.y >> 16);
                        d[4 * (size_t)SEQ] = (bf16_t)(w.z & 0xffff); d[5 * (size_t)SEQ] = (bf16_t)(w.z >> 16); d[6 * (size_t)SEQ] = (bf16_t)(w.w & 0xffff); d[7 * (size_t)SEQ] = (bf16_t)(w.w >> 16);
                    } else {
                        *(u32x4*)(dst + (size_t)row * D + col) = w;
                    }
                }
            }
    }
};
struct EpiRes {
    static constexpr bool PERM = false, AFTER_DRAIN = false;
    float* C; const float* R; int ldc;
    __device__ __forceinline__ void operator()(const f32x4 (&acc)[2][2][4][2], const pg8::Unit& u, int wr, int wc, int fr, int fq) const {
        const int row0 = u.pm * 256 + wr * 64 + fr, col0 = u.pn * 256 + wc * 32 + 4 * fq;
#pragma unroll
        for (int ai = 0; ai < 2; ++ai)
#pragma unroll
            for (int m = 0; m < 4; ++m) {
                const size_t off = (size_t)(row0 + ai * 128 + m * 16) * ldc + col0;
#pragma unroll
                for (int bj = 0; bj < 2; ++bj)
#pragma unroll
                    for (int n = 0; n < 2; ++n) { const f32x4 r = *(const f32x4*)(R + off + bj * 128 + n * 16); *(f32x4*)(C + off + bj * 128 + n * 16) = acc[ai][bj][m][n] + r; }
            }
    }
};
struct EpiB {
    static constexpr bool PERM = true, AFTER_DRAIN = false;
    bf16_t* O; int ldc;
    __device__ __forceinline__ void operator()(const f32x4 (&acc)[2][2][4][2], const pg8::Unit& u, int wr, int wc, int fr, int fq) const {
        const int row0 = u.pm * 256 + wr * 64 + fr, col0 = u.pn * 256 + wc * 32 + 8 * fq;
#pragma unroll
        for (int ai = 0; ai < 2; ++ai)
#pragma unroll
            for (int m = 0; m < 4; ++m) {
                bf16_t* rowp = O + (size_t)(row0 + ai * 128 + m * 16) * ldc + col0;
#pragma unroll
                for (int bj = 0; bj < 2; ++bj) {
                    u32x4 w; w.x = cvt_pk_bf16(acc[ai][bj][m][0][0], acc[ai][bj][m][0][1]); w.y = cvt_pk_bf16(acc[ai][bj][m][0][2], acc[ai][bj][m][0][3]);
                    w.z = cvt_pk_bf16(acc[ai][bj][m][1][0], acc[ai][bj][m][1][1]); w.w = cvt_pk_bf16(acc[ai][bj][m][1][2], acc[ai][bj][m][1][3]);
                    *(u32x4*)(rowp + bj * 128) = w;
                }
            }
    }
};
template <class Epi> __device__ __forceinline__ void run_gemm(unsigned char* shm, const bf16_t* A, const bf16_t* Bt, int M, int N, int K, const Epi& E) {
    pg8::Gemm g{A, Bt, M, N, K};
    pg8::StaticOrder S; S.init(M, N, (int)gridDim.x, (int)blockIdx.x);
    pg8::gemm_phase<Epi, pg8::StaticOrder, false>((PG8_LAS unsigned char*)shm, g, S, E, nullptr);
}

__device__ __forceinline__ void phase2a(const Params& p, unsigned char* shm) {
    const int tid = threadIdx.x, lane = tid & 63, wave = tid >> 6;
    const bf16_t* AQK = (const bf16_t*)(p.ws + WS_AQK);
    bf16_t* Q2 = (bf16_t*)((unsigned char*)p.out + DO_Q2); bf16_t* K2 = (bf16_t*)((unsigned char*)p.out + DO_K2); bf16_t* KT = (bf16_t*)(p.ws + WS_KT);
    bf16_t* tl = (bf16_t*)shm;
    for (int item = blockIdx.x; item < 256 * 32; item += gridDim.x) {
        const int ch = item >> 5, cgp = item & 31, t0 = ch * 128, oct = tid & 7, rg = tid >> 3, c0 = 64 * cgp + 8 * oct;
        float w[4][8], bias[8];
#pragma unroll
        for (int j = 0; j < 4; ++j) { const f32x4 a = *(const f32x4*)(p.qk_conv_w + j * D + c0), b = *(const f32x4*)(p.qk_conv_w + j * D + c0 + 4);
            w[j][0] = a.x; w[j][1] = a.y; w[j][2] = a.z; w[j][3] = a.w; w[j][4] = b.x; w[j][5] = b.y; w[j][6] = b.z; w[j][7] = b.w; }
        { const f32x4 a = *(const f32x4*)(p.qk_conv_b + c0), b = *(const f32x4*)(p.qk_conv_b + c0 + 4);
          bias[0] = a.x; bias[1] = a.y; bias[2] = a.z; bias[3] = a.w; bias[4] = b.x; bias[5] = b.y; bias[6] = b.z; bias[7] = b.w; }
        float in[5][8];
        const int rl0 = 2 * rg;
#pragma unroll
        for (int k = 0; k < 5; ++k) {
            const int rl = rl0 - 3 + k; const int sp = (t0 & (SEQ - 1)) + rl;
            if (sp >= 0) { const u32x4 u = *(const u32x4*)(AQK + (size_t)(t0 + rl) * D + c0); unpack8(u, in[k]); }
            else {
#pragma unroll
                for (int e = 0; e < 8; ++e) in[k][e] = 0.f; }
        }
        const bool isq = cgp < 16;
#pragma unroll
        for (int rr = 0; rr < 2; ++rr) {
            float y[8];
#pragma unroll
            for (int e = 0; e < 8; ++e) { float a = bias[e]; a += w[0][e] * in[rr][e]; a += w[1][e] * in[rr + 1][e]; a += w[2][e] * in[rr + 2][e]; a += w[3][e] * in[rr + 3][e];
                a = a * fsig(a); y[e] = isq ? a * 0.0625f : a; }
            const u32x4 o = pack8(y);
            const size_t row = (size_t)(t0 + rl0 + rr);
            if (isq) *(u32x4*)(Q2 + row * 1024 + c0) = o;
            else {
                *(u32x4*)(K2 + row * 1024 + (c0 - 1024)) = o;
                bf16_t* tp = tl + (8 * oct) * 136 + rl0 + rr;
                tp[0 * 136] = (bf16_t)(o.x & 0xffff); tp[1 * 136] = (bf16_t)(o.x >> 16); tp[2 * 136] = (bf16_t)(o.y & 0xffff); tp[3 * 136] = (bf16_t)(o.y >> 16);
                tp[4 * 136] = (bf16_t)(o.z & 0xffff); tp[5 * 136] = (bf16_t)(o.z >> 16); tp[6 * 136] = (bf16_t)(o.w & 0xffff); tp[7 * 136] = (bf16_t)(o.w >> 16);
            }
        }
        if (!isq) {
            __syncthreads();
            const int col = tid >> 3, seg = tid & 7, kc = 64 * (cgp - 16) + col, hA = kc >> 8, d = kc & 255, b = t0 >> 13, s0 = t0 & (SEQ - 1);
            const u32x4 a0 = *(const u32x4*)(tl + col * 136 + 16 * seg), a1 = *(const u32x4*)(tl + col * 136 + 16 * seg + 8);
            bf16_t* dst = KT + ((size_t)((b * 4 + hA) * 256 + d)) * SEQ + s0 + 16 * seg;
            *(u32x4*)dst = a0; *(u32x4*)(dst + 8) = a1;
            __syncthreads();
        }
    }
    {
        bf16_t* BQ = (bf16_t*)(p.ws + WS_BQ); bf16_t* BK = (bf16_t*)(p.ws + WS_BK);
        const int e16 = lane & 15, sub = lane >> 4;
        const float qs = 0.08838834764831845f * LOG2E;
        const f32x4 gq0 = *(const f32x4*)(p.q_norm_g + 8 * e16), gq1 = *(const f32x4*)(p.q_norm_g + 8 * e16 + 4);
        const f32x4 gk0 = *(const f32x4*)(p.k_norm_g + 8 * e16), gk1 = *(const f32x4*)(p.k_norm_g + 8 * e16 + 4);
        const int gwv = blockIdx.x * 8 + wave, ngw = gridDim.x * 8;
        for (int it = gwv; it < T * 32 / 4; it += ngw) {
            const int gid = it * 4 + sub, t = gid >> 5, grp = gid & 31;
            const bool isq = grp < 16;
            bf16_t* ptr = (isq ? BQ : BK) + (size_t)t * D + 128 * (grp & 15) + 8 * e16;
            float f[8]; unpack8(*(const u32x4*)ptr, f);
            float ss = 0.f;
#pragma unroll
            for (int e = 0; e < 8; ++e) ss += f[e] * f[e];
            ss += __shfl_xor(ss, 1); ss += __shfl_xor(ss, 2); ss += __shfl_xor(ss, 4); ss += __shfl_xor(ss, 8);
            const float rinv = rsqrtf(ss * (1.f / 128.f) + EPS) * (isq ? qs : 1.f);
            const f32x4 g0 = isq ? gq0 : gk0, g1 = isq ? gq1 : gk1;
            f[0] *= rinv * g0.x; f[1] *= rinv * g0.y; f[2] *= rinv * g0.z; f[3] *= rinv * g0.w; f[4] *= rinv * g1.x; f[5] *= rinv * g1.y; f[6] *= rinv * g1.z; f[7] *= rinv * g1.w;
            *(u32x4*)ptr = pack8(f);
        }
    }
}

constexpr int ML_KL = 0, ML_CT = 67584, ML_VT = 101376, ML_A = 118784, ML_MM = 119296, ML_BB = 119808, ML_WS = 120320, ML_N = 120832, ML_MISC = 121856;
__device__ __forceinline__ void mlstm_item(const Params& p, unsigned char* shm, int item) {
    const int tid = threadIdx.x, lane = tid & 63, w = __builtin_amdgcn_readfirstlane(tid >> 6), l15 = lane & 15, qq = lane >> 4;
    const int sl = item & 7, hA = (item >> 3) & 3, b = item >> 5;
    const bf16_t* Q2 = (const bf16_t*)((const unsigned char*)p.out + DO_Q2); const bf16_t* K2 = (const bf16_t*)((const unsigned char*)p.out + DO_K2);
    const bf16_t* KT = (const bf16_t*)(p.ws + WS_KT); const bf16_t* VTM = (const bf16_t*)(p.ws + WS_VTM); const float* GIF = (const float*)(p.ws + WS_GIF);
    bf16_t* HM = (bf16_t*)(p.ws + WS_HM);
    float* sA = (float*)(shm + ML_A); float* sMM = (float*)(shm + ML_MM); float* sBB = (float*)(shm + ML_BB); float* sWS = (float*)(shm + ML_WS); float* sN = (float*)(shm + ML_N); float* sMisc = (float*)(shm + ML_MISC);
    f32x4 Cacc[2][4];
#pragma unroll
    for (int a = 0; a < 2; ++a)
#pragma unroll
        for (int c = 0; c < 4; ++c) Cacc[a][c] = (f32x4){0.f, 0.f, 0.f, 0.f};
    float n_reg = 0.f, m_st = 0.f;
    const bf16_t* ktrow0 = KT + ((size_t)((b * 4 + hA) * 256)) * SEQ;
    const bf16_t* vtrow0 = VTM + ((size_t)((b * 4 + hA) * 512 + 64 * sl)) * SEQ;
    for (int c = 0; c < 64; ++c) {
        const int s0 = 128 * c; const size_t t0 = (size_t)b * SEQ + s0;
        bf16x8 qf[8];
        { const bf16_t* qp = Q2 + (t0 + 16 * w + l15) * 1024 + hA * 256 + 64 * qq;
#pragma unroll
          for (int ks = 0; ks < 8; ++ks) qf[ks] = *(const bf16x8*)(qp + 8 * ks); }
        { const int row = tid >> 2, part = tid & 3; const bf16_t* src = K2 + (t0 + row) * 1024 + hA * 256 + part * 64; unsigned char* dst = shm + ML_KL + row * 528 + part * 128;
#pragma unroll
          for (int e = 0; e < 8; ++e) *(u32x4*)(dst + 16 * e) = *(const u32x4*)(src + 8 * e); }
        { const int dv = tid >> 3, part = tid & 7; const bf16_t* src = vtrow0 + (size_t)dv * SEQ + s0 + part * 16; unsigned char* dst = shm + ML_VT + dv * 272 + part * 32;
          *(u32x4*)dst = *(const u32x4*)src; *(u32x4*)(dst + 16) = *(const u32x4*)(src + 8); }
#pragma unroll
        for (int dkb = 0; dkb < 2; ++dkb)
#pragma unroll
            for (int dvb = 0; dvb < 4; ++dvb) {
                u32x2 o; o.x = cvt_pk_bf16(Cacc[dkb][dvb][0], Cacc[dkb][dvb][1]); o.y = cvt_pk_bf16(Cacc[dkb][dvb][2], Cacc[dkb][dvb][3]);
                *(u32x2*)(shm + ML_CT + (16 * dvb + l15) * 528 + (32 * w + 16 * dkb + 4 * qq) * 2) = o;
            }
        if ((tid & 1) == 0) sN[tid >> 1] = n_reg;
        if (w == 0) {
            const float li0 = GIF[(t0 + 2 * lane) * 8 + hA], li1 = GIF[(t0 + 2 * lane + 1) * 8 + hA], lf0 = GIF[(t0 + 2 * lane) * 8 + 4 + hA], lf1 = GIF[(t0 + 2 * lane + 1) * 8 + 4 + hA];
            float cs = lf0 + lf1;
#pragma unroll
            for (int o = 1; o < 64; o <<= 1) { const float v = __shfl_up(cs, o); if (lane >= o) cs += v; }
            const float b1 = cs, b0 = cs - lf1;
            const float a0 = li0 - b0, a1 = li1 - b1;
            float pmx = fmaxf(a0, a1);
#pragma unroll
            for (int o = 1; o < 64; o <<= 1) { const float v = __shfl_up(pmx, o); if (lane >= o) pmx = fmaxf(pmx, v); }
            float ex = __shfl_up(pmx, 1); if (lane == 0) ex = -3.0e38f;
            const float pm0 = fmaxf(ex, a0), pm1 = pmx;
            const float mm0 = fmaxf(pm0, m_st), mm1 = fmaxf(pm1, m_st);
            const float mml = __shfl(mm1, 63), bl = __shfl(b1, 63);
            sA[2 * lane] = a0; sA[2 * lane + 1] = a1; sMM[2 * lane] = mm0; sMM[2 * lane + 1] = mm1; sBB[2 * lane] = b0; sBB[2 * lane + 1] = b1;
            sWS[2 * lane] = __expf(a0 - mml); sWS[2 * lane + 1] = __expf(a1 - mml);
            if (lane == 0) { sMisc[0] = bl; sMisc[1] = mml; }
        }
        __syncthreads();
        const int tl = 16 * w + l15;
        const float mm_t = sMM[tl], b_t = sBB[tl], gi = __expf(m_st - mm_t);
        bf16x8 pf[4]; float den = 0.f;
#pragma unroll
        for (int a = 0; a < 4; ++a) {
            pf[a] = (bf16x8){0, 0, 0, 0, 0, 0, 0, 0};
            if (2 * a <= w) {
                float pv[8];
#pragma unroll
                for (int e = 0; e < 2; ++e) {
                    {
                        f32x4 S = (f32x4){0.f, 0.f, 0.f, 0.f};
                        const int krow = 32 * a + 8 * (l15 >> 2) + 4 * e + (l15 & 3);
                        const unsigned char* kp = shm + ML_KL + krow * 528 + 128 * qq;
#pragma unroll
                        for (int ks = 0; ks < 8; ++ks) { const bf16x8 kf = *(const bf16x8*)(kp + 16 * ks); S = __builtin_amdgcn_mfma_f32_16x16x32_bf16(kf, qf[ks], S, 0, 0, 0); }
                        const int key0 = 32 * a + 8 * qq + 4 * e;
                        const f32x4 av = *(const f32x4*)(sA + key0);
#pragma unroll
                        for (int i = 0; i < 4; ++i) { const float pw = (key0 + i <= tl) ? S[i] * __expf(av[i] - mm_t) : 0.f; pv[4 * e + i] = pw; den += pw; }
                    }
                }
                const u32x4 pk = pack8(pv);
                pf[a] = __builtin_bit_cast(bf16x8, pk);
            }
        }
        den += __shfl_xor(den, 16); den += __shfl_xor(den, 32);
        f32x4 num[4];
#pragma unroll
        for (int dvb = 0; dvb < 4; ++dvb) {
            f32x4 acc = (f32x4){0.f, 0.f, 0.f, 0.f};
            const unsigned char* cp = shm + ML_CT + (16 * dvb + l15) * 528 + 128 * qq;
#pragma unroll
            for (int ks = 0; ks < 8; ++ks) { const bf16x8 cf = *(const bf16x8*)(cp + 16 * ks); acc = __builtin_amdgcn_mfma_f32_16x16x32_bf16(cf, qf[ks], acc, 0, 0, 0); }
            num[dvb] = acc * gi;
        }
        float qn = 0.f;
#pragma unroll
        for (int ks = 0; ks < 8; ++ks) {
            float qv[8]; unpack8(__builtin_bit_cast(u32x4, qf[ks]), qv);
            const f32x4 n0 = *(const f32x4*)(sN + 64 * qq + 8 * ks), n1 = *(const f32x4*)(sN + 64 * qq + 8 * ks + 4);
            qn += (qv[0] * n0.x + qv[1] * n0.y) + (qv[2] * n0.z + qv[3] * n0.w) + (qv[4] * n1.x + qv[5] * n1.y) + (qv[6] * n1.z + qv[7] * n1.w);
        }
        qn += __shfl_xor(qn, 16); qn += __shfl_xor(qn, 32);
        den += gi * qn;
#pragma unroll
        for (int a = 0; a < 4; ++a) {
            if (2 * a <= w) {
#pragma unroll
                for (int dvb = 0; dvb < 4; ++dvb) {
                    const bf16x8 vf = *(const bf16x8*)(shm + ML_VT + (16 * dvb + l15) * 272 + (32 * a + 8 * qq) * 2);
                    num[dvb] = __builtin_amdgcn_mfma_f32_16x16x32_bf16(vf, pf[a], num[dvb], 0, 0, 0);
                }
            }
        }
        { const float dn = __builtin_amdgcn_rcpf(fmaxf(fabsf(den), __expf(-(b_t + mm_t))));
          bf16_t* hp = HM + (t0 + tl) * D + hA * 512 + 64 * sl + 4 * qq;
#pragma unroll
          for (int dvb = 0; dvb < 4; ++dvb) { u32x2 o; o.x = cvt_pk_bf16(num[dvb][0] * dn, num[dvb][1] * dn); o.y = cvt_pk_bf16(num[dvb][2] * dn, num[dvb][3] * dn); *(u32x2*)(hp + 16 * dvb) = o; } }
        const float b_last = sMisc[0], mm_last = sMisc[1], decay = __expf(m_st - mm_last);
#pragma unroll
        for (int dkb = 0; dkb < 2; ++dkb)
#pragma unroll
            for (int dvb = 0; dvb < 4; ++dvb) Cacc[dkb][dvb] = Cacc[dkb][dvb] * decay;
#pragma unroll
        for (int a = 0; a < 4; ++a) {
            const f32x4 w0 = *(const f32x4*)(sWS + 32 * a + 8 * qq), w1 = *(const f32x4*)(sWS + 32 * a + 8 * qq + 4);
            bf16x8 kt[2];
#pragma unroll
            for (int dkb = 0; dkb < 2; ++dkb) kt[dkb] = *(const bf16x8*)(ktrow0 + (size_t)(32 * w + 16 * dkb + l15) * SEQ + s0 + 32 * a + 8 * qq);
#pragma unroll
            for (int dvb = 0; dvb < 4; ++dvb) {
                float vv[8]; unpack8(*(const u32x4*)(shm + ML_VT + (16 * dvb + l15) * 272 + (32 * a + 8 * qq) * 2), vv);
                vv[0] *= w0.x; vv[1] *= w0.y; vv[2] *= w0.z; vv[3] *= w0.w; vv[4] *= w1.x; vv[5] *= w1.y; vv[6] *= w1.z; vv[7] *= w1.w;
                const bf16x8 wv = __builtin_bit_cast(bf16x8, pack8(vv));
#pragma unroll
                for (int dkb = 0; dkb < 2; ++dkb) Cacc[dkb][dvb] = __builtin_amdgcn_mfma_f32_16x16x32_bf16(kt[dkb], wv, Cacc[dkb][dvb], 0, 0, 0);
            }
        }
        { const int dk = tid >> 1, hf = tid & 1; const bf16_t* kr = ktrow0 + (size_t)dk * SEQ + s0 + 64 * hf; float acc = 0.f;
#pragma unroll
          for (int e = 0; e < 8; ++e) { float kv[8]; unpack8(*(const u32x4*)(kr + 8 * e), kv); const f32x4 w0 = *(const f32x4*)(sWS + 64 * hf + 8 * e), w1 = *(const f32x4*)(sWS + 64 * hf + 8 * e + 4);
              acc += (kv[0] * w0.x + kv[1] * w0.y) + (kv[2] * w0.z + kv[3] * w0.w) + (kv[4] * w1.x + kv[5] * w1.y) + (kv[6] * w1.z + kv[7] * w1.w); }
          acc += __shfl_xor(acc, 1);
          n_reg = decay * n_reg + acc; }
        m_st = b_last + mm_last;
        __syncthreads();
    }
}

constexpr int AT_V = 17408, AT_BUF = 37888;
__device__ __forceinline__ void attn_item(const Params& p, unsigned char* shm, int b, int h, int qb, float lam, float M2) {
    const int tid = threadIdx.x, lane = tid & 63, wave = __builtin_amdgcn_readfirstlane(tid >> 6), c = wave & 1, g = wave >> 1, r = lane & 31, hh = lane >> 5;
    bf16_t* BQ = (bf16_t*)(p.ws + WS_BQ); const bf16_t* BK = (const bf16_t*)(p.ws + WS_BK); const bf16_t* VTD = (const bf16_t*)(p.ws + WS_VTD); const bf16_t* GB = (const bf16_t*)(p.ws + WS_GB);
    float* cmb = (float*)shm;
    const int tq = qb * 128 + 32 * g + r; const size_t rowq = (size_t)b * SEQ + tq;
    bf16x8 qf[8];
    { const bf16_t* qp = BQ + rowq * D + h * 256 + c * 128 + 64 * hh;
#pragma unroll
      for (int ks = 0; ks < 8; ++ks) qf[ks] = *(const bf16x8*)(qp + 8 * ks); }
    f32x16 O[8];
#pragma unroll
    for (int db = 0; db < 8; ++db)
#pragma unroll
        for (int i = 0; i < 16; ++i) O[db][i] = 0.f;
    float lsum = 0.f;
    const float slope2 = exp2f(-(float)(h + 1)) * LOG2E;
    const int ntile_w = qb * 4 + g + 1, ntile = qb * 4 + 4;
    int kt0 = (int)ceilf(((float)(qb * 128 - 31) - (150.f + 2.f * M2) / slope2) * (1.f / 32.f)); kt0 = kt0 < 0 ? 0 : kt0;
    const int keyperm = (r & 19) | ((r & 4) << 1) | ((r & 8) >> 1);
    const bf16_t* ksrc = BK + ((size_t)b * SEQ + ((tid >> 4) & 31)) * D + h * 256 + 8 * (tid & 15);
    const bf16_t* vsrc = VTD + ((size_t)(b * 8 + h) * 256) * 8192 + (size_t)tid * 8;
    const int kdst = (((tid >> 4) & 31)) * 272 + 16 * (tid & 15);
    const int vdst = AT_V + (tid >> 2) * 80 + 16 * (tid & 3);
    const int kfo = (c * 32 + keyperm) * 272 + 128 * hh, vfo = AT_V + r * 80 + 16 * hh;
    u32x4 st0, st1, st2, st3;
    { const bf16_t* ks_ = ksrc + (size_t)(32 * kt0) * D; const bf16_t* vs_ = vsrc + (size_t)kt0 * 8192;
      st0 = *(const u32x4*)ks_; st1 = *(const u32x4*)(ks_ + 128); st2 = *(const u32x4*)vs_; st3 = *(const u32x4*)(vs_ + 4096); }
    __syncthreads();
    *(u32x4*)(shm + kdst) = st0; *(u32x4*)(shm + kdst + 32 * 272) = st1; *(u32x4*)(shm + vdst) = st2; *(u32x4*)(shm + vdst + 128 * 80) = st3;
    __syncthreads();
    for (int kt = kt0; kt < ntile; ++kt) {
        const int s0 = 32 * kt;
        unsigned char* buf = shm + ((kt - kt0) & 1) * AT_BUF;
        unsigned char* nbuf = shm + (((kt - kt0) & 1) ^ 1) * AT_BUF;
        const bool more = kt + 1 < ntile;
        if (more) { const bf16_t* ks_ = ksrc + (size_t)(s0 + 32) * D; const bf16_t* vs_ = vsrc + (size_t)(kt + 1) * 8192;
            st0 = *(const u32x4*)ks_; st1 = *(const u32x4*)(ks_ + 128); st2 = *(const u32x4*)vs_; st3 = *(const u32x4*)(vs_ + 4096); }
        if (kt < ntile_w) {
            f32x16 S;
#pragma unroll
            for (int i = 0; i < 16; ++i) S[i] = 0.f;
#pragma unroll
            for (int ks = 0; ks < 8; ++ks) { const bf16x8 kf = *(const bf16x8*)(buf + kfo + 16 * ks); S = __builtin_amdgcn_mfma_f32_32x32x16_bf16(kf, qf[ks], S, 0, 0, 0); }
            const float base = slope2 * (float)(s0 + 8 * hh - tq) - M2;
            float pv[16];
#pragma unroll
            for (int i = 0; i < 16; ++i) pv[i] = __builtin_amdgcn_exp2f(S[i] + fmaf(slope2, (float)((i & 3) + 4 * ((i >> 2) & 1) + 16 * (i >> 3)), base));
            if (kt == ntile_w - 1) {
#pragma unroll
                for (int i = 0; i < 16; ++i) { const int key = s0 + (i & 3) + 4 * ((i >> 2) & 1) + 8 * hh + 16 * (i >> 3); pv[i] = (key <= tq) ? pv[i] : 0.f; }
            }
#pragma unroll
            for (int i = 0; i < 16; ++i) lsum += pv[i];
            bf16x8 pf[2];
#pragma unroll
            for (int k2 = 0; k2 < 2; ++k2) { u32x4 u; u.x = cvt_pk_bf16(pv[8 * k2 + 0], pv[8 * k2 + 1]); u.y = cvt_pk_bf16(pv[8 * k2 + 2], pv[8 * k2 + 3]); u.z = cvt_pk_bf16(pv[8 * k2 + 4], pv[8 * k2 + 5]); u.w = cvt_pk_bf16(pv[8 * k2 + 6], pv[8 * k2 + 7]);
                pf[k2] = __builtin_bit_cast(bf16x8, u); }
#pragma unroll
            for (int db = 0; db < 8; ++db)
#pragma unroll
                for (int k2 = 0; k2 < 2; ++k2) { const bf16x8 vf = *(const bf16x8*)(buf + vfo + db * 32 * 80 + 32 * k2); O[db] = __builtin_amdgcn_mfma_f32_32x32x16_bf16(vf, pf[k2], O[db], 0, 0, 0); }
        }
        if (more) { *(u32x4*)(nbuf + kdst) = st0; *(u32x4*)(nbuf + kdst + 32 * 272) = st1; *(u32x4*)(nbuf + vdst) = st2; *(u32x4*)(nbuf + vdst + 128 * 80) = st3; }
        __syncthreads();
    }
    const float ltot = lsum + __shfl_xor(lsum, 32);
    const float inv = 1.f / ltot;
    if (c == 1) {
#pragma unroll
        for (int db = 0; db < 8; ++db)
#pragma unroll
            for (int i = 0; i < 16; ++i) { const int dv = 32 * db + (i & 3) + 8 * (i >> 2) + 4 * hh; cmb[(g * 256 + dv) * 32 + r] = O[db][i] * inv; }
    }
    __syncthreads();
    if (c == 0) {
        float ss = 0.f;
#pragma unroll
        for (int db = 0; db < 8; ++db)
#pragma unroll
            for (int i = 0; i < 16; ++i) { const int dv = 32 * db + (i & 3) + 8 * (i >> 2) + 4 * hh; const float o = O[db][i] * inv - lam * cmb[(g * 256 + dv) * 32 + r]; O[db][i] = o; ss += o * o; }
        ss += __shfl_xor(ss, 32);
        const float rinv = rsqrtf(ss * (1.f / 256.f) + EPS) * 0.8f;
#pragma unroll
        for (int db = 0; db < 8; ++db)
#pragma unroll
            for (int ig = 0; ig < 4; ++ig) {
                const int dv0 = 32 * db + 8 * ig + 4 * hh; const size_t off = rowq * D + h * 256 + dv0;
                const u32x2 gbu = *(const u32x2*)(GB + off); const f32x4 sg = *(const f32x4*)(p.subln_g + dv0);
                u32x2 o; o.x = cvt_pk_bf16(O[db][4 * ig + 0] * rinv * sg.x * bflo(gbu.x), O[db][4 * ig + 1] * rinv * sg.y * bfhi(gbu.x));
                o.y = cvt_pk_bf16(O[db][4 * ig + 2] * rinv * sg.z * bflo(gbu.y), O[db][4 * ig + 3] * rinv * sg.w * bfhi(gbu.y));
                *(u32x2*)(BQ + off) = o;
            }
    }
}

__device__ __forceinline__ void phase2b(const Params& p, unsigned char* shm) {
    const int tid = threadIdx.x, lane = tid & 63;
    if (blockIdx.x < 128) mlstm_item(p, shm, blockIdx.x);
    float lam, M2;
    { const float a0 = p.diff_lambda[lane] * p.diff_lambda[128 + lane] + p.diff_lambda[64 + lane] * p.diff_lambda[192 + lane];
      const float a1 = p.diff_lambda[256 + lane] * p.diff_lambda[384 + lane] + p.diff_lambda[320 + lane] * p.diff_lambda[448 + lane];
      lam = expf(wave_sum(a0)) - expf(wave_sum(a1)) + 0.2f;
      float mq = fmaxf(fabsf(p.q_norm_g[lane]), fabsf(p.q_norm_g[64 + lane])), mk = fmaxf(fabsf(p.k_norm_g[lane]), fabsf(p.k_norm_g[64 + lane]));
#pragma unroll
      for (int o = 1; o < 64; o <<= 1) { mq = fmaxf(mq, __shfl_xor(mq, o)); mk = fmaxf(mk, __shfl_xor(mk, o)); }
      M2 = 128.f * mq * mk * 0.08838834764831845f * LOG2E * 1.02f;
      lam = __uint_as_float(__builtin_amdgcn_readfirstlane(__float_as_uint(lam))); M2 = __uint_as_float(__builtin_amdgcn_readfirstlane(__float_as_uint(M2))); }
    unsigned* ctr = (unsigned*)(p.ws + WS_CTL);
    int* sItem = (int*)(shm + 147456 - 64);
    const int myx = blockIdx.x & 7;
    for (;;) {
        __syncthreads();
        if (tid == 0) { int it = -1;
            for (int k = 0; k < 8; ++k) { const int q = (myx + k) & 7; const unsigned v = atomicAdd(ctr + 16 * q, 1u); if (v < 256u) { it = q * 256 + (int)v; break; } }
            *sItem = it; }
        __syncthreads();
        const int item = *sItem;
        if (item < 0) break;
        const int q = item >> 8, v = item & 255, b = v >> 6, qb = 63 - (v & 63);
        const int h = (b == 0) ? q : (b == 1) ? 7 - q : (b == 2) ? ((q + 4) & 7) : ((3 - q) & 7);
        attn_item(p, shm, b, h, qb, lam, M2);
    }
}

__device__ __forceinline__ void phase3(const Params& p, unsigned char* shm) {
    const int tid = threadIdx.x, lane = tid & 63, wave = tid >> 6, gw = blockIdx.x * 8 + wave, ngw = gridDim.x * 8;
    float* scr = (float*)(shm + wave * 8448);
    transpose_plain(p.w_out, D, D, (bf16_t*)(p.ws + WS_WOUT), scr, gw, ngw, lane);
    transpose_plain(p.w_up, D, 2 * DFF, (bf16_t*)(p.ws + WS_WUP), scr, gw, ngw, lane);
    transpose_plain(p.w_down, DFF, D, (bf16_t*)(p.ws + WS_WDN), scr, gw, ngw, lane);
    const bf16_t* HM = (const bf16_t*)(p.ws + WS_HM); const bf16_t* GA = (const bf16_t*)(p.ws + WS_GA); bf16_t* Y = (bf16_t*)(p.ws + WS_BQ);
    for (int it = gw; it < T * 4; it += ngw) {
        const size_t off = (size_t)(it >> 2) * D + (it & 3) * 512 + 8 * lane;
        float hm[8], ga[8], yb[8]; unpack8(*(const u32x4*)(HM + off), hm); unpack8(*(const u32x4*)(GA + off), ga); unpack8(*(const u32x4*)(Y + off), yb);
        float ss = 0.f;
#pragma unroll
        for (int e = 0; e < 8; ++e) ss += hm[e] * hm[e];
        const float rinv = rsqrtf(wave_sum(ss) * (1.f / 512.f) + EPS);
        const f32x4 g0 = *(const f32x4*)(p.mlstm_norm_g + (it & 3) * 512 + 8 * lane), g1 = *(const f32x4*)(p.mlstm_norm_g + (it & 3) * 512 + 8 * lane + 4);
        float y[8];
        y[0] = ga[0] * hm[0] * rinv * g0.x + yb[0]; y[1] = ga[1] * hm[1] * rinv * g0.y + yb[1]; y[2] = ga[2] * hm[2] * rinv * g0.z + yb[2]; y[3] = ga[3] * hm[3] * rinv * g0.w + yb[3];
        y[4] = ga[4] * hm[4] * rinv * g1.x + yb[4]; y[5] = ga[5] * hm[5] * rinv * g1.y + yb[5]; y[6] = ga[6] * hm[6] * rinv * g1.z + yb[6]; y[7] = ga[7] * hm[7] * rinv * g1.w + yb[7];
        *(u32x4*)(Y + off) = pack8(y);
    }
}
__device__ __forceinline__ void phase5(const Params& p) {
    const int tid = threadIdx.x, lane = tid & 63, wave = tid >> 6, gw = blockIdx.x * 8 + wave, ngw = gridDim.x * 8;
    bf16_t* H2 = (bf16_t*)(p.ws + WS_H2);
    for (int row = gw; row < T; row += ngw) {
        const f32x4* xr = (const f32x4*)(p.out + (size_t)row * D) + lane;
        f32x4 v[8]; float ss = 0.f;
#pragma unroll
        for (int j = 0; j < 8; ++j) { v[j] = xr[64 * j]; ss += (v[j].x * v[j].x + v[j].y * v[j].y) + (v[j].z * v[j].z + v[j].w * v[j].w); }
        const float rinv = rsqrtf(wave_sum(ss) * (1.f / D) + EPS);
        u32x2* o8 = (u32x2*)(H2 + (size_t)row * D) + lane;
#pragma unroll
        for (int j = 0; j < 8; ++j) { const f32x4 g = *((const f32x4*)p.norm2_g + lane + 64 * j);
            u32x2 o; o.x = cvt_pk_bf16(v[j].x * rinv * g.x, v[j].y * rinv * g.y); o.y = cvt_pk_bf16(v[j].z * rinv * g.z, v[j].w * rinv * g.w); o8[64 * j] = o; }
    }
}
__device__ __forceinline__ void phase7(const Params& p, int half) {
    const bf16_t* UP = (const bf16_t*)(p.ws + WS_UP); bf16_t* ACT = (bf16_t*)(p.ws + WS_ACT);
    const int gt = blockIdx.x * 512 + threadIdx.x, ngt = gridDim.x * 512;
    for (int idx = gt; idx < (TH / 16) * 704; idx += ngt) {
        const int oct = idx % 704, rb = idx / 704, c0 = 8 * oct, r0 = 16 * rb;
        float wg[3][8], wv[3][8], bg[8], bv[8];
#pragma unroll
        for (int j = 0; j < 3; ++j) {
            const f32x4 a = *(const f32x4*)(p.ffn_conv_w + (size_t)j * 2 * DFF + c0), b = *(const f32x4*)(p.ffn_conv_w + (size_t)j * 2 * DFF + c0 + 4);
            const f32x4 c = *(const f32x4*)(p.ffn_conv_w + (size_t)j * 2 * DFF + DFF + c0), d = *(const f32x4*)(p.ffn_conv_w + (size_t)j * 2 * DFF + DFF + c0 + 4);
            wg[j][0] = a.x; wg[j][1] = a.y; wg[j][2] = a.z; wg[j][3] = a.w; wg[j][4] = b.x; wg[j][5] = b.y; wg[j][6] = b.z; wg[j][7] = b.w;
            wv[j][0] = c.x; wv[j][1] = c.y; wv[j][2] = c.z; wv[j][3] = c.w; wv[j][4] = d.x; wv[j][5] = d.y; wv[j][6] = d.z; wv[j][7] = d.w;
        }
        { const f32x4 a = *(const f32x4*)(p.ffn_conv_b + c0), b = *(const f32x4*)(p.ffn_conv_b + c0 + 4), c = *(const f32x4*)(p.ffn_conv_b + DFF + c0), d = *(const f32x4*)(p.ffn_conv_b + DFF + c0 + 4);
          bg[0] = a.x; bg[1] = a.y; bg[2] = a.z; bg[3] = a.w; bg[4] = b.x; bg[5] = b.y; bg[6] = b.z; bg[7] = b.w; bv[0] = c.x; bv[1] = c.y; bv[2] = c.z; bv[3] = c.w; bv[4] = d.x; bv[5] = d.y; bv[6] = d.z; bv[7] = d.w; }
        float g2[8], g1[8], v2[8], v1[8];
        const bool has_prev = ((half * TH + r0) & (SEQ - 1)) != 0;
        if (has_prev) {
            unpack8(*(const u32x4*)(UP + (size_t)(r0 - 2) * (2 * DFF) + c0), g2); unpack8(*(const u32x4*)(UP + (size_t)(r0 - 1) * (2 * DFF) + c0), g1);
            unpack8(*(const u32x4*)(UP + (size_t)(r0 - 2) * (2 * DFF) + DFF + c0), v2); unpack8(*(const u32x4*)(UP + (size_t)(r0 - 1) * (2 * DFF) + DFF + c0), v1);
        } else {
#pragma unroll
            for (int e = 0; e < 8; ++e) { g2[e] = 0.f; g1[e] = 0.f; v2[e] = 0.f; v1[e] = 0.f; }
        }
#pragma unroll 4
        for (int rr = 0; rr < 16; ++rr) {
            float g0[8], v0[8], y[8];
            unpack8(*(const u32x4*)(UP + (size_t)(r0 + rr) * (2 * DFF) + c0), g0); unpack8(*(const u32x4*)(UP + (size_t)(r0 + rr) * (2 * DFF) + DFF + c0), v0);
#pragma unroll
            for (int e = 0; e < 8; ++e) {
                const float ug = bg[e] + wg[0][e] * g2[e] + wg[1][e] * g1[e] + wg[2][e] * g0[e];
                const float uv = bv[e] + wv[0][e] * v2[e] + wv[1][e] * v1[e] + wv[2][e] * v0[e];
                y[e] = ug * fsig(ug) * uv; g2[e] = g1[e]; g1[e] = g0[e]; v2[e] = v1[e]; v1[e] = v0[e];
            }
            *(u32x4*)(ACT + (size_t)(r0 + rr) * DFF + c0) = pack8(y);
        }
    }
}

__global__ void __launch_bounds__(512, 2) mega(Params p) {
    extern __shared__ __attribute__((aligned(16))) unsigned char shm[];
    cg::grid_group grid = cg::this_grid();
    bf16_t* H = (bf16_t*)((unsigned char*)p.out + DO_H); bf16_t* WinT = (bf16_t*)((unsigned char*)p.out + DO_WIN);
    bf16_t* H2 = (bf16_t*)(p.ws + WS_H2); bf16_t* UPb = (bf16_t*)(p.ws + WS_UP); bf16_t* ACTb = (bf16_t*)(p.ws + WS_ACT);
    const bf16_t* WoT = (const bf16_t*)(p.ws + WS_WOUT); const bf16_t* WuT = (const bf16_t*)(p.ws + WS_WUP); const bf16_t* WdT = (const bf16_t*)(p.ws + WS_WDN);
#define PH(i) (p.ph_lo <= (i) && (i) < p.ph_hi)
#define SYNC(i) do { if (p.ph_lo <= (i) && (i) + 1 < p.ph_hi) grid.sync(); } while (0)
    if (PH(0)) phase0(p, shm);
    SYNC(0);
    if (PH(1)) { Epi1 E{(bf16_t*)(p.ws + WS_AQK), (bf16_t*)(p.ws + WS_VTM), (bf16_t*)(p.ws + WS_GA), (bf16_t*)(p.ws + WS_BQ), (bf16_t*)(p.ws + WS_BK), (bf16_t*)(p.ws + WS_VTD), (bf16_t*)(p.ws + WS_GB)};
        run_gemm(shm, H, WinT, T, 16384, D, E); }
    SYNC(1);
    if (PH(2)) phase2a(p, shm);
    SYNC(2);
    if (PH(3)) phase2b(p, shm);
    SYNC(3);
    if (PH(4)) phase3(p, shm);
    SYNC(4);
    if (PH(5)) { EpiRes E{p.out, p.x, D}; run_gemm(shm, (const bf16_t*)(p.ws + WS_BQ), WoT, T, D, D, E); }
    SYNC(5);
    if (PH(6)) phase5(p);
    SYNC(6);
    if (PH(7)) { EpiB E{UPb, 2 * DFF}; run_gemm(shm, H2, WuT, TH, 2 * DFF, D, E); }
    SYNC(7);
    if (PH(8)) phase7(p, 0);
    SYNC(8);
    if (PH(9)) { { EpiRes E{p.out, p.out, D}; run_gemm(shm, ACTb, WdT, TH, D, DFF, E); }
                 { EpiB E{UPb, 2 * DFF}; run_gemm(shm, H2 + (size_t)TH * D, WuT, TH, 2 * DFF, D, E); } }
    SYNC(9);
    if (PH(10)) phase7(p, 1);
    SYNC(10);
    if (PH(11)) { EpiRes E{p.out + (size_t)TH * D, p.out + (size_t)TH * D, D}; run_gemm(shm, ACTb, WdT, TH, D, DFF, E); }
#undef PH
#undef SYNC
}

#ifndef N_LAUNCHES
#define N_LAUNCHES 1
#endif
extern "C" void kernel_launch(void* const* d_in, const int* in_sizes, int n_in, void* d_out, int out_size, void* d_ws, size_t ws_size, hipStream_t stream) {
    static int grid = 0;
    if (grid == 0) {
        if (n_in != 17 || out_size != T * D || ws_size < WS_END) { fprintf(stderr, "kernel_launch: unexpected problem (n_in %d, out %d, ws %zu)\n", n_in, out_size, ws_size); grid = -1; return; }
        int dev = 0, cus = 0, per_cu = 0;
        if (hipGetDevice(&dev) != hipSuccess || hipDeviceGetAttribute(&cus, hipDeviceAttributeMultiprocessorCount, dev) != hipSuccess) { grid = -1; return; }
        if (hipFuncSetAttribute((const void*)mega, hipFuncAttributeMaxDynamicSharedMemorySize, LDS_BYTES) != hipSuccess) { fprintf(stderr, "kernel_launch: hipFuncSetAttribute failed\n"); grid = -1; return; }
        if (hipOccupancyMaxActiveBlocksPerMultiprocessor(&per_cu, (const void*)mega, 512, LDS_BYTES) != hipSuccess || per_cu < 1) { fprintf(stderr, "kernel_launch: occupancy query says %d\n", per_cu); per_cu = 1; }
        (void)hipGetLastError();
        grid = cus * per_cu;
    }
    if (grid < 0) return;
    if (hipMemsetAsync((char*)d_ws + WS_CTL, 0, 4096, stream) != hipSuccess) { fprintf(stderr, "kernel_launch: memset failed\n"); return; }
    Params p{};
    const float** pp = (const float**)&p;
    for (int i = 0; i < 17; ++i) pp[i] = (const float*)d_in[i];
    p.out = (float*)d_out; p.ws = (unsigned char*)d_ws;
    constexpr int NPH = 12;
    for (int li = 0; li < N_LAUNCHES; ++li) {
        p.ph_lo = (N_LAUNCHES == 1) ? 0 : li; p.ph_hi = (N_LAUNCHES == 1) ? NPH : li + 1;
        void* args[] = {&p};
        hipError_t e = hipLaunchCooperativeKernel((const void*)mega, dim3(grid), dim3(512), args, LDS_BYTES, stream);
        if (e != hipSuccess) { fprintf(stderr, "cooperative launch failed: %s (grid %d)\n", hipGetErrorString(e), grid); break; }
    }
}
```

```cpp
#include <hip/hip_runtime.h>
#include <hip/hip_cooperative_groups.h>
#include <cstdio>
#include <cstdint>
namespace cg = cooperative_groups;
namespace pg8 {
#define PG8_LAS __attribute__((address_space(3)))
typedef unsigned short bf16_t;
typedef short bf16x8 __attribute__((ext_vector_type(8)));
typedef float f32x4 __attribute__((ext_vector_type(4)));
typedef unsigned u32x4 __attribute__((ext_vector_type(4)));
constexpr int BM = 256, BK = 64, HALF = 128, HTB = HALF * BK * 2  , STAGE_BYTES = 8 * HTB, NXCD = 8, WGM = 8;

__host__ __device__ __forceinline__ int lds_byte(int r, int c) { const int st = (r >> 4) * 2 + (c >> 5), rr = r & 15, cc = c & 31, ob = rr * 64 + cc * 2; return st * 1024 + (ob ^ (((ob >> 9) & 1) << 5)); }
__host__ __device__ __forceinline__ void stage_rc(int b, int& R, int& C) { const int st = b / 1024, sb = b % 1024, swz = sb ^ (((sb >> 9) & 1) << 5); R = (st >> 1) * 16 + swz / 64; C = (st & 1) * 32 + (swz % 64) / 2; }
__host__ __device__ __forceinline__ int perm32(int rho) { const int n = rho >> 4, i = rho & 15; return 8 * (i >> 2) + 4 * n + (i & 3); }

struct Unit { int pm, pn; };
struct Gemm { const bf16_t* A; const bf16_t* Bt; int M, N, K; };

struct StaticOrder {
    int nM, nN, nwg, G, c;
    __host__ __device__ void init(int M, int N, int G_, int c_) { nM = M / BM; nN = N / BM; nwg = nM * nN; G = G_; c = c_; }
    __host__ __device__ bool next(int i, Unit& u) const {
        const long L = (long)i * G + c; if (L >= nwg) return false;
        int wgid = (int)L; { const int q = nwg / NXCD, r = nwg % NXCD, xcd = wgid % NXCD, off = wgid / NXCD; wgid = (xcd < r ? xcd * (q + 1) : r * (q + 1) + (xcd - r) * q) + off; }
        const int nig = WGM * nN, gid = wgid / nig, fm = gid * WGM, gsz = (nM - fm) < WGM ? (nM - fm) : WGM;
        u.pm = fm + ((wgid % nig) % gsz); u.pn = (wgid % nig) / gsz; return true;
    }
    __device__ __forceinline__ void a_ready(const Unit&) const {}
    __device__ __forceinline__ void done(const Unit&) const {}
};
__device__ __forceinline__ unsigned cvt_pk_bf16(float lo, float hi) { unsigned r; asm volatile("v_cvt_pk_bf16_f32 %0, %1, %2" : "=v"(r) : "v"(lo), "v"(hi)); return r; }
template <class Epi, class Sched, bool STAMP = false>
__device__ __forceinline__ void gemm_phase(PG8_LAS unsigned char* lds, const Gemm g, const Sched& S, const Epi& E, unsigned long long* stamps) {
    int tid_ = threadIdx.x; asm volatile("" : "+v"(tid_)); const int tid = tid_, wid = __builtin_amdgcn_readfirstlane(tid >> 6), lane = tid & 63, wr = wid >> 2, wc = wid & 3, fr = lane & 15, fq = lane >> 4;
    const int K = g.K, nt = K / BK;
    int ts_lo = 0, ts_hi = 0, nts = 0; const unsigned long long rt_entry = STAMP ? (unsigned long long)wall_clock64() : 0ull;
#define PG8_STAMP() do { if (STAMP && wid == 0 && nts < 64) { const unsigned long long _c = (unsigned long long)clock64(); \
        ts_lo = (lane == nts) ? (int)(unsigned)_c : ts_lo; ts_hi = (lane == nts) ? (int)(unsigned)(_c >> 32) : ts_hi; ++nts; } } while (0)
    PG8_STAMP();
    unsigned voffA[2], voffB[2];
#pragma unroll
    for (int i = 0; i < 2; ++i) { int R, C; stage_rc(tid * 16 + i * 8192, R, C); const int Rb = Epi::PERM ? ((R & ~31) + perm32(R & 31)) : R;
        voffA[i] = (unsigned)(R * K + C) * 2u; voffB[i] = (unsigned)(Rb * K + C) * 2u; }
    const size_t kstep = (size_t)(BK * 2);
    const size_t hstep = (size_t)HALF * K * 2;
    const size_t tstep = 2 * hstep;
    const unsigned ldsw = (unsigned)wid * 1024u;
    const int aoff = lds_byte(wr * 64 + fr, fq * 8), boff = lds_byte(wc * 32 + fr, fq * 8);
#define PG8_SA(b, h) (((b) * 2 + (h)) * HTB)
#define PG8_SB(b, h) ((4 + (b) * 2 + (h)) * HTB)
#define PG8_STAGE(bufoff, gbase, voff) do { _Pragma("unroll") for (int _i = 0; _i < 2; ++_i) \
        __builtin_amdgcn_global_load_lds((const unsigned*)((const char*)(gbase) + (voff)[_i]), (PG8_LAS unsigned*)(lds + (bufoff) + ldsw + _i * 8192), 16, 0, 0); } while (0)
#define PG8_LDA(dst, b, h) do { _Pragma("unroll") for (int m = 0; m < 4; ++m) _Pragma("unroll") for (int k = 0; k < 2; ++k) dst[m][k] = *(const PG8_LAS bf16x8*)(lds + PG8_SA(b, h) + aoff + m * 2048 + k * 1024); } while (0)
#define PG8_LDB(dst, b, h) do { _Pragma("unroll") for (int n = 0; n < 2; ++n) _Pragma("unroll") for (int k = 0; k < 2; ++k) dst[n][k] = *(const PG8_LAS bf16x8*)(lds + PG8_SB(b, h) + boff + n * 2048 + k * 1024); } while (0)
#define PG8_MMA(ai, bj, At, Bt) do { __builtin_amdgcn_s_setprio(1); _Pragma("unroll") for (int m = 0; m < 4; ++m) _Pragma("unroll") for (int n = 0; n < 2; ++n) _Pragma("unroll") for (int k = 0; k < 2; ++k) \
        acc[ai][bj][m][n] = __builtin_amdgcn_mfma_f32_16x16x32_bf16(Bt[n][k], At[m][k], acc[ai][bj][m][n], 0, 0, 0); __builtin_amdgcn_s_setprio(0); } while (0)
#define PG8_WAIT_V(n) asm volatile("s_waitcnt vmcnt(" #n ")" ::: "memory")
#define PG8_WAIT_L(n) asm volatile("s_waitcnt lgkmcnt(" #n ")" ::: "memory")
#define PG8_BAR __builtin_amdgcn_s_barrier()
#define PG8_SCHED __builtin_amdgcn_sched_barrier(0)
    Unit cur, nxt; int ui = 0;
    if (!S.next(0, cur)) return;
    f32x4 acc[2][2][4][2];
#pragma unroll
    for (int a = 0; a < 2; ++a)
#pragma unroll
        for (int b = 0; b < 2; ++b)
#pragma unroll
            for (int m = 0; m < 4; ++m)
#pragma unroll
                for (int n = 0; n < 2; ++n) acc[a][b][m][n] = (f32x4){0.f, 0.f, 0.f, 0.f};
    bf16x8 At[4][2], B0[2][2], B1[2][2];
    const char* cA = (const char*)g.A + (size_t)cur.pm * tstep; const char* cB = (const char*)g.Bt + (size_t)cur.pn * tstep;
    S.a_ready(cur);
    PG8_STAGE(PG8_SB(0, 0), cB, voffB); PG8_STAGE(PG8_SA(0, 0), cA, voffA); PG8_STAGE(PG8_SB(0, 1), cB + hstep, voffB); PG8_STAGE(PG8_SA(0, 1), cA + hstep, voffA);
    if (wr == 1) PG8_BAR;
    PG8_WAIT_V(4); PG8_BAR;
    PG8_STAGE(PG8_SB(1, 0), cB + kstep, voffB); PG8_STAGE(PG8_SA(1, 0), cA + kstep, voffA); PG8_STAGE(PG8_SB(1, 1), cB + hstep + kstep, voffB);
    PG8_WAIT_V(6); PG8_BAR;
    PG8_STAMP();
    for (;;) {
        const bool has_next = S.next(ui + 1, nxt);
        const char* nA = has_next ? (const char*)g.A + (size_t)nxt.pm * tstep : cA; const char* nB = has_next ? (const char*)g.Bt + (size_t)nxt.pn * tstep : cB;
        for (int t = 0; t < nt; t += 2) {
            const bool last = (t == nt - 2);
            const char* a1 = cA + (size_t)(t + 1) * kstep;
            const char* a2 = last ? nA : cA + (size_t)(t + 2) * kstep; const char* b2 = last ? nB : cB + (size_t)(t + 2) * kstep;
            const char* a3 = a2 + kstep; const char* b3 = b2 + kstep;
            if (last && has_next) S.a_ready(nxt);
            PG8_LDB(B0, 0, 0); PG8_SCHED; PG8_LDA(At, 0, 0); PG8_STAGE(PG8_SA(1, 1), a1 + hstep, voffA);
            PG8_WAIT_L(8); PG8_BAR; PG8_WAIT_L(0); PG8_MMA(0, 0, At, B0); PG8_BAR; PG8_SCHED;
            PG8_LDB(B1, 0, 1); PG8_STAGE(PG8_SB(0, 0), b2, voffB);
            PG8_BAR; PG8_WAIT_L(0); PG8_MMA(0, 1, At, B1); PG8_BAR;
            PG8_LDA(At, 0, 1); PG8_STAGE(PG8_SA(0, 0), a2, voffA);
            PG8_BAR; PG8_WAIT_L(0); PG8_MMA(1, 0, At, B0); PG8_BAR; PG8_SCHED;
            PG8_STAGE(PG8_SB(0, 1), b2 + hstep, voffB);
            PG8_WAIT_V(6); PG8_BAR; PG8_MMA(1, 1, At, B1); PG8_BAR;
            PG8_LDB(B0, 1, 0); PG8_SCHED; PG8_LDA(At, 1, 0); PG8_STAGE(PG8_SA(0, 1), a2 + hstep, voffA);
            PG8_WAIT_L(8); PG8_BAR; PG8_WAIT_L(0); PG8_MMA(0, 0, At, B0); PG8_BAR; PG8_SCHED;
            PG8_LDB(B1, 1, 1); PG8_STAGE(PG8_SB(1, 0), b3, voffB);
            PG8_BAR; PG8_WAIT_L(0); PG8_MMA(0, 1, At, B1); PG8_BAR;
            PG8_LDA(At, 1, 1); PG8_STAGE(PG8_SA(1, 0), a3, voffA);
            PG8_BAR; PG8_WAIT_L(0); PG8_MMA(1, 0, At, B0); PG8_BAR; PG8_SCHED;
            PG8_STAGE(PG8_SB(1, 1), b3 + hstep, voffB);
            PG8_WAIT_V(6); PG8_BAR; PG8_MMA(1, 1, At, B1); PG8_BAR;
        }
        PG8_STAMP();
        if constexpr (!Epi::AFTER_DRAIN) { E(acc, cur, wr, wc, fr, fq); S.done(cur); }
        PG8_STAMP();
        if (!has_next) break;
#pragma unroll
        for (int a = 0; a < 2; ++a)
#pragma unroll
            for (int b = 0; b < 2; ++b)
#pragma unroll
                for (int m = 0; m < 4; ++m)
#pragma unroll
                    for (int n = 0; n < 2; ++n) acc[a][b][m][n] = (f32x4){0.f, 0.f, 0.f, 0.f};
        cur = nxt; cA = nA; cB = nB; ++ui;
    }
    PG8_WAIT_V(0);
    if (wr == 0) PG8_BAR;
    PG8_BAR;
    if constexpr (Epi::AFTER_DRAIN) { E.fused(acc, cur, wr, wc, fr, fq, lds, wid, lane); S.done(cur); }
    PG8_STAMP();
    if (STAMP && wid == 0) { stamps[lane] = lane < nts ? (((unsigned long long)(unsigned)ts_hi << 32) | (unsigned)ts_lo) : 0ull;
        if (lane == 62) stamps[62] = rt_entry; if (lane == 63) stamps[63] = (unsigned long long)wall_clock64(); }
#undef PG8_STAMP
#undef PG8_SA
#undef PG8_SB
#undef PG8_STAGE
#undef PG8_LDA
#undef PG8_LDB
#undef PG8_MMA
#undef PG8_WAIT_V
#undef PG8_WAIT_L
#undef PG8_BAR
#undef PG8_SCHED
}
}
using pg8::bf16_t; using pg8::bf16x8; using pg8::f32x4; using pg8::u32x4; using pg8::cvt_pk_bf16;
typedef unsigned u32x2 __attribute__((ext_vector_type(2)));
typedef float f32x16 __attribute__((ext_vector_type(16)));

constexpr int T = 32768, D = 2048, SEQ = 8192, PIN = 16392, DFF = 5632, TH = 16384;
constexpr float EPS = 1e-6f, LOG2E = 1.4426950408889634f;
constexpr size_t MiB = (size_t)1 << 20;
constexpr size_t WS_CTL = 0, WS_GIF = 1 * MiB, WS_KT = 2 * MiB, WS_AQK = 66 * MiB, WS_VTM = 194 * MiB, WS_GA = 322 * MiB, WS_BQ = 450 * MiB, WS_BK = 578 * MiB,
                 WS_VTD = 706 * MiB, WS_GB = 834 * MiB, WS_END = 962 * MiB;
constexpr size_t WS_HM = WS_AQK, WS_H2 = WS_AQK, WS_WOUT = WS_VTM, WS_WUP = WS_VTM + 8 * MiB, WS_WDN = WS_VTM + 52 * MiB, WS_UP = WS_GA, WS_ACT = 674 * MiB;
constexpr size_t DO_H = 0, DO_Q2 = 0, DO_K2 = 64 * MiB, DO_WIN = 128 * MiB, DO_YB = 128 * MiB;
constexpr int LDS_BYTES = 147456;

struct Params {
    const float *x, *norm1_g, *w_in, *if_bias, *qk_conv_w, *qk_conv_b, *mlstm_norm_g, *q_norm_g, *k_norm_g, *diff_lambda, *subln_g, *w_out, *norm2_g, *w_up, *ffn_conv_w, *ffn_conv_b, *w_down;
    float* out; unsigned char* ws; int ph_lo, ph_hi;
};

__device__ __forceinline__ void lds_wait() { asm volatile("s_waitcnt lgkmcnt(0)" ::: "memory"); }
__device__ __forceinline__ float bflo(unsigned u) { return __uint_as_float(u << 16); }
__device__ __forceinline__ float bfhi(unsigned u) { return __uint_as_float(u & 0xffff0000u); }
__device__ __forceinline__ float fsig(float v) { return __builtin_amdgcn_rcpf(1.f + __expf(-v)); }
__device__ __forceinline__ float wave_sum(float v) {
#pragma unroll
    for (int o = 1; o < 64; o <<= 1) v += __shfl_xor(v, o);
    return v;
}
__device__ __forceinline__ void unpack8(u32x4 u, float (&f)[8]) {
    f[0] = bflo(u.x); f[1] = bfhi(u.x); f[2] = bflo(u.y); f[3] = bfhi(u.y); f[4] = bflo(u.z); f[5] = bfhi(u.z); f[6] = bflo(u.w); f[7] = bfhi(u.w);
}
__device__ __forceinline__ u32x4 pack8(const float (&f)[8]) {
    u32x4 o; o.x = cvt_pk_bf16(f[0], f[1]); o.y = cvt_pk_bf16(f[2], f[3]); o.z = cvt_pk_bf16(f[4], f[5]); o.w = cvt_pk_bf16(f[6], f[7]); return o;
}

__device__ __forceinline__ void transpose_item(const float* __restrict__ W, size_t ldw, int K, bf16_t* WT, int k0, int srcn0, int dstn0, float* scr, int lane) {
#pragma unroll 8
    for (int i = 0; i < 32; ++i) { const int kk = 2 * i + (lane >> 5); scr[kk * 33 + (lane & 31)] = W[(size_t)(k0 + kk) * ldw + srcn0 + (lane & 31)]; }
    lds_wait();
    const int c = lane & 7;
#pragma unroll
    for (int j = 0; j < 4; ++j) { const int n = (lane >> 3) + 8 * j; const float* s = scr + (8 * c) * 33 + n;
        u32x4 o; o.x = cvt_pk_bf16(s[0], s[33]); o.y = cvt_pk_bf16(s[66], s[99]); o.z = cvt_pk_bf16(s[132], s[165]); o.w = cvt_pk_bf16(s[198], s[231]);
        *(u32x4*)(WT + (size_t)(dstn0 + n) * K + k0 + 8 * c) = o; }
    lds_wait();
}
__device__ __forceinline__ int win_src(int n) {
    if (n < 4096) return n;
    if (n < 8192) { const int p = (n - 4096) >> 8, j = (n - 4096) & 255; return j < 128 ? 4096 + 128 * p + j : 12296 + 128 * p + (j - 128); }
    if (n < 10240) return 6152 + (n - 8192);
    if (n < 12288) return 8200 + (n - 10240);
    if (n < 14336) return 10248 + (n - 12288);
    return 14344 + (n - 14336);
}
__device__ __forceinline__ void transpose_plain(const float* W, int K, int N, bf16_t* WT, float* scr, int gw, int ngw, int lane) {
    const int nblk = N / 32, nitems = (K / 64) * nblk;
    for (int it = gw; it < nitems; it += ngw) { const int kb = it / nblk, nb = it % nblk; transpose_item(W, (size_t)N, K, WT, 64 * kb, 32 * nb, 32 * nb, scr, lane); }
}

__device__ __forceinline__ void phase0(const Params& p, unsigned char* shm) {
    int tid_ = threadIdx.x; asm volatile("" : "+v"(tid_)); const int tid = tid_, lane = tid & 63, wave = tid >> 6, gw = blockIdx.x * 8 + wave, ngw = gridDim.x * 8;
    float* scr = (float*)(shm + wave * 8448);
    bf16_t* WinT = (bf16_t*)((unsigned char*)p.out + DO_WIN);
    { const int nblk = 16384 / 32, nitems = (D / 64) * nblk;
      for (int it = gw; it < nitems; it += ngw) { const int kb = it / nblk, nb = it % nblk; transpose_item(p.w_in, (size_t)PIN, D, WinT, 64 * kb, win_src(32 * nb), 32 * nb, scr, lane); } }
    float* wifT = (float*)(shm + 69632);
    for (int idx = tid; idx < 8 * D; idx += 512) { const int k = idx >> 3, j = idx & 7; wifT[j * D + k] = p.w_in[(size_t)k * PIN + 6144 + j]; }
    __syncthreads();
    bf16_t* H = (bf16_t*)((unsigned char*)p.out + DO_H);
    float* GIF = (float*)(p.ws + WS_GIF);
    for (int row = gw; row < T; row += ngw) {
        const f32x4* xr = (const f32x4*)(p.x + (size_t)row * D) + lane;
        f32x4 v[8]; float ss = 0.f;
#pragma unroll
        for (int j = 0; j < 8; ++j) { v[j] = xr[64 * j]; ss += (v[j].x * v[j].x + v[j].y * v[j].y) + (v[j].z * v[j].z + v[j].w * v[j].w); }
        const float rinv = rsqrtf(wave_sum(ss) * (1.f / D) + EPS);
        float ga[8];
#pragma unroll
        for (int j = 0; j < 8; ++j) ga[j] = 0.f;
        u32x2* o8 = (u32x2*)(H + (size_t)row * D) + lane;
#pragma unroll
        for (int j = 0; j < 8; ++j) {
            const f32x4 g = *((const f32x4*)p.norm1_g + lane + 64 * j);
            f32x4 h; h.x = v[j].x * rinv * g.x; h.y = v[j].y * rinv * g.y; h.z = v[j].z * rinv * g.z; h.w = v[j].w * rinv * g.w;
            u32x2 o; o.x = cvt_pk_bf16(h.x, h.y); o.y = cvt_pk_bf16(h.z, h.w); o8[64 * j] = o;
#pragma unroll
            for (int q = 0; q < 8; ++q) { const f32x4 w = *((const f32x4*)(wifT + q * D) + lane + 64 * j); ga[q] += (h.x * w.x + h.y * w.y) + (h.z * w.z + h.w * w.w); }
        }
#pragma unroll
        for (int q = 0; q < 8; ++q) ga[q] = wave_sum(ga[q]);
        if (lane < 8) {
            float val = 0.f;
#pragma unroll
            for (int q = 0; q < 8; ++q) val = (lane == q) ? ga[q] : val;
            val += p.if_bias[lane];
            if (lane >= 4) val = fminf(val, 0.f) - log1pf(expf(-fabsf(val)));
            GIF[(size_t)row * 8 + lane] = val;
        }
    }
}

struct Epi1 {
    static constexpr bool PERM = true, AFTER_DRAIN = false;
    bf16_t *aqk, *vtm, *ga, *bq, *bk, *vtd, *gb;
    __device__ __forceinline__ void operator()(const f32x4 (&acc)[2][2][4][2], const pg8::Unit& u, int wr, int wc, int fr, int fq) const {
        const int pn = u.pn, row0 = u.pm * 256 + wr * 64 + fr, cw = wc * 32 + 8 * fq;
        if (pn >= 16 && pn < 32) {
            const int cb = 128 * (pn - 16) + cw;
#pragma unroll
            for (int ai = 0; ai < 2; ++ai)
#pragma unroll
                for (int m = 0; m < 4; ++m) {
                    const size_t row = (size_t)(row0 + ai * 128 + m * 16);
                    float f[8];
#pragma unroll
                    for (int j = 0; j < 4; ++j) { f[j] = fsig(acc[ai][0][m][0][j]) * fsig(acc[ai][1][m][0][j]); f[4 + j] = fsig(acc[ai][0][m][1][j]) * fsig(acc[ai][1][m][1][j]); }
                    *(u32x4*)(ga + row * D + cb) = pack8(f);
                }
            return;
        }
        bf16_t* dst; int col0; int mode;
        if (pn < 8) { dst = aqk; col0 = 256 * pn; mode = 0; }
        else if (pn < 16) { dst = vtm; col0 = 256 * (pn - 8); mode = 1; }
        else if (pn < 40) { dst = bq; col0 = 256 * (pn - 32); mode = 0; }
        else if (pn < 48) { dst = bk; col0 = 256 * (pn - 40); mode = 0; }
        else if (pn < 56) { dst = vtd; col0 = 256 * (pn - 48); mode = 3; }
        else { dst = gb; col0 = 256 * (pn - 56); mode = 2; }
#pragma unroll
        for (int ai = 0; ai < 2; ++ai)
#pragma unroll
            for (int m = 0; m < 4; ++m) {
                const int row = row0 + ai * 128 + m * 16;
#pragma unroll
                for (int bj = 0; bj < 2; ++bj) {
                    const int col = col0 + bj * 128 + cw;
                    float f[8];
#pragma unroll
                    for (int j = 0; j < 4; ++j) { f[j] = acc[ai][bj][m][0][j]; f[4 + j] = acc[ai][bj][m][1][j]; }
                    if (mode == 2) {
#pragma unroll
                        for (int j = 0; j < 8; ++j) f[j] = fsig(f[j]);
                    }
                    const u32x4 w = pack8(f);
                    if (mode == 3) {
                        bf16_t* d = dst + (((size_t)((row >> 13) * 8 + (col >> 8)) * 256 + ((row & (SEQ - 1)) >> 5)) * 256 + (col & 255)) * 32 + (row & 31);
                        d[0] = (bf16_t)(w.x & 0xffff); d[32] = (bf16_t)(w.x >> 16); d[64] = (bf16_t)(w.y & 0xffff); d[96] = (bf16_t)(w.y >> 16);
                        d[128] = (bf16_t)(w.z & 0xffff); d[160] = (bf16_t)(w.z >> 16); d[192] = (bf16_t)(w.w & 0xffff); d[224] = (bf16_t)(w.w >> 16);
                    } else if (mode == 1) {
                        bf16_t* d = dst + ((size_t)((row >> 13) * D + col)) * SEQ + (row & (SEQ - 1));
                        d[0 * (size_t)SEQ] = (bf16_t)(w.x & 0xffff); d[1 * (size_t)SEQ] = (bf16_t)(w.x >> 16); d[2 * (size_t)SEQ] = (bf16_t)(w.y & 0xffff); d[3 * (size_t)SEQ] = (bf16_t)(w.y >> 16);
                        d[4 * (size_t)SEQ] = (bf16_t)(w.z & 0xffff); d[5 * (size_t)SEQ] = (bf16_t)(w.z >> 16); d[6 * (size_t)SEQ] = (bf16_t)(w.w & 0xffff); d[7 * (size_t)SEQ] = (bf16_t)(w.w >> 16);
                    } else {
                        *(u32x4*)(dst + (size_t)row * D + col) = w;
                    }
                }
            }
    }
};
struct EpiRes {
    static constexpr bool PERM = false, AFTER_DRAIN = false;
    float* C; const float* R; int ldc;
    __device__ __forceinline__ void operator()(const f32x4 (&acc)[2][2][4][2], const pg8::Unit& u, int wr, int wc, int fr, int fq) const {
        const int row0 = u.pm * 256 + wr * 64 + fr, col0 = u.pn * 256 + wc * 32 + 4 * fq;
#pragma unroll
        for (int ai = 0; ai < 2; ++ai)
#pragma unroll
            for (int m = 0; m < 4; ++m) {
                const size_t off = (size_t)(row0 + ai * 128 + m * 16) * ldc + col0;
#pragma unroll
                for (int bj = 0; bj < 2; ++bj)
#pragma unroll
                    for (int n = 0; n < 2; ++n) { const f32x4 r = *(const f32x4*)(R + off + bj * 128 + n * 16); *(f32x4*)(C + off + bj * 128 + n * 16) = acc[ai][bj][m][n] + r; }
            }
    }
};
struct EpiB {
    static constexpr bool PERM = true, AFTER_DRAIN = false;
    bf16_t* O; int ldc;
    __device__ __forceinline__ void operator()(const f32x4 (&acc)[2][2][4][2], const pg8::Unit& u, int wr, int wc, int fr, int fq) const {
        const int row0 = u.pm * 256 + wr * 64 + fr, col0 = u.pn * 256 + wc * 32 + 8 * fq;
#pragma unroll
        for (int ai = 0; ai < 2; ++ai)
#pragma unroll
            for (int m = 0; m < 4; ++m) {
                bf16_t* rowp = O + (size_t)(row0 + ai * 128 + m * 16) * ldc + col0;
#pragma unroll
                for (int bj = 0; bj < 2; ++bj) {
                    u32x4 w; w.x = cvt_pk_bf16(acc[ai][bj][m][0][0], acc[ai][bj][m][0][1]); w.y = cvt_pk_bf16(acc[ai][bj][m][0][2], acc[ai][bj][m][0][3]);
                    w.z = cvt_pk_bf16(acc[ai][bj][m][1][0], acc[ai][bj][m][1][1]); w.w = cvt_pk_bf16(acc[ai][bj][m][1][2], acc[ai][bj][m][1][3]);
                    *(u32x4*)(rowp + bj * 128) = w;
                }
            }
    }
};
template <class Epi> __device__ __forceinline__ void run_gemm(unsigned char* shm, const bf16_t* A, const bf16_t* Bt, int M, int N, int K, const Epi& E) {
    pg8::Gemm g{A, Bt, M, N, K};
    pg8::StaticOrder S; S.init(M, N, (int)gridDim.x, (int)blockIdx.x);
    pg8::gemm_phase<Epi, pg8::StaticOrder, false>((PG8_LAS unsigned char*)shm, g, S, E, nullptr);
}

__device__ __forceinline__ void phase2a(const Params& p, unsigned char* shm) {
    int tid_ = threadIdx.x; asm volatile("" : "+v"(tid_)); const int tid = tid_, lane = tid & 63, wave = tid >> 6;
    const bf16_t* AQK = (const bf16_t*)(p.ws + WS_AQK);
    bf16_t* Q2 = (bf16_t*)((unsigned char*)p.out + DO_Q2); bf16_t* K2 = (bf16_t*)((unsigned char*)p.out + DO_K2); bf16_t* KT = (bf16_t*)(p.ws + WS_KT);
    bf16_t* tl = (bf16_t*)shm;
    for (int item = blockIdx.x; item < 256 * 32; item += gridDim.x) {
        const int ch = item >> 5, cgp = item & 31, t0 = ch * 128, oct = tid & 7, rg = tid >> 3, c0 = 64 * cgp + 8 * oct;
        float w[4][8], bias[8];
#pragma unroll
        for (int j = 0; j < 4; ++j) { const f32x4 a = *(const f32x4*)(p.qk_conv_w + j * D + c0), b = *(const f32x4*)(p.qk_conv_w + j * D + c0 + 4);
            w[j][0] = a.x; w[j][1] = a.y; w[j][2] = a.z; w[j][3] = a.w; w[j][4] = b.x; w[j][5] = b.y; w[j][6] = b.z; w[j][7] = b.w; }
        { const f32x4 a = *(const f32x4*)(p.qk_conv_b + c0), b = *(const f32x4*)(p.qk_conv_b + c0 + 4);
          bias[0] = a.x; bias[1] = a.y; bias[2] = a.z; bias[3] = a.w; bias[4] = b.x; bias[5] = b.y; bias[6] = b.z; bias[7] = b.w; }
        float in[5][8];
        const int rl0 = 2 * rg;
#pragma unroll
        for (int k = 0; k < 5; ++k) {
            const int rl = rl0 - 3 + k; const int sp = (t0 & (SEQ - 1)) + rl;
            if (sp >= 0) { const u32x4 u = *(const u32x4*)(AQK + (size_t)(t0 + rl) * D + c0); unpack8(u, in[k]); }
            else {
#pragma unroll
                for (int e = 0; e < 8; ++e) in[k][e] = 0.f; }
        }
        const bool isq = cgp < 16;
#pragma unroll
        for (int rr = 0; rr < 2; ++rr) {
            float y[8];
#pragma unroll
            for (int e = 0; e < 8; ++e) { float a = bias[e]; a += w[0][e] * in[rr][e]; a += w[1][e] * in[rr + 1][e]; a += w[2][e] * in[rr + 2][e]; a += w[3][e] * in[rr + 3][e];
                a = a * fsig(a); y[e] = isq ? a * 0.0625f : a; }
            const u32x4 o = pack8(y);
            const size_t row = (size_t)(t0 + rl0 + rr);
            if (isq) *(u32x4*)(Q2 + row * 1024 + c0) = o;
            else {
                *(u32x4*)(K2 + row * 1024 + (c0 - 1024)) = o;
            }
        }
    }
    {
        bf16_t* BQ = (bf16_t*)(p.ws + WS_BQ); bf16_t* BK = (bf16_t*)(p.ws + WS_BK);
        const int e16 = lane & 15, sub = lane >> 4;
        const float qs = 0.08838834764831845f * LOG2E;
        const f32x4 gq0 = *(const f32x4*)(p.q_norm_g + 8 * e16), gq1 = *(const f32x4*)(p.q_norm_g + 8 * e16 + 4);
        const f32x4 gk0 = *(const f32x4*)(p.k_norm_g + 8 * e16), gk1 = *(const f32x4*)(p.k_norm_g + 8 * e16 + 4);
        const int gwv = blockIdx.x * 8 + wave, ngw = gridDim.x * 8;
        for (int it = gwv; it < T * 32 / 4; it += ngw) {
            const int gid = it * 4 + sub, t = gid >> 5, grp = gid & 31;
            const bool isq = grp < 16;
            bf16_t* ptr = (isq ? BQ : BK) + (size_t)t * D + 128 * (grp & 15) + 8 * e16;
            float f[8]; unpack8(*(const u32x4*)ptr, f);
            float ss = 0.f;
#pragma unroll
            for (int e = 0; e < 8; ++e) ss += f[e] * f[e];
            ss += __shfl_xor(ss, 1); ss += __shfl_xor(ss, 2); ss += __shfl_xor(ss, 4); ss += __shfl_xor(ss, 8);
            const float rinv = rsqrtf(ss * (1.f / 128.f) + EPS) * (isq ? qs : 1.f);
            const f32x4 g0 = isq ? gq0 : gk0, g1 = isq ? gq1 : gk1;
            f[0] *= rinv * g0.x; f[1] *= rinv * g0.y; f[2] *= rinv * g0.z; f[3] *= rinv * g0.w; f[4] *= rinv * g1.x; f[5] *= rinv * g1.y; f[6] *= rinv * g1.z; f[7] *= rinv * g1.w;
            *(u32x4*)ptr = pack8(f);
        }
    }
}

constexpr int ML_KL = 0, ML_CT = 67584, ML_VT = 101376, ML_A = 118784, ML_MM = 119296, ML_BB = 119808, ML_WS = 120320, ML_N = 120832, ML_MISC = 121856;
typedef short s16x4 __attribute__((ext_vector_type(4)));
#define ML_SB __builtin_amdgcn_sched_barrier(0)
#define ML_MFMA(a_, b_, c_) __builtin_amdgcn_mfma_f32_16x16x32_bf16(a_, b_, c_, 0, 0, 0)
__device__ __forceinline__ void ml_chain2(const unsigned char* baseA, const unsigned char* baseB, const bf16x8 (&qf)[8], f32x4& SA, f32x4& SB) {
    bf16x8 f0 = *(const bf16x8*)(baseA), f1 = *(const bf16x8*)(baseB), f2 = *(const bf16x8*)(baseA + 16), f3 = *(const bf16x8*)(baseB + 16);
    ML_SB;
#pragma unroll
    for (int ks = 0; ks < 8; ks += 2) {
        SA = ML_MFMA(f0, qf[ks], SA); if (ks + 2 < 8) f0 = *(const bf16x8*)(baseA + 16 * (ks + 2)); ML_SB;
        SB = ML_MFMA(f1, qf[ks], SB); if (ks + 2 < 8) f1 = *(const bf16x8*)(baseB + 16 * (ks + 2)); ML_SB;
        SA = ML_MFMA(f2, qf[ks + 1], SA); if (ks + 3 < 8) f2 = *(const bf16x8*)(baseA + 16 * (ks + 3)); ML_SB;
        SB = ML_MFMA(f3, qf[ks + 1], SB); if (ks + 3 < 8) f3 = *(const bf16x8*)(baseB + 16 * (ks + 3)); ML_SB;
    }
}
__device__ __forceinline__ void mlstm_item(const Params& p, unsigned char* shm, int item) {
    int tid_ = threadIdx.x; asm volatile("" : "+v"(tid_)); const int tid = tid_, lane = tid & 63, w = __builtin_amdgcn_readfirstlane(tid >> 6), l15 = lane & 15, qq = lane >> 4;
    const int sl = item & 7, hA = (item >> 3) & 3, b = item >> 5;
    const int wq = w < 4 ? w : 11 - w;
    const bf16_t* Q2 = (const bf16_t*)((const unsigned char*)p.out + DO_Q2); const bf16_t* K2 = (const bf16_t*)((const unsigned char*)p.out + DO_K2);
    const bf16_t* VTM = (const bf16_t*)(p.ws + WS_VTM); const float* GIF = (const float*)(p.ws + WS_GIF);
    bf16_t* HM = (bf16_t*)(p.ws + WS_HM);
    float* sA = (float*)(shm + ML_A); float* sMM = (float*)(shm + ML_MM); float* sBB = (float*)(shm + ML_BB); float* sWS = (float*)(shm + ML_WS); float* sN = (float*)(shm + ML_N); float* sMisc = (float*)(shm + ML_MISC);
    f32x4 Cacc[2][4], Nacc[2];
#pragma unroll
    for (int a = 0; a < 2; ++a) { Nacc[a] = (f32x4){0.f, 0.f, 0.f, 0.f};
#pragma unroll
        for (int c = 0; c < 4; ++c) Cacc[a][c] = (f32x4){0.f, 0.f, 0.f, 0.f}; }
    float m_st = 0.f;
    const bf16_t* vtrow0 = VTM + ((size_t)((b * 4 + hA) * 512 + 64 * sl)) * SEQ;
    const size_t tb = (size_t)b * SEQ;
    u32x4 stK[8], stV[2]; float gli0 = 0.f, gli1 = 0.f, glf0 = 0.f, glf1 = 0.f; bf16x8 qf[8];
    const int krow_s = tid >> 2, kpart = tid & 3, vdv = tid >> 3, vpart = tid & 7;
#define ML_LOAD_STAGE(c_) do { const size_t t0_ = tb + 128 * (c_); \
        { const bf16_t* src = K2 + (t0_ + krow_s) * 1024 + hA * 256 + kpart * 64; _Pragma("unroll") for (int e = 0; e < 8; ++e) stK[e] = *(const u32x4*)(src + 8 * e); } \
        { const bf16_t* src = vtrow0 + (size_t)vdv * SEQ + 128 * (c_) + vpart * 16; stV[0] = *(const u32x4*)src; stV[1] = *(const u32x4*)(src + 8); } \
        if (w == 0) { gli0 = GIF[(t0_ + 2 * lane) * 8 + hA]; gli1 = GIF[(t0_ + 2 * lane + 1) * 8 + hA]; glf0 = GIF[(t0_ + 2 * lane) * 8 + 4 + hA]; glf1 = GIF[(t0_ + 2 * lane + 1) * 8 + 4 + hA]; } } while (0)
#define ML_LOAD_Q(c_) do { const bf16_t* qp = Q2 + (tb + 128 * (c_) + 16 * wq + l15) * 1024 + hA * 256 + 64 * qq; _Pragma("unroll") for (int ks = 0; ks < 8; ++ks) qf[ks] = *(const bf16x8*)(qp + 8 * ks); } while (0)
#define ML_WRITE_STAGE() do { \
        { unsigned char* dst = shm + ML_KL + krow_s * 528 + kpart * 128; _Pragma("unroll") for (int e = 0; e < 8; ++e) *(u32x4*)(dst + 16 * e) = stK[e]; } \
        { unsigned char* dst = shm + ML_VT + vdv * 272 + vpart * 32; *(u32x4*)dst = stV[0]; *(u32x4*)(dst + 16) = stV[1]; } \
        _Pragma("unroll") for (int dkb = 0; dkb < 2; ++dkb) { \
            _Pragma("unroll") for (int dvb = 0; dvb < 4; ++dvb) { u32x2 o; o.x = cvt_pk_bf16(Cacc[dkb][dvb][0], Cacc[dkb][dvb][1]); o.y = cvt_pk_bf16(Cacc[dkb][dvb][2], Cacc[dkb][dvb][3]); \
                *(u32x2*)(shm + ML_CT + (16 * dvb + l15) * 528 + (32 * w + 16 * dkb + 4 * qq) * 2) = o; } \
            if (l15 == 0) *(f32x4*)(sN + 32 * w + 16 * dkb + 4 * qq) = Nacc[dkb]; } \
        if (w == 0) { \
            float cs = glf0 + glf1; \
            _Pragma("unroll") for (int o = 1; o < 64; o <<= 1) { const float v = __shfl_up(cs, o); if (lane >= o) cs += v; } \
            const float b1 = cs, b0 = cs - glf1; const float a0 = gli0 - b0, a1 = gli1 - b1; \
            float pmx = fmaxf(a0, a1); \
            _Pragma("unroll") for (int o = 1; o < 64; o <<= 1) { const float v = __shfl_up(pmx, o); if (lane >= o) pmx = fmaxf(pmx, v); } \
            float ex = __shfl_up(pmx, 1); if (lane == 0) ex = -3.0e38f; \
            const float pm0 = fmaxf(ex, a0), pm1 = pmx; const float mm0 = fmaxf(pm0, m_st), mm1 = fmaxf(pm1, m_st); \
            const float mml = __shfl(mm1, 63), bl = __shfl(b1, 63); \
            sA[2 * lane] = a0; sA[2 * lane + 1] = a1; sMM[2 * lane] = mm0; sMM[2 * lane + 1] = mm1; sBB[2 * lane] = b0; sBB[2 * lane + 1] = b1; \
            sWS[2 * lane] = __expf(a0 - mml); sWS[2 * lane + 1] = __expf(a1 - mml); \
            if (lane == 0) { sMisc[0] = bl; sMisc[1] = mml; } } } while (0)
    ML_LOAD_STAGE(0); ML_LOAD_Q(0);
    ML_WRITE_STAGE();
    for (int c = 0; c < 64; ++c) {
        __syncthreads();
        if (c + 1 < 64) ML_LOAD_STAGE(c + 1);
        const size_t t0 = tb + 128 * c;
        const int tl = 16 * wq + l15;
        const float mm_t = sMM[tl], b_t = sBB[tl], gi = __expf(m_st - mm_t);
        bf16x8 pf[4]; float den = 0.f;
#pragma unroll
        for (int a = 0; a < 4; ++a) {
            pf[a] = (bf16x8){0, 0, 0, 0, 0, 0, 0, 0};
            if (2 * a <= wq) {
                f32x4 S0 = (f32x4){0.f, 0.f, 0.f, 0.f}, S1 = (f32x4){0.f, 0.f, 0.f, 0.f};
                const unsigned char* kp = shm + ML_KL + (32 * a + 8 * (l15 >> 2) + (l15 & 3)) * 528 + 128 * qq;
                ml_chain2(kp, kp + 4 * 528, qf, S0, S1);
                const int key0 = 32 * a + 8 * qq;
                const f32x4 av0 = *(const f32x4*)(sA + key0), av1 = *(const f32x4*)(sA + key0 + 4);
                float pv[8];
#pragma unroll
                for (int i = 0; i < 4; ++i) { pv[i] = (key0 + i <= tl) ? S0[i] * __expf(av0[i] - mm_t) : 0.f; pv[4 + i] = (key0 + 4 + i <= tl) ? S1[i] * __expf(av1[i] - mm_t) : 0.f; den += pv[i] + pv[4 + i]; }
                pf[a] = __builtin_bit_cast(bf16x8, pack8(pv));
            }
        }
        den += __shfl_xor(den, 16); den += __shfl_xor(den, 32);
        f32x4 num[4];
        { const unsigned char* cp = shm + ML_CT + l15 * 528 + 128 * qq;
          f32x4 n0 = (f32x4){0.f, 0.f, 0.f, 0.f}, n1 = n0, n2 = n0, n3 = n0;
          ml_chain2(cp, cp + 16 * 528, qf, n0, n1); ml_chain2(cp + 32 * 528, cp + 48 * 528, qf, n2, n3);
          num[0] = n0 * gi; num[1] = n1 * gi; num[2] = n2 * gi; num[3] = n3 * gi; }
        float qn = 0.f;
#pragma unroll
        for (int ks = 0; ks < 8; ++ks) {
            float qv[8]; unpack8(__builtin_bit_cast(u32x4, qf[ks]), qv);
            const f32x4 n0 = *(const f32x4*)(sN + 64 * qq + 8 * ks), n1 = *(const f32x4*)(sN + 64 * qq + 8 * ks + 4);
            qn += (qv[0] * n0.x + qv[1] * n0.y) + (qv[2] * n0.z + qv[3] * n0.w) + (qv[4] * n1.x + qv[5] * n1.y) + (qv[6] * n1.z + qv[7] * n1.w);
        }
        qn += __shfl_xor(qn, 16); qn += __shfl_xor(qn, 32);
        den += gi * qn;
        ML_SB;
        if (c + 1 < 64) ML_LOAD_Q(c + 1);
        ML_SB;
#pragma unroll
        for (int a = 0; a < 4; ++a) {
            if (2 * a <= wq) {
                const unsigned char* vp = shm + ML_VT + l15 * 272 + (32 * a + 8 * qq) * 2;
                const bf16x8 v0 = *(const bf16x8*)(vp), v1 = *(const bf16x8*)(vp + 16 * 272), v2 = *(const bf16x8*)(vp + 32 * 272), v3 = *(const bf16x8*)(vp + 48 * 272);
                ML_SB;
                num[0] = ML_MFMA(v0, pf[a], num[0]); num[1] = ML_MFMA(v1, pf[a], num[1]); num[2] = ML_MFMA(v2, pf[a], num[2]); num[3] = ML_MFMA(v3, pf[a], num[3]);
            }
        }
        { const float dn = __builtin_amdgcn_rcpf(fmaxf(fabsf(den), __expf(-(b_t + mm_t))));
          bf16_t* hp = HM + (t0 + tl) * D + hA * 512 + 64 * sl + 4 * qq;
#pragma unroll
          for (int dvb = 0; dvb < 4; ++dvb) { u32x2 o; o.x = cvt_pk_bf16(num[dvb][0] * dn, num[dvb][1] * dn); o.y = cvt_pk_bf16(num[dvb][2] * dn, num[dvb][3] * dn); *(u32x2*)(hp + 16 * dvb) = o; } }
        const float b_last = sMisc[0], mm_last = sMisc[1], decay = __expf(m_st - mm_last);
#pragma unroll
        for (int dkb = 0; dkb < 2; ++dkb) { Nacc[dkb] = Nacc[dkb] * decay;
#pragma unroll
            for (int dvb = 0; dvb < 4; ++dvb) Cacc[dkb][dvb] = Cacc[dkb][dvb] * decay; }
#pragma unroll
        for (int a = 0; a < 4; ++a) {
            const f32x4 w0 = *(const f32x4*)(sWS + 32 * a + 8 * qq), w1 = *(const f32x4*)(sWS + 32 * a + 8 * qq + 4);
            const unsigned char* tp = shm + ML_KL + (32 * a + 8 * qq + (l15 >> 2)) * 528 + (32 * w + 4 * (l15 & 3)) * 2;
            const s16x4 t00 = __builtin_amdgcn_ds_read_tr16_b64_v4i16((PG8_LAS s16x4*)(tp)), t01 = __builtin_amdgcn_ds_read_tr16_b64_v4i16((PG8_LAS s16x4*)(tp + 4 * 528));
            const s16x4 t10 = __builtin_amdgcn_ds_read_tr16_b64_v4i16((PG8_LAS s16x4*)(tp + 32)), t11 = __builtin_amdgcn_ds_read_tr16_b64_v4i16((PG8_LAS s16x4*)(tp + 32 + 4 * 528));
            const unsigned char* vp = shm + ML_VT + l15 * 272 + (32 * a + 8 * qq) * 2;
            const u32x4 r0 = *(const u32x4*)(vp), r1 = *(const u32x4*)(vp + 16 * 272), r2 = *(const u32x4*)(vp + 32 * 272), r3 = *(const u32x4*)(vp + 48 * 272);
            ML_SB;
            bf16x8 kt0, kt1;
            kt0[0] = t00[0]; kt0[1] = t00[1]; kt0[2] = t00[2]; kt0[3] = t00[3]; kt0[4] = t01[0]; kt0[5] = t01[1]; kt0[6] = t01[2]; kt0[7] = t01[3];
            kt1[0] = t10[0]; kt1[1] = t10[1]; kt1[2] = t10[2]; kt1[3] = t10[3]; kt1[4] = t11[0]; kt1[5] = t11[1]; kt1[6] = t11[2]; kt1[7] = t11[3];
            float wsv[8] = {w0.x, w0.y, w0.z, w0.w, w1.x, w1.y, w1.z, w1.w};
            float zf[8];
#pragma unroll
            for (int e = 0; e < 8; ++e) zf[e] = (l15 == 0) ? wsv[e] : 0.f;
            const bf16x8 wsf = __builtin_bit_cast(bf16x8, pack8(zf));
            Nacc[0] = ML_MFMA(kt0, wsf, Nacc[0]); Nacc[1] = ML_MFMA(kt1, wsf, Nacc[1]);
            const u32x4 rr[4] = {r0, r1, r2, r3};
#pragma unroll
            for (int dvb = 0; dvb < 4; ++dvb) {
                float vv[8]; unpack8(rr[dvb], vv);
#pragma unroll
                for (int e = 0; e < 8; ++e) vv[e] *= wsv[e];
                const bf16x8 wv = __builtin_bit_cast(bf16x8, pack8(vv));
                Cacc[0][dvb] = ML_MFMA(kt0, wv, Cacc[0][dvb]); Cacc[1][dvb] = ML_MFMA(kt1, wv, Cacc[1][dvb]);
            }
        }
        m_st = b_last + mm_last;
        __syncthreads();
        if (c + 1 < 64) ML_WRITE_STAGE();
    }
#undef ML_LOAD_STAGE
#undef ML_LOAD_Q
#undef ML_WRITE_STAGE
}
#undef ML_SB
#undef ML_MFMA

constexpr int AT_V = 16384, AT_BUF = 32768;
__device__ __forceinline__ void attn_item(const Params& p, unsigned char* shm, int b, int h, int qb, float lam, float M2) {
    int tid_ = threadIdx.x; asm volatile("" : "+v"(tid_)); const int tid = tid_, lane = tid & 63, wave = __builtin_amdgcn_readfirstlane(tid >> 6), c = wave & 1, g = wave >> 1, r = lane & 31, hh = lane >> 5;
    const bf16_t* BQ = (const bf16_t*)(p.ws + WS_BQ); const bf16_t* BK = (const bf16_t*)(p.ws + WS_BK); const bf16_t* VTD = (const bf16_t*)(p.ws + WS_VTD); const bf16_t* GB = (const bf16_t*)(p.ws + WS_GB);
    bf16_t* YB = (bf16_t*)((unsigned char*)p.out + DO_YB);
    float* cmb = (float*)shm;
    const int tq = qb * 128 + 32 * g + r; const size_t rowq = (size_t)b * SEQ + tq;
    bf16x8 qf[8];
    { const bf16_t* qp = BQ + rowq * D + h * 256 + c * 128 + 64 * hh;
#pragma unroll
      for (int ks = 0; ks < 8; ++ks) qf[ks] = *(const bf16x8*)(qp + 8 * ks); }
    f32x16 O[8];
#pragma unroll
    for (int db = 0; db < 8; ++db)
#pragma unroll
        for (int i = 0; i < 16; ++i) O[db][i] = 0.f;
    float lsum = 0.f;
    const float slope2 = exp2f(-(float)(h + 1)) * LOG2E;
    const int ntile_w = qb * 4 + g + 1, ntile = qb * 4 + 4;
    int kt0 = (int)ceilf(((float)(qb * 128 - 31) - (150.f + 2.f * M2) / slope2) * (1.f / 32.f)); kt0 = kt0 < 0 ? 0 : kt0;
    const int keyperm = (r & 19) | ((r & 4) << 1) | ((r & 8) >> 1);
    unsigned kgo[2], vgo[2];
#pragma unroll
    for (int j = 0; j < 2; ++j) { const int R = 8 * wave + 4 * j + (lane >> 4); kgo[j] = (unsigned)((R & 31) * D + (R >> 5) * 128 + 8 * ((lane & 15) ^ (R & 15))) * 2u;
        const int dv = 32 * wave + 16 * j + (lane >> 2); vgo[j] = (unsigned)(dv * 32 + 8 * ((lane & 3) ^ ((dv >> 2) & 3))) * 2u; }
    const char* kgb = (const char*)(BK + ((size_t)b * SEQ) * D + h * 256);
    const char* vgb = (const char*)(VTD + ((size_t)(b * 8 + h) * 256) * 8192);
#define AT_ISSUE(kt_, dst_) do { const char* kb_ = kgb + (size_t)(32 * (kt_)) * (D * 2); const char* vb_ = vgb + (size_t)(kt_) * 16384; \
        _Pragma("unroll") for (int j = 0; j < 2; ++j) __builtin_amdgcn_global_load_lds((const unsigned*)(kb_ + kgo[j]), (PG8_LAS unsigned*)((dst_) + (2 * wave + j) * 1024), 16, 0, 0); \
        _Pragma("unroll") for (int j = 0; j < 2; ++j) __builtin_amdgcn_global_load_lds((const unsigned*)(vb_ + vgo[j]), (PG8_LAS unsigned*)((dst_) + AT_V + (2 * wave + j) * 1024), 16, 0, 0); } while (0)
    const int krow = (c * 32 + keyperm) * 256, kx = keyperm & 15;
    const int vrow = AT_V + r * 64, vf_ = hh ^ ((r >> 2) & 3);
    __syncthreads();
    const int kt0e = kt0 & ~1, n64 = (ntile - kt0e) >> 1;
    AT_ISSUE(kt0e, shm); AT_ISSUE(kt0e + 1, shm + AT_BUF);
    asm volatile("s_waitcnt vmcnt(0)" ::: "memory");
    __builtin_amdgcn_s_barrier(); asm volatile("" ::: "memory");
    for (int it = 0; it < n64; ++it) {
      unsigned char* slot = shm + (it & 1) * (2 * AT_BUF);
      if (it + 1 < n64) { unsigned char* ns = shm + ((it & 1) ^ 1) * (2 * AT_BUF); AT_ISSUE(kt0e + 2 * it + 2, ns); AT_ISSUE(kt0e + 2 * it + 3, ns + AT_BUF); }
#pragma unroll
      for (int u = 0; u < 2; ++u) {
        const int kt = kt0e + 2 * it + u;
        const int s0 = 32 * kt;
        unsigned char* buf = slot + u * AT_BUF;
        if (kt < ntile_w) {
#define AT_KF(ks_) (*(const bf16x8*)(buf + krow + 16 * ((8 * hh + (ks_)) ^ kx)))
#define AT_VF(i_) (*(const bf16x8*)(buf + vrow + ((i_) & 7) * 2048 + 16 * ((2 * ((i_) >> 3)) ^ vf_)))
#define AT_SB __builtin_amdgcn_sched_barrier(0)
            const float base = slope2 * (float)(s0 + 8 * hh - tq) - M2;
            f32x16 S;
#pragma unroll
            for (int i = 0; i < 16; ++i) S[i] = fmaf(slope2, (float)((i & 3) + 4 * ((i >> 2) & 1) + 16 * (i >> 3)), base);
            bf16x8 f0 = AT_KF(0), f1 = AT_KF(1), f2 = AT_KF(2), f3 = AT_KF(3);
            AT_SB;
            S = __builtin_amdgcn_mfma_f32_32x32x16_bf16(f0, qf[0], S, 0, 0, 0); f0 = AT_KF(4); AT_SB;
            S = __builtin_amdgcn_mfma_f32_32x32x16_bf16(f1, qf[1], S, 0, 0, 0); f1 = AT_KF(5); AT_SB;
            S = __builtin_amdgcn_mfma_f32_32x32x16_bf16(f2, qf[2], S, 0, 0, 0); f2 = AT_KF(6); AT_SB;
            S = __builtin_amdgcn_mfma_f32_32x32x16_bf16(f3, qf[3], S, 0, 0, 0); f3 = AT_KF(7); AT_SB;
            S = __builtin_amdgcn_mfma_f32_32x32x16_bf16(f0, qf[4], S, 0, 0, 0); f0 = AT_VF(0); AT_SB;
            S = __builtin_amdgcn_mfma_f32_32x32x16_bf16(f1, qf[5], S, 0, 0, 0); f1 = AT_VF(1); AT_SB;
            S = __builtin_amdgcn_mfma_f32_32x32x16_bf16(f2, qf[6], S, 0, 0, 0); f2 = AT_VF(2); AT_SB;
            S = __builtin_amdgcn_mfma_f32_32x32x16_bf16(f3, qf[7], S, 0, 0, 0); f3 = AT_VF(3); AT_SB;
            float pv[16];
#pragma unroll
            for (int i = 0; i < 16; ++i) pv[i] = __builtin_amdgcn_exp2f(S[i]);
            if (kt == ntile_w - 1) {
#pragma unroll
                for (int i = 0; i < 16; ++i) { const int key = s0 + (i & 3) + 4 * ((i >> 2) & 1) + 8 * hh + 16 * (i >> 3); pv[i] = (key <= tq) ? pv[i] : 0.f; }
            }
#pragma unroll
            for (int i = 0; i < 16; ++i) lsum += pv[i];
            bf16x8 pf[2];
#pragma unroll
            for (int k2 = 0; k2 < 2; ++k2) { u32x4 u; u.x = cvt_pk_bf16(pv[8 * k2 + 0], pv[8 * k2 + 1]); u.y = cvt_pk_bf16(pv[8 * k2 + 2], pv[8 * k2 + 3]); u.z = cvt_pk_bf16(pv[8 * k2 + 4], pv[8 * k2 + 5]); u.w = cvt_pk_bf16(pv[8 * k2 + 6], pv[8 * k2 + 7]);
                pf[k2] = __builtin_bit_cast(bf16x8, u); }
            AT_SB;
#define AT_PV(i_, f_) do { O[(i_) & 7] = __builtin_amdgcn_mfma_f32_32x32x16_bf16(f_, pf[(i_) >> 3], O[(i_) & 7], 0, 0, 0); if ((i_) + 4 < 16) f_ = AT_VF((i_) + 4); AT_SB; } while (0)
            AT_PV(0, f0); AT_PV(1, f1); AT_PV(2, f2); AT_PV(3, f3); AT_PV(4, f0); AT_PV(5, f1); AT_PV(6, f2); AT_PV(7, f3);
            AT_PV(8, f0); AT_PV(9, f1); AT_PV(10, f2); AT_PV(11, f3); AT_PV(12, f0); AT_PV(13, f1); AT_PV(14, f2); AT_PV(15, f3);
#undef AT_PV
#undef AT_KF
#undef AT_VF
#undef AT_SB
        }
      }
      asm volatile("s_waitcnt vmcnt(0)" ::: "memory");
      asm volatile("s_waitcnt lgkmcnt(0)" ::: "memory");
      __builtin_amdgcn_s_barrier(); asm volatile("" ::: "memory");
    }
#undef AT_ISSUE
    const float ltot = lsum + __shfl_xor(lsum, 32);
    const float inv = 1.f / ltot;
    if (c == 1) {
#pragma unroll
        for (int db = 0; db < 8; ++db)
#pragma unroll
            for (int i = 0; i < 16; ++i) { const int dv = 32 * db + (i & 3) + 8 * (i >> 2) + 4 * hh; cmb[(g * 256 + dv) * 32 + r] = O[db][i] * inv; }
    }
    __syncthreads();
    if (c == 0) {
        float ss = 0.f;
#pragma unroll
        for (int db = 0; db < 8; ++db)
#pragma unroll
            for (int i = 0; i < 16; ++i) { const int dv = 32 * db + (i & 3) + 8 * (i >> 2) + 4 * hh; const float o = O[db][i] * inv - lam * cmb[(g * 256 + dv) * 32 + r]; O[db][i] = o; ss += o * o; }
        ss += __shfl_xor(ss, 32);
        const float rinv = rsqrtf(ss * (1.f / 256.f) + EPS) * 0.8f;
#pragma unroll
        for (int db = 0; db < 8; ++db)
#pragma unroll
            for (int ig = 0; ig < 4; ++ig) {
                const int dv0 = 32 * db + 8 * ig + 4 * hh; const size_t off = rowq * D + h * 256 + dv0;
                const u32x2 gbu = *(const u32x2*)(GB + off); const f32x4 sg = *(const f32x4*)(p.subln_g + dv0);
                u32x2 o; o.x = cvt_pk_bf16(O[db][4 * ig + 0] * rinv * sg.x * bflo(gbu.x), O[db][4 * ig + 1] * rinv * sg.y * bfhi(gbu.x));
                o.y = cvt_pk_bf16(O[db][4 * ig + 2] * rinv * sg.z * bflo(gbu.y), O[db][4 * ig + 3] * rinv * sg.w * bfhi(gbu.y));
                *(u32x2*)(YB + off) = o;
            }
    }
}

__device__ __forceinline__ void phase2b(const Params& p, unsigned char* shm, int rep) {
    int tid_ = threadIdx.x; asm volatile("" : "+v"(tid_)); const int tid = tid_, lane = tid & 63;
    if (blockIdx.x < 128) { const int xcd = blockIdx.x & 7, idx = blockIdx.x >> 3; mlstm_item(p, shm, (xcd * 2 + (idx >> 3)) * 8 + (idx & 7)); }
    float lam, M2;
    { const float a0 = p.diff_lambda[lane] * p.diff_lambda[128 + lane] + p.diff_lambda[64 + lane] * p.diff_lambda[192 + lane];
      const float a1 = p.diff_lambda[256 + lane] * p.diff_lambda[384 + lane] + p.diff_lambda[320 + lane] * p.diff_lambda[448 + lane];
      lam = expf(wave_sum(a0)) - expf(wave_sum(a1)) + 0.2f;
      float mq = fmaxf(fabsf(p.q_norm_g[lane]), fabsf(p.q_norm_g[64 + lane])), mk = fmaxf(fabsf(p.k_norm_g[lane]), fabsf(p.k_norm_g[64 + lane]));
#pragma unroll
      for (int o = 1; o < 64; o <<= 1) { mq = fmaxf(mq, __shfl_xor(mq, o)); mk = fmaxf(mk, __shfl_xor(mk, o)); }
      M2 = 128.f * mq * mk * 0.08838834764831845f * LOG2E * 1.02f;
      lam = __uint_as_float(__builtin_amdgcn_readfirstlane(__float_as_uint(lam))); M2 = __uint_as_float(__builtin_amdgcn_readfirstlane(__float_as_uint(M2))); }
    unsigned* ctr = (unsigned*)(p.ws + WS_CTL) + 128 * rep;
    int* sItem = (int*)(shm + 147456 - 64);
    const int myx = blockIdx.x & 7;
    for (;;) {
        __syncthreads();
        if (tid == 0) { int it = -1;
            for (int k = 0; k < 8; ++k) { const int q = (myx + k) & 7; const unsigned v = atomicAdd(ctr + 16 * q, 1u); if (v < 256u) { it = q * 256 + (int)v; break; } }
            *sItem = it; }
        __syncthreads();
        const int item = *sItem;
        if (item < 0) break;
        const int q = item >> 8, v = item & 255, b = v >> 6, qb = 63 - (v & 63);
        const int h = (b == 0) ? q : (b == 1) ? 7 - q : (b == 2) ? ((q + 4) & 7) : ((3 - q) & 7);
        attn_item(p, shm, b, h, qb, lam, M2);
    }
}

__device__ __forceinline__ void phase3(const Params& p, unsigned char* shm) {
    int tid_ = threadIdx.x; asm volatile("" : "+v"(tid_)); const int tid = tid_, lane = tid & 63, wave = tid >> 6, gw = blockIdx.x * 8 + wave, ngw = gridDim.x * 8;
    float* scr = (float*)(shm + wave * 8448);
    transpose_plain(p.w_out, D, D, (bf16_t*)(p.ws + WS_WOUT), scr, gw, ngw, lane);
    transpose_plain(p.w_up, D, 2 * DFF, (bf16_t*)(p.ws + WS_WUP), scr, gw, ngw, lane);
    transpose_plain(p.w_down, DFF, D, (bf16_t*)(p.ws + WS_WDN), scr, gw, ngw, lane);
    const bf16_t* HM = (const bf16_t*)(p.ws + WS_HM); const bf16_t* GA = (const bf16_t*)(p.ws + WS_GA); bf16_t* Y = (bf16_t*)(p.ws + WS_BQ); const bf16_t* YBp = (const bf16_t*)((const unsigned char*)p.out + DO_YB);
    for (int it = gw; it < T * 4; it += ngw) {
        const size_t off = (size_t)(it >> 2) * D + (it & 3) * 512 + 8 * lane;
        float hm[8], ga[8], yb[8]; unpack8(*(const u32x4*)(HM + off), hm); unpack8(*(const u32x4*)(GA + off), ga); unpack8(*(const u32x4*)(YBp + off), yb);
        float ss = 0.f;
#pragma unroll
        for (int e = 0; e < 8; ++e) ss += hm[e] * hm[e];
        const float rinv = rsqrtf(wave_sum(ss) * (1.f / 512.f) + EPS);
        const f32x4 g0 = *(const f32x4*)(p.mlstm_norm_g + (it & 3) * 512 + 8 * lane), g1 = *(const f32x4*)(p.mlstm_norm_g + (it & 3) * 512 + 8 * lane + 4);
        float y[8];
        y[0] = ga[0] * hm[0] * rinv * g0.x + yb[0]; y[1] = ga[1] * hm[1] * rinv * g0.y + yb[1]; y[2] = ga[2] * hm[2] * rinv * g0.z + yb[2]; y[3] = ga[3] * hm[3] * rinv * g0.w + yb[3];
        y[4] = ga[4] * hm[4] * rinv * g1.x + yb[4]; y[5] = ga[5] * hm[5] * rinv * g1.y + yb[5]; y[6] = ga[6] * hm[6] * rinv * g1.z + yb[6]; y[7] = ga[7] * hm[7] * rinv * g1.w + yb[7];
        *(u32x4*)(Y + off) = pack8(y);
    }
}
__device__ __forceinline__ void phase5(const Params& p) {
    int tid_ = threadIdx.x; asm volatile("" : "+v"(tid_)); const int tid = tid_, lane = tid & 63, wave = tid >> 6, gw = blockIdx.x * 8 + wave, ngw = gridDim.x * 8;
    bf16_t* H2 = (bf16_t*)(p.ws + WS_H2);
    for (int row = gw; row < T; row += ngw) {
        const f32x4* xr = (const f32x4*)(p.out + (size_t)row * D) + lane;
        f32x4 v[8]; float ss = 0.f;
#pragma unroll
        for (int j = 0; j < 8; ++j) { v[j] = xr[64 * j]; ss += (v[j].x * v[j].x + v[j].y * v[j].y) + (v[j].z * v[j].z + v[j].w * v[j].w); }
        const float rinv = rsqrtf(wave_sum(ss) * (1.f / D) + EPS);
        u32x2* o8 = (u32x2*)(H2 + (size_t)row * D) + lane;
#pragma unroll
        for (int j = 0; j < 8; ++j) { const f32x4 g = *((const f32x4*)p.norm2_g + lane + 64 * j);
            u32x2 o; o.x = cvt_pk_bf16(v[j].x * rinv * g.x, v[j].y * rinv * g.y); o.y = cvt_pk_bf16(v[j].z * rinv * g.z, v[j].w * rinv * g.w); o8[64 * j] = o; }
    }
}
__device__ __forceinline__ void phase7(const Params& p, int half) {
    const bf16_t* UP = (const bf16_t*)(p.ws + WS_UP); bf16_t* ACT = (bf16_t*)(p.ws + WS_ACT);
    int tid_ = threadIdx.x; asm volatile("" : "+v"(tid_)); const int gt = blockIdx.x * 512 + tid_, ngt = gridDim.x * 512;
    for (int idx = gt; idx < (TH / 16) * 704; idx += ngt) {
        const int oct = idx % 704, rb = idx / 704, c0 = 8 * oct, r0 = 16 * rb;
        float wg[3][8], wv[3][8], bg[8], bv[8];
#pragma unroll
        for (int j = 0; j < 3; ++j) {
            const f32x4 a = *(const f32x4*)(p.ffn_conv_w + (size_t)j * 2 * DFF + c0), b = *(const f32x4*)(p.ffn_conv_w + (size_t)j * 2 * DFF + c0 + 4);
            const f32x4 c = *(const f32x4*)(p.ffn_conv_w + (size_t)j * 2 * DFF + DFF + c0), d = *(const f32x4*)(p.ffn_conv_w + (size_t)j * 2 * DFF + DFF + c0 + 4);
            wg[j][0] = a.x; wg[j][1] = a.y; wg[j][2] = a.z; wg[j][3] = a.w; wg[j][4] = b.x; wg[j][5] = b.y; wg[j][6] = b.z; wg[j][7] = b.w;
            wv[j][0] = c.x; wv[j][1] = c.y; wv[j][2] = c.z; wv[j][3] = c.w; wv[j][4] = d.x; wv[j][5] = d.y; wv[j][6] = d.z; wv[j][7] = d.w;
        }
        { const f32x4 a = *(const f32x4*)(p.ffn_conv_b + c0), b = *(const f32x4*)(p.ffn_conv_b + c0 + 4), c = *(const f32x4*)(p.ffn_conv_b + DFF + c0), d = *(const f32x4*)(p.ffn_conv_b + DFF + c0 + 4);
          bg[0] = a.x; bg[1] = a.y; bg[2] = a.z; bg[3] = a.w; bg[4] = b.x; bg[5] = b.y; bg[6] = b.z; bg[7] = b.w; bv[0] = c.x; bv[1] = c.y; bv[2] = c.z; bv[3] = c.w; bv[4] = d.x; bv[5] = d.y; bv[6] = d.z; bv[7] = d.w; }
        float g2[8], g1[8], v2[8], v1[8];
        const bool has_prev = ((half * TH + r0) & (SEQ - 1)) != 0;
        if (has_prev) {
            unpack8(*(const u32x4*)(UP + (size_t)(r0 - 2) * (2 * DFF) + c0), g2); unpack8(*(const u32x4*)(UP + (size_t)(r0 - 1) * (2 * DFF) + c0), g1);
            unpack8(*(const u32x4*)(UP + (size_t)(r0 - 2) * (2 * DFF) + DFF + c0), v2); unpack8(*(const u32x4*)(UP + (size_t)(r0 - 1) * (2 * DFF) + DFF + c0), v1);
        } else {
#pragma unroll
            for (int e = 0; e < 8; ++e) { g2[e] = 0.f; g1[e] = 0.f; v2[e] = 0.f; v1[e] = 0.f; }
        }
#pragma unroll 4
        for (int rr = 0; rr < 16; ++rr) {
            float g0[8], v0[8], y[8];
            unpack8(*(const u32x4*)(UP + (size_t)(r0 + rr) * (2 * DFF) + c0), g0); unpack8(*(const u32x4*)(UP + (size_t)(r0 + rr) * (2 * DFF) + DFF + c0), v0);
#pragma unroll
            for (int e = 0; e < 8; ++e) {
                const float ug = bg[e] + wg[0][e] * g2[e] + wg[1][e] * g1[e] + wg[2][e] * g0[e];
                const float uv = bv[e] + wv[0][e] * v2[e] + wv[1][e] * v1[e] + wv[2][e] * v0[e];
                y[e] = ug * fsig(ug) * uv; g2[e] = g1[e]; g1[e] = g0[e]; v2[e] = v1[e]; v1[e] = v0[e];
            }
            *(u32x4*)(ACT + (size_t)(r0 + rr) * DFF + c0) = pack8(y);
        }
    }
}

#ifndef REP1
#define REP1 1
#endif
#ifndef REP3
#define REP3 1
#endif
__global__ void __launch_bounds__(512, 2) mega(Params p) {
    extern __shared__ __attribute__((aligned(16))) unsigned char shm[];
    cg::grid_group grid = cg::this_grid();
    bf16_t* H = (bf16_t*)((unsigned char*)p.out + DO_H); bf16_t* WinT = (bf16_t*)((unsigned char*)p.out + DO_WIN);
    bf16_t* H2 = (bf16_t*)(p.ws + WS_H2); bf16_t* UPb = (bf16_t*)(p.ws + WS_UP); bf16_t* ACTb = (bf16_t*)(p.ws + WS_ACT);
    const bf16_t* WoT = (const bf16_t*)(p.ws + WS_WOUT); const bf16_t* WuT = (const bf16_t*)(p.ws + WS_WUP); const bf16_t* WdT = (const bf16_t*)(p.ws + WS_WDN);
#define PH(i) (p.ph_lo <= (i) && (i) < p.ph_hi)
#define SYNC(i) do { if (p.ph_lo <= (i) && (i) + 1 < p.ph_hi) grid.sync(); } while (0)
    if (PH(0)) phase0(p, shm);
    SYNC(0);
    for (int rep = 0; rep < REP1; ++rep) { if (rep) grid.sync();
    if (PH(1)) { Epi1 E{(bf16_t*)(p.ws + WS_AQK), (bf16_t*)(p.ws + WS_VTM), (bf16_t*)(p.ws + WS_GA), (bf16_t*)(p.ws + WS_BQ), (bf16_t*)(p.ws + WS_BK), (bf16_t*)(p.ws + WS_VTD), (bf16_t*)(p.ws + WS_GB)};
        run_gemm(shm, H, WinT, T, 16384, D, E); } }
    SYNC(1);
    if (PH(2)) phase2a(p, shm);
    SYNC(2);
    for (int rep = 0; rep < REP3; ++rep) { if (rep) grid.sync(); if (PH(3)) phase2b(p, shm, rep); }
    SYNC(3);
    if (PH(4)) phase3(p, shm);
    SYNC(4);
    if (PH(5)) { EpiRes E{p.out, p.x, D}; run_gemm(shm, (const bf16_t*)(p.ws + WS_BQ), WoT, T, D, D, E); }
    SYNC(5);
    if (PH(6)) phase5(p);
    SYNC(6);
    if (PH(7)) { EpiB E{UPb, 2 * DFF}; run_gemm(shm, H2, WuT, TH, 2 * DFF, D, E); }
    SYNC(7);
    if (PH(8)) phase7(p, 0);
    SYNC(8);
    if (PH(9)) { { EpiRes E{p.out, p.out, D}; run_gemm(shm, ACTb, WdT, TH, D, DFF, E); }
                 { EpiB E{UPb, 2 * DFF}; run_gemm(shm, H2 + (size_t)TH * D, WuT, TH, 2 * DFF, D, E); } }
    SYNC(9);
    if (PH(10)) phase7(p, 1);
    SYNC(10);
    if (PH(11)) { EpiRes E{p.out + (size_t)TH * D, p.out + (size_t)TH * D, D}; run_gemm(shm, ACTb, WdT, TH, D, DFF, E); }
#undef PH
#undef SYNC
}

#ifndef N_LAUNCHES
#define N_LAUNCHES 1
#endif
extern "C" void kernel_launch(void* const* d_in, const int* in_sizes, int n_in, void* d_out, int out_size, void* d_ws, size_t ws_size, hipStream_t stream) {
    static int grid = 0;
    if (grid == 0) {
        if (n_in != 17 || out_size != T * D || ws_size < WS_END) { fprintf(stderr, "kernel_launch: unexpected problem (n_in %d, out %d, ws %zu)\n", n_in, out_size, ws_size); grid = -1; return; }
        int dev = 0, cus = 0, per_cu = 0;
        if (hipGetDevice(&dev) != hipSuccess || hipDeviceGetAttribute(&cus, hipDeviceAttributeMultiprocessorCount, dev) != hipSuccess) { grid = -1; return; }
        if (hipFuncSetAttribute((const void*)mega, hipFuncAttributeMaxDynamicSharedMemorySize, LDS_BYTES) != hipSuccess) { fprintf(stderr, "kernel_launch: hipFuncSetAttribute failed\n"); grid = -1; return; }
        if (hipOccupancyMaxActiveBlocksPerMultiprocessor(&per_cu, (const void*)mega, 512, LDS_BYTES) != hipSuccess || per_cu < 1) { fprintf(stderr, "kernel_launch: occupancy query says %d\n", per_cu); per_cu = 1; }
        (void)hipGetLastError();
        grid = cus * per_cu;
    }
    if (grid < 0) return;
    if (hipMemsetAsync((char*)d_ws + WS_CTL, 0, 4096, stream) != hipSuccess) { fprintf(stderr, "kernel_launch: memset failed\n"); return; }
    Params p{};
    const float** pp = (const float**)&p;
    for (int i = 0; i < 17; ++i) pp[i] = (const float*)d_in[i];
    p.out = (float*)d_out; p.ws = (unsigned char*)d_ws;
    constexpr int NPH = 12;
    for (int li = 0; li < N_LAUNCHES; ++li) {
        p.ph_lo = (N_LAUNCHES == 1) ? 0 : li; p.ph_hi = (N_LAUNCHES == 1) ? NPH : li + 1;
        void* args[] = {&p};
        hipError_t e = hipLaunchCooperativeKernel((const void*)mega, dim3(grid), dim3(512), args, LDS_BYTES, stream);
        if (e != hipSuccess) { fprintf(stderr, "cooperative launch failed: %s (grid %d)\n", hipGetErrorString(e), grid); break; }
    }
}
```

```cpp
#include <hip/hip_runtime.h>
#include <hip/hip_cooperative_groups.h>
#include <cstdio>
#include <cstdint>
namespace cg = cooperative_groups;
namespace pg8 {
#define PG8_LAS __attribute__((address_space(3)))
typedef unsigned short bf16_t;
typedef short bf16x8 __attribute__((ext_vector_type(8)));
typedef float f32x4 __attribute__((ext_vector_type(4)));
typedef unsigned u32x4 __attribute__((ext_vector_type(4)));
constexpr int BM = 256, BK = 64, HALF = 128, HTB = HALF * BK * 2  , STAGE_BYTES = 8 * HTB, NXCD = 8, WGM = 8;

__host__ __device__ __forceinline__ int lds_byte(int r, int c) { const int st = (r >> 4) * 2 + (c >> 5), rr = r & 15, cc = c & 31, ob = rr * 64 + cc * 2; return st * 1024 + (ob ^ (((ob >> 9) & 1) << 5)); }
__host__ __device__ __forceinline__ void stage_rc(int b, int& R, int& C) { const int st = b / 1024, sb = b % 1024, swz = sb ^ (((sb >> 9) & 1) << 5); R = (st >> 1) * 16 + swz / 64; C = (st & 1) * 32 + (swz % 64) / 2; }
__host__ __device__ __forceinline__ int perm32(int rho) { const int n = rho >> 4, i = rho & 15; return 8 * (i >> 2) + 4 * n + (i & 3); }

struct Unit { int pm, pn; };
struct Gemm { const bf16_t* A; const bf16_t* Bt; int M, N, K; };

struct StaticOrder {
    int nM, nN, nwg, G, c;
    __host__ __device__ void init(int M, int N, int G_, int c_) { nM = M / BM; nN = N / BM; nwg = nM * nN; G = G_; c = c_; }
    __host__ __device__ bool next(int i, Unit& u) const {
        const long L = (long)i * G + c; if (L >= nwg) return false;
        int wgid = (int)L; { const int q = nwg / NXCD, r = nwg % NXCD, xcd = wgid % NXCD, off = wgid / NXCD; wgid = (xcd < r ? xcd * (q + 1) : r * (q + 1) + (xcd - r) * q) + off; }
        const int nig = WGM * nN, gid = wgid / nig, fm = gid * WGM, gsz = (nM - fm) < WGM ? (nM - fm) : WGM;
        u.pm = fm + ((wgid % nig) % gsz); u.pn = (wgid % nig) / gsz; return true;
    }
    __device__ __forceinline__ void a_ready(const Unit&) const {}
    __device__ __forceinline__ void done(const Unit&) const {}
};
__device__ __forceinline__ unsigned cvt_pk_bf16(float lo, float hi) { unsigned r; asm volatile("v_cvt_pk_bf16_f32 %0, %1, %2" : "=v"(r) : "v"(lo), "v"(hi)); return r; }
template <class Epi, class Sched, bool STAMP = false>
__device__ __forceinline__ void gemm_phase(PG8_LAS unsigned char* lds, const Gemm g, const Sched& S, const Epi& E, unsigned long long* stamps) {
    int tid_ = threadIdx.x; asm volatile("" : "+v"(tid_)); const int tid = tid_, wid = __builtin_amdgcn_readfirstlane(tid >> 6), lane = tid & 63, wr = wid >> 2, wc = wid & 3, fr = lane & 15, fq = lane >> 4;
    const int K = g.K, nt = K / BK;
    int ts_lo = 0, ts_hi = 0, nts = 0; const unsigned long long rt_entry = STAMP ? (unsigned long long)wall_clock64() : 0ull;
#define PG8_STAMP() do { if (STAMP && wid == 0 && nts < 64) { const unsigned long long _c = (unsigned long long)clock64(); \
        ts_lo = (lane == nts) ? (int)(unsigned)_c : ts_lo; ts_hi = (lane == nts) ? (int)(unsigned)(_c >> 32) : ts_hi; ++nts; } } while (0)
    PG8_STAMP();
    unsigned voffA[2], voffB[2];
#pragma unroll
    for (int i = 0; i < 2; ++i) { int R, C; stage_rc(tid * 16 + i * 8192, R, C); const int Rb = Epi::PERM ? ((R & ~31) + perm32(R & 31)) : R;
        voffA[i] = (unsigned)(R * K + C) * 2u; voffB[i] = (unsigned)(Rb * K + C) * 2u; }
    const size_t kstep = (size_t)(BK * 2);
    const size_t hstep = (size_t)HALF * K * 2;
    const size_t tstep = 2 * hstep;
    const unsigned ldsw = (unsigned)wid * 1024u;
    const int aoff = lds_byte(wr * 64 + fr, fq * 8), boff = lds_byte(wc * 32 + fr, fq * 8);
#define PG8_SA(b, h) (((b) * 2 + (h)) * HTB)
#define PG8_SB(b, h) ((4 + (b) * 2 + (h)) * HTB)
#define PG8_STAGE(bufoff, gbase, voff) do { _Pragma("unroll") for (int _i = 0; _i < 2; ++_i) \
        __builtin_amdgcn_global_load_lds((const unsigned*)((const char*)(gbase) + (voff)[_i]), (PG8_LAS unsigned*)(lds + (bufoff) + ldsw + _i * 8192), 16, 0, 0); } while (0)
#define PG8_LDA(dst, b, h) do { _Pragma("unroll") for (int m = 0; m < 4; ++m) _Pragma("unroll") for (int k = 0; k < 2; ++k) dst[m][k] = *(const PG8_LAS bf16x8*)(lds + PG8_SA(b, h) + aoff + m * 2048 + k * 1024); } while (0)
#define PG8_LDB(dst, b, h) do { _Pragma("unroll") for (int n = 0; n < 2; ++n) _Pragma("unroll") for (int k = 0; k < 2; ++k) dst[n][k] = *(const PG8_LAS bf16x8*)(lds + PG8_SB(b, h) + boff + n * 2048 + k * 1024); } while (0)
#define PG8_MMA(ai, bj, At, Bt) do { __builtin_amdgcn_s_setprio(1); _Pragma("unroll") for (int m = 0; m < 4; ++m) _Pragma("unroll") for (int n = 0; n < 2; ++n) _Pragma("unroll") for (int k = 0; k < 2; ++k) \
        acc[ai][bj][m][n] = __builtin_amdgcn_mfma_f32_16x16x32_bf16(Bt[n][k], At[m][k], acc[ai][bj][m][n], 0, 0, 0); __builtin_amdgcn_s_setprio(0); } while (0)
#define PG8_WAIT_V(n) asm volatile("s_waitcnt vmcnt(" #n ")" ::: "memory")
#define PG8_WAIT_L(n) asm volatile("s_waitcnt lgkmcnt(" #n ")" ::: "memory")
#define PG8_BAR __builtin_amdgcn_s_barrier()
#define PG8_SCHED __builtin_amdgcn_sched_barrier(0)
    Unit cur, nxt; int ui = 0;
    if (!S.next(0, cur)) return;
    f32x4 acc[2][2][4][2];
#pragma unroll
    for (int a = 0; a < 2; ++a)
#pragma unroll
        for (int b = 0; b < 2; ++b)
#pragma unroll
            for (int m = 0; m < 4; ++m)
#pragma unroll
                for (int n = 0; n < 2; ++n) acc[a][b][m][n] = (f32x4){0.f, 0.f, 0.f, 0.f};
    bf16x8 At[4][2], B0[2][2], B1[2][2];
    const char* cA = (const char*)g.A + (size_t)cur.pm * tstep; const char* cB = (const char*)g.Bt + (size_t)cur.pn * tstep;
    S.a_ready(cur);
    PG8_STAGE(PG8_SB(0, 0), cB, voffB); PG8_STAGE(PG8_SA(0, 0), cA, voffA); PG8_STAGE(PG8_SB(0, 1), cB + hstep, voffB); PG8_STAGE(PG8_SA(0, 1), cA + hstep, voffA);
    if (wr == 1) PG8_BAR;
    PG8_WAIT_V(4); PG8_BAR;
    PG8_STAGE(PG8_SB(1, 0), cB + kstep, voffB); PG8_STAGE(PG8_SA(1, 0), cA + kstep, voffA); PG8_STAGE(PG8_SB(1, 1), cB + hstep + kstep, voffB);
    PG8_WAIT_V(6); PG8_BAR;
    PG8_STAMP();
    for (;;) {
        const bool has_next = S.next(ui + 1, nxt);
        const char* nA = has_next ? (const char*)g.A + (size_t)nxt.pm * tstep : cA; const char* nB = has_next ? (const char*)g.Bt + (size_t)nxt.pn * tstep : cB;
        for (int t = 0; t < nt; t += 2) {
            const bool last = (t == nt - 2);
            const char* a1 = cA + (size_t)(t + 1) * kstep;
            const char* a2 = last ? nA : cA + (size_t)(t + 2) * kstep; const char* b2 = last ? nB : cB + (size_t)(t + 2) * kstep;
            const char* a3 = a2 + kstep; const char* b3 = b2 + kstep;
            if (last && has_next) S.a_ready(nxt);
            PG8_LDB(B0, 0, 0); PG8_SCHED; PG8_LDA(At, 0, 0); PG8_STAGE(PG8_SA(1, 1), a1 + hstep, voffA);
            PG8_WAIT_L(8); PG8_BAR; PG8_WAIT_L(0); PG8_MMA(0, 0, At, B0); PG8_BAR; PG8_SCHED;
            PG8_LDB(B1, 0, 1); PG8_STAGE(PG8_SB(0, 0), b2, voffB);
            PG8_BAR; PG8_WAIT_L(0); PG8_MMA(0, 1, At, B1); PG8_BAR;
            PG8_LDA(At, 0, 1); PG8_STAGE(PG8_SA(0, 0), a2, voffA);
            PG8_BAR; PG8_WAIT_L(0); PG8_MMA(1, 0, At, B0); PG8_BAR; PG8_SCHED;
            PG8_STAGE(PG8_SB(0, 1), b2 + hstep, voffB);
            PG8_WAIT_V(6); PG8_BAR; PG8_MMA(1, 1, At, B1); PG8_BAR;
            PG8_LDB(B0, 1, 0); PG8_SCHED; PG8_LDA(At, 1, 0); PG8_STAGE(PG8_SA(0, 1), a2 + hstep, voffA);
            PG8_WAIT_L(8); PG8_BAR; PG8_WAIT_L(0); PG8_MMA(0, 0, At, B0); PG8_BAR; PG8_SCHED;
            PG8_LDB(B1, 1, 1); PG8_STAGE(PG8_SB(1, 0), b3, voffB);
            PG8_BAR; PG8_WAIT_L(0); PG8_MMA(0, 1, At, B1); PG8_BAR;
            PG8_LDA(At, 1, 1); PG8_STAGE(PG8_SA(1, 0), a3, voffA);
            PG8_BAR; PG8_WAIT_L(0); PG8_MMA(1, 0, At, B0); PG8_BAR; PG8_SCHED;
            PG8_STAGE(PG8_SB(1, 1), b3 + hstep, voffB);
            PG8_WAIT_V(6); PG8_BAR; PG8_MMA(1, 1, At, B1); PG8_BAR;
        }
        PG8_STAMP();
        if constexpr (!Epi::AFTER_DRAIN) { E(acc, cur, wr, wc, fr, fq); S.done(cur); }
        PG8_STAMP();
        if (!has_next) break;
#pragma unroll
        for (int a = 0; a < 2; ++a)
#pragma unroll
            for (int b = 0; b < 2; ++b)
#pragma unroll
                for (int m = 0; m < 4; ++m)
#pragma unroll
                    for (int n = 0; n < 2; ++n) acc[a][b][m][n] = (f32x4){0.f, 0.f, 0.f, 0.f};
        cur = nxt; cA = nA; cB = nB; ++ui;
    }
    PG8_WAIT_V(0);
    if (wr == 0) PG8_BAR;
    PG8_BAR;
    if constexpr (Epi::AFTER_DRAIN) { E.fused(acc, cur, wr, wc, fr, fq, lds, wid, lane); S.done(cur); }
    PG8_STAMP();
    if (STAMP && wid == 0) { stamps[lane] = lane < nts ? (((unsigned long long)(unsigned)ts_hi << 32) | (unsigned)ts_lo) : 0ull;
        if (lane == 62) stamps[62] = rt_entry; if (lane == 63) stamps[63] = (unsigned long long)wall_clock64(); }
#undef PG8_STAMP
#undef PG8_SA
#undef PG8_SB
#undef PG8_STAGE
#undef PG8_LDA
#undef PG8_LDB
#undef PG8_MMA
#undef PG8_WAIT_V
#undef PG8_WAIT_L
#undef PG8_BAR
#undef PG8_SCHED
}
}
using pg8::bf16_t; using pg8::bf16x8; using pg8::f32x4; using pg8::u32x4; using pg8::cvt_pk_bf16;
typedef unsigned u32x2 __attribute__((ext_vector_type(2)));
typedef float f32x16 __attribute__((ext_vector_type(16)));

constexpr int T = 32768, D = 2048, SEQ = 8192, PIN = 16392, DFF = 5632, TH = 16384;
constexpr float EPS = 1e-6f, LOG2E = 1.4426950408889634f;
constexpr size_t MiB = (size_t)1 << 20;
constexpr size_t WS_CTL = 0, WS_GIF = 1 * MiB, WS_KT = 2 * MiB, WS_AQK = 66 * MiB, WS_VTM = 194 * MiB, WS_GA = 322 * MiB, WS_BQ = 450 * MiB, WS_BK = 578 * MiB,
                 WS_VTD = 706 * MiB, WS_GB = 834 * MiB, WS_END = 962 * MiB;
constexpr size_t WS_HM = WS_AQK, WS_H2 = WS_AQK, WS_WOUT = WS_VTM, WS_WUP = WS_VTM + 8 * MiB, WS_WDN = WS_VTM + 52 * MiB, WS_ACT = WS_GA, WS_SB = 674 * MiB;
constexpr size_t DO_H = 0, DO_Q2 = 0, DO_K2 = 64 * MiB, DO_WIN = 128 * MiB, DO_YB = 128 * MiB;
constexpr int LDS_BYTES = 147456;

struct Params {
    const float *x, *norm1_g, *w_in, *if_bias, *qk_conv_w, *qk_conv_b, *mlstm_norm_g, *q_norm_g, *k_norm_g, *diff_lambda, *subln_g, *w_out, *norm2_g, *w_up, *ffn_conv_w, *ffn_conv_b, *w_down;
    float* out; unsigned char* ws; int ph_lo, ph_hi;
};

__device__ __forceinline__ void lds_wait() { asm volatile("s_waitcnt lgkmcnt(0)" ::: "memory"); }
__device__ __forceinline__ float bflo(unsigned u) { return __uint_as_float(u << 16); }
__device__ __forceinline__ float bfhi(unsigned u) { return __uint_as_float(u & 0xffff0000u); }
__device__ __forceinline__ float fsig(float v) { return __builtin_amdgcn_rcpf(1.f + __expf(-v)); }
__device__ __forceinline__ float wave_sum(float v) {
#pragma unroll
    for (int o = 1; o < 64; o <<= 1) v += __shfl_xor(v, o);
    return v;
}
__device__ __forceinline__ void unpack8(u32x4 u, float (&f)[8]) {
    f[0] = bflo(u.x); f[1] = bfhi(u.x); f[2] = bflo(u.y); f[3] = bfhi(u.y); f[4] = bflo(u.z); f[5] = bfhi(u.z); f[6] = bflo(u.w); f[7] = bfhi(u.w);
}
__device__ __forceinline__ u32x4 pack8(const float (&f)[8]) {
    u32x4 o; o.x = cvt_pk_bf16(f[0], f[1]); o.y = cvt_pk_bf16(f[2], f[3]); o.z = cvt_pk_bf16(f[4], f[5]); o.w = cvt_pk_bf16(f[6], f[7]); return o;
}

__device__ __forceinline__ void transpose_item(const float* __restrict__ W, size_t ldw, int K, bf16_t* WT, int k0, int srcn0, int dstn0, float* scr, int lane) {
#pragma unroll 8
    for (int i = 0; i < 32; ++i) { const int kk = 2 * i + (lane >> 5); scr[kk * 33 + (lane & 31)] = W[(size_t)(k0 + kk) * ldw + srcn0 + (lane & 31)]; }
    lds_wait();
    const int c = lane & 7;
#pragma unroll
    for (int j = 0; j < 4; ++j) { const int n = (lane >> 3) + 8 * j; const float* s = scr + (8 * c) * 33 + n;
        u32x4 o; o.x = cvt_pk_bf16(s[0], s[33]); o.y = cvt_pk_bf16(s[66], s[99]); o.z = cvt_pk_bf16(s[132], s[165]); o.w = cvt_pk_bf16(s[198], s[231]);
        *(u32x4*)(WT + (size_t)(dstn0 + n) * K + k0 + 8 * c) = o; }
    lds_wait();
}
__device__ __forceinline__ int win_src(int n) {
    if (n < 4096) return n;
    if (n < 8192) { const int p = (n - 4096) >> 8, j = (n - 4096) & 255; return j < 128 ? 4096 + 128 * p + j : 12296 + 128 * p + (j - 128); }
    if (n < 10240) return 6152 + (n - 8192);
    if (n < 12288) return 8200 + (n - 10240);
    if (n < 14336) return 10248 + (n - 12288);
    return 14344 + (n - 14336);
}
__device__ __forceinline__ void transpose_plain(const float* W, int K, int N, bf16_t* WT, float* scr, int gw, int ngw, int lane) {
    const int nblk = N / 32, nitems = (K / 64) * nblk;
    for (int it = gw; it < nitems; it += ngw) { const int kb = it / nblk, nb = it % nblk; transpose_item(W, (size_t)N, K, WT, 64 * kb, 32 * nb, 32 * nb, scr, lane); }
}

__device__ __forceinline__ void phase0(const Params& p, unsigned char* shm) {
    int tid_ = threadIdx.x; asm volatile("" : "+v"(tid_)); const int tid = tid_, lane = tid & 63, wave = tid >> 6, gw = blockIdx.x * 8 + wave, ngw = gridDim.x * 8;
    float* scr = (float*)(shm + wave * 8448);
    bf16_t* WinT = (bf16_t*)((unsigned char*)p.out + DO_WIN);
    { const int nblk = 16384 / 32, nitems = (D / 64) * nblk;
      for (int it = gw; it < nitems; it += ngw) { const int kb = it / nblk, nb = it % nblk; transpose_item(p.w_in, (size_t)PIN, D, WinT, 64 * kb, win_src(32 * nb), 32 * nb, scr, lane); } }
    float* wifT = (float*)(shm + 69632);
    for (int idx = tid; idx < 8 * D; idx += 512) { const int k = idx >> 3, j = idx & 7; wifT[j * D + k] = p.w_in[(size_t)k * PIN + 6144 + j]; }
    __syncthreads();
    bf16_t* H = (bf16_t*)((unsigned char*)p.out + DO_H);
    float* GIF = (float*)(p.ws + WS_GIF);
    for (int row = gw; row < T; row += ngw) {
        const f32x4* xr = (const f32x4*)(p.x + (size_t)row * D) + lane;
        f32x4 v[8]; float ss = 0.f;
#pragma unroll
        for (int j = 0; j < 8; ++j) { v[j] = xr[64 * j]; ss += (v[j].x * v[j].x + v[j].y * v[j].y) + (v[j].z * v[j].z + v[j].w * v[j].w); }
        const float rinv = rsqrtf(wave_sum(ss) * (1.f / D) + EPS);
        float ga[8];
#pragma unroll
        for (int j = 0; j < 8; ++j) ga[j] = 0.f;
        u32x2* o8 = (u32x2*)(H + (size_t)row * D) + lane;
#pragma unroll
        for (int j = 0; j < 8; ++j) {
            const f32x4 g = *((const f32x4*)p.norm1_g + lane + 64 * j);
            f32x4 h; h.x = v[j].x * rinv * g.x; h.y = v[j].y * rinv * g.y; h.z = v[j].z * rinv * g.z; h.w = v[j].w * rinv * g.w;
            u32x2 o; o.x = cvt_pk_bf16(h.x, h.y); o.y = cvt_pk_bf16(h.z, h.w); o8[64 * j] = o;
#pragma unroll
            for (int q = 0; q < 8; ++q) { const f32x4 w = *((const f32x4*)(wifT + q * D) + lane + 64 * j); ga[q] += (h.x * w.x + h.y * w.y) + (h.z * w.z + h.w * w.w); }
        }
#pragma unroll
        for (int q = 0; q < 8; ++q) ga[q] = wave_sum(ga[q]);
        if (lane < 8) {
            float val = 0.f;
#pragma unroll
            for (int q = 0; q < 8; ++q) val = (lane == q) ? ga[q] : val;
            val += p.if_bias[lane];
            if (lane >= 4) val = fminf(val, 0.f) - log1pf(expf(-fabsf(val)));
            GIF[(size_t)row * 8 + lane] = val;
        }
    }
}

struct Epi1 {
    static constexpr bool PERM = true, AFTER_DRAIN = false;
    bf16_t *aqk, *vtm, *ga, *bq, *bk, *vtd, *gb;
    __device__ __forceinline__ void operator()(const f32x4 (&acc)[2][2][4][2], const pg8::Unit& u, int wr, int wc, int fr, int fq) const {
        const int pn = u.pn, row0 = u.pm * 256 + wr * 64 + fr, cw = wc * 32 + 8 * fq;
        if (pn >= 16 && pn < 32) {
            const int cb = 128 * (pn - 16) + cw;
#pragma unroll
            for (int ai = 0; ai < 2; ++ai)
#pragma unroll
                for (int m = 0; m < 4; ++m) {
                    const size_t row = (size_t)(row0 + ai * 128 + m * 16);
                    float f[8];
#pragma unroll
                    for (int j = 0; j < 4; ++j) { f[j] = fsig(acc[ai][0][m][0][j]) * fsig(acc[ai][1][m][0][j]); f[4 + j] = fsig(acc[ai][0][m][1][j]) * fsig(acc[ai][1][m][1][j]); }
                    *(u32x4*)(ga + row * D + cb) = pack8(f);
                }
            return;
        }
        bf16_t* dst; int col0; int mode;
        if (pn < 8) { dst = aqk; col0 = 256 * pn; mode = 0; }
        else if (pn < 16) { dst = vtm; col0 = 256 * (pn - 8); mode = 1; }
        else if (pn < 40) { dst = bq; col0 = 256 * (pn - 32); mode = 0; }
        else if (pn < 48) { dst = bk; col0 = 256 * (pn - 40); mode = 0; }
        else if (pn < 56) { dst = vtd; col0 = 256 * (pn - 48); mode = 3; }
        else { dst = gb; col0 = 256 * (pn - 56); mode = 2; }
#pragma unroll
        for (int ai = 0; ai < 2; ++ai)
#pragma unroll
            for (int m = 0; m < 4; ++m) {
                const int row = row0 + ai * 128 + m * 16;
#pragma unroll
                for (int bj = 0; bj < 2; ++bj) {
                    const int col = col0 + bj * 128 + cw;
                    float f[8];
#pragma unroll
                    for (int j = 0; j < 4; ++j) { f[j] = acc[ai][bj][m][0][j]; f[4 + j] = acc[ai][bj][m][1][j]; }
                    if (mode == 2) {
#pragma unroll
                        for (int j = 0; j < 8; ++j) f[j] = fsig(f[j]);
                    }
                    const u32x4 w = pack8(f);
                    if (mode == 3) {
                        bf16_t* d = dst + (((size_t)((row >> 13) * 8 + (col >> 8)) * 256 + ((row & (SEQ - 1)) >> 5)) * 256 + (col & 255)) * 32 + (row & 31);
                        d[0] = (bf16_t)(w.x & 0xffff); d[32] = (bf16_t)(w.x >> 16); d[64] = (bf16_t)(w.y & 0xffff); d[96] = (bf16_t)(w.y >> 16);
                        d[128] = (bf16_t)(w.z & 0xffff); d[160] = (bf16_t)(w.z >> 16); d[192] = (bf16_t)(w.w & 0xffff); d[224] = (bf16_t)(w.w >> 16);
                    } else if (mode == 1) {
                        bf16_t* d = dst + ((size_t)((row >> 13) * D + col)) * SEQ + (row & (SEQ - 1));
                        d[0 * (size_t)SEQ] = (bf16_t)(w.x & 0xffff); d[1 * (size_t)SEQ] = (bf16_t)(w.x >> 16); d[2 * (size_t)SEQ] = (bf16_t)(w.y & 0xffff); d[3 * (size_t)SEQ] = (bf16_t)(w.y >> 16);
                        d[4 * (size_t)SEQ] = (bf16_t)(w.z & 0xffff); d[5 * (size_t)SEQ] = (bf16_t)(w.z >> 16); d[6 * (size_t)SEQ] = (bf16_t)(w.w & 0xffff); d[7 * (size_t)SEQ] = (bf16_t)(w.w >> 16);
                    } else {
                        *(u32x4*)(dst + (size_t)row * D + col) = w;
                    }
                }
            }
    }
};
struct EpiRes {
    static constexpr bool PERM = false, AFTER_DRAIN = false;
    float* C; const float* R; int ldc;
    __device__ __forceinline__ void operator()(const f32x4 (&acc)[2][2][4][2], const pg8::Unit& u, int wr, int wc, int fr, int fq) const {
        const int row0 = u.pm * 256 + wr * 64 + fr, col0 = u.pn * 256 + wc * 32 + 4 * fq;
#pragma unroll
        for (int ai = 0; ai < 2; ++ai)
#pragma unroll
            for (int m = 0; m < 4; ++m) {
                const size_t off = (size_t)(row0 + ai * 128 + m * 16) * ldc + col0;
#pragma unroll
                for (int bj = 0; bj < 2; ++bj)
#pragma unroll
                    for (int n = 0; n < 2; ++n) { const f32x4 r = *(const f32x4*)(R + off + bj * 128 + n * 16); *(f32x4*)(C + off + bj * 128 + n * 16) = acc[ai][bj][m][n] + r; }
            }
    }
};
struct EpiB {
    static constexpr bool PERM = true, AFTER_DRAIN = false;
    bf16_t* O; int ldc;
    __device__ __forceinline__ void operator()(const f32x4 (&acc)[2][2][4][2], const pg8::Unit& u, int wr, int wc, int fr, int fq) const {
        const int row0 = u.pm * 256 + wr * 64 + fr, col0 = u.pn * 256 + wc * 32 + 8 * fq;
#pragma unroll
        for (int ai = 0; ai < 2; ++ai)
#pragma unroll
            for (int m = 0; m < 4; ++m) {
                bf16_t* rowp = O + (size_t)(row0 + ai * 128 + m * 16) * ldc + col0;
#pragma unroll
                for (int bj = 0; bj < 2; ++bj) {
                    u32x4 w; w.x = cvt_pk_bf16(acc[ai][bj][m][0][0], acc[ai][bj][m][0][1]); w.y = cvt_pk_bf16(acc[ai][bj][m][0][2], acc[ai][bj][m][0][3]);
                    w.z = cvt_pk_bf16(acc[ai][bj][m][1][0], acc[ai][bj][m][1][1]); w.w = cvt_pk_bf16(acc[ai][bj][m][1][2], acc[ai][bj][m][1][3]);
                    *(u32x4*)(rowp + bj * 128) = w;
                }
            }
    }
};
template <class Epi> __device__ __forceinline__ void run_gemm(unsigned char* shm, const bf16_t* A, const bf16_t* Bt, int M, int N, int K, const Epi& E) {
    pg8::Gemm g{A, Bt, M, N, K};
    pg8::StaticOrder S; S.init(M, N, (int)gridDim.x, (int)blockIdx.x);
    pg8::gemm_phase<Epi, pg8::StaticOrder, false>((PG8_LAS unsigned char*)shm, g, S, E, nullptr);
}

__device__ __forceinline__ void phase2a(const Params& p, unsigned char* shm) {
    int tid_ = threadIdx.x; asm volatile("" : "+v"(tid_)); const int tid = tid_, lane = tid & 63, wave = tid >> 6;
    const bf16_t* AQK = (const bf16_t*)(p.ws + WS_AQK);
    bf16_t* Q2 = (bf16_t*)((unsigned char*)p.out + DO_Q2); bf16_t* K2 = (bf16_t*)((unsigned char*)p.out + DO_K2); bf16_t* KT = (bf16_t*)(p.ws + WS_KT);
    bf16_t* tl = (bf16_t*)shm;
    for (int item = blockIdx.x; item < 256 * 32; item += gridDim.x) {
        const int ch = item >> 5, cgp = item & 31, t0 = ch * 128, oct = tid & 7, rg = tid >> 3, c0 = 64 * cgp + 8 * oct;
        float w[4][8], bias[8];
#pragma unroll
        for (int j = 0; j < 4; ++j) { const f32x4 a = *(const f32x4*)(p.qk_conv_w + j * D + c0), b = *(const f32x4*)(p.qk_conv_w + j * D + c0 + 4);
            w[j][0] = a.x; w[j][1] = a.y; w[j][2] = a.z; w[j][3] = a.w; w[j][4] = b.x; w[j][5] = b.y; w[j][6] = b.z; w[j][7] = b.w; }
        { const f32x4 a = *(const f32x4*)(p.qk_conv_b + c0), b = *(const f32x4*)(p.qk_conv_b + c0 + 4);
          bias[0] = a.x; bias[1] = a.y; bias[2] = a.z; bias[3] = a.w; bias[4] = b.x; bias[5] = b.y; bias[6] = b.z; bias[7] = b.w; }
        float in[5][8];
        const int rl0 = 2 * rg;
#pragma unroll
        for (int k = 0; k < 5; ++k) {
            const int rl = rl0 - 3 + k; const int sp = (t0 & (SEQ - 1)) + rl;
            if (sp >= 0) { const u32x4 u = *(const u32x4*)(AQK + (size_t)(t0 + rl) * D + c0); unpack8(u, in[k]); }
            else {
#pragma unroll
                for (int e = 0; e < 8; ++e) in[k][e] = 0.f; }
        }
        const bool isq = cgp < 16;
#pragma unroll
        for (int rr = 0; rr < 2; ++rr) {
            float y[8];
#pragma unroll
            for (int e = 0; e < 8; ++e) { float a = bias[e]; a += w[0][e] * in[rr][e]; a += w[1][e] * in[rr + 1][e]; a += w[2][e] * in[rr + 2][e]; a += w[3][e] * in[rr + 3][e];
                a = a * fsig(a); y[e] = isq ? a * 0.0625f : a; }
            const u32x4 o = pack8(y);
            const size_t row = (size_t)(t0 + rl0 + rr);
            if (isq) *(u32x4*)(Q2 + row * 1024 + c0) = o;
            else {
                *(u32x4*)(K2 + row * 1024 + (c0 - 1024)) = o;
            }
        }
    }
    {
        bf16_t* BQ = (bf16_t*)(p.ws + WS_BQ); bf16_t* BK = (bf16_t*)(p.ws + WS_BK);
        const int e16 = lane & 15, sub = lane >> 4;
        const float qs = 0.08838834764831845f * LOG2E;
        const f32x4 gq0 = *(const f32x4*)(p.q_norm_g + 8 * e16), gq1 = *(const f32x4*)(p.q_norm_g + 8 * e16 + 4);
        const f32x4 gk0 = *(const f32x4*)(p.k_norm_g + 8 * e16), gk1 = *(const f32x4*)(p.k_norm_g + 8 * e16 + 4);
        const int gwv = blockIdx.x * 8 + wave, ngw = gridDim.x * 8;
        for (int it = gwv; it < T * 16 / 4; it += ngw) {
            const int gid = it * 4 + sub, t = gid >> 4, grp = 16 + (gid & 15);
            const bool isq = false;
            bf16_t* ptr = (isq ? BQ : BK) + (size_t)t * D + 128 * (grp & 15) + 8 * e16;
            float f[8]; unpack8(*(const u32x4*)ptr, f);
            float ss = 0.f;
#pragma unroll
            for (int e = 0; e < 8; ++e) ss += f[e] * f[e];
            ss += __shfl_xor(ss, 1); ss += __shfl_xor(ss, 2); ss += __shfl_xor(ss, 4); ss += __shfl_xor(ss, 8);
            const float rinv = rsqrtf(ss * (1.f / 128.f) + EPS) * (isq ? qs : 1.f);
            const f32x4 g0 = isq ? gq0 : gk0, g1 = isq ? gq1 : gk1;
            f[0] *= rinv * g0.x; f[1] *= rinv * g0.y; f[2] *= rinv * g0.z; f[3] *= rinv * g0.w; f[4] *= rinv * g1.x; f[5] *= rinv * g1.y; f[6] *= rinv * g1.z; f[7] *= rinv * g1.w;
            *(u32x4*)ptr = pack8(f);
        }
    }
}

constexpr int ML_KL = 0, ML_CT = 67584, ML_VT = 101376, ML_A = 118784, ML_MM = 119296, ML_BB = 119808, ML_WS = 120320, ML_N = 120832, ML_MISC = 121856;
typedef short s16x4 __attribute__((ext_vector_type(4)));
#define ML_SB __builtin_amdgcn_sched_barrier(0)
#define ML_MFMA(a_, b_, c_) __builtin_amdgcn_mfma_f32_16x16x32_bf16(a_, b_, c_, 0, 0, 0)
__device__ __forceinline__ void ml_chain2(const unsigned char* baseA, const unsigned char* baseB, const bf16x8 (&qf)[8], f32x4& SA, f32x4& SB) {
    bf16x8 f0 = *(const bf16x8*)(baseA), f1 = *(const bf16x8*)(baseB), f2 = *(const bf16x8*)(baseA + 16), f3 = *(const bf16x8*)(baseB + 16);
    ML_SB;
#pragma unroll
    for (int ks = 0; ks < 8; ks += 2) {
        SA = ML_MFMA(f0, qf[ks], SA); if (ks + 2 < 8) f0 = *(const bf16x8*)(baseA + 16 * (ks + 2)); ML_SB;
        SB = ML_MFMA(f1, qf[ks], SB); if (ks + 2 < 8) f1 = *(const bf16x8*)(baseB + 16 * (ks + 2)); ML_SB;
        SA = ML_MFMA(f2, qf[ks + 1], SA); if (ks + 3 < 8) f2 = *(const bf16x8*)(baseA + 16 * (ks + 3)); ML_SB;
        SB = ML_MFMA(f3, qf[ks + 1], SB); if (ks + 3 < 8) f3 = *(const bf16x8*)(baseB + 16 * (ks + 3)); ML_SB;
    }
}
__device__ __forceinline__ void mlstm_item(const Params& p, unsigned char* shm, int item) {
    int tid_ = threadIdx.x; asm volatile("" : "+v"(tid_)); const int tid = tid_, lane = tid & 63, w = __builtin_amdgcn_readfirstlane(tid >> 6), l15 = lane & 15, qq = lane >> 4;
    const int sl = item & 7, hA = (item >> 3) & 3, b = item >> 5;
    const int wq = w < 4 ? w : 11 - w;
    const bf16_t* Q2 = (const bf16_t*)((const unsigned char*)p.out + DO_Q2); const bf16_t* K2 = (const bf16_t*)((const unsigned char*)p.out + DO_K2);
    const bf16_t* VTM = (const bf16_t*)(p.ws + WS_VTM); const float* GIF = (const float*)(p.ws + WS_GIF);
    bf16_t* HM = (bf16_t*)(p.ws + WS_HM);
    float* sA = (float*)(shm + ML_A); float* sMM = (float*)(shm + ML_MM); float* sBB = (float*)(shm + ML_BB); float* sWS = (float*)(shm + ML_WS); float* sN = (float*)(shm + ML_N); float* sMisc = (float*)(shm + ML_MISC);
    f32x4 Cacc[2][4], Nacc[2];
#pragma unroll
    for (int a = 0; a < 2; ++a) { Nacc[a] = (f32x4){0.f, 0.f, 0.f, 0.f};
#pragma unroll
        for (int c = 0; c < 4; ++c) Cacc[a][c] = (f32x4){0.f, 0.f, 0.f, 0.f}; }
    float m_st = 0.f;
    const bf16_t* vtrow0 = VTM + ((size_t)((b * 4 + hA) * 512 + 64 * sl)) * SEQ;
    const size_t tb = (size_t)b * SEQ;
    u32x4 stK[8], stV[2]; float gli0 = 0.f, gli1 = 0.f, glf0 = 0.f, glf1 = 0.f; bf16x8 qf[8];
    const int krow_s = tid >> 2, kpart = tid & 3, vdv = tid >> 3, vpart = tid & 7;
#define ML_LOAD_STAGE(c_) do { const size_t t0_ = tb + 128 * (c_); \
        { const bf16_t* src = K2 + (t0_ + krow_s) * 1024 + hA * 256 + kpart * 64; _Pragma("unroll") for (int e = 0; e < 8; ++e) stK[e] = *(const u32x4*)(src + 8 * e); } \
        { const bf16_t* src = vtrow0 + (size_t)vdv * SEQ + 128 * (c_) + vpart * 16; stV[0] = *(const u32x4*)src; stV[1] = *(const u32x4*)(src + 8); } \
        if (w == 0) { gli0 = GIF[(t0_ + 2 * lane) * 8 + hA]; gli1 = GIF[(t0_ + 2 * lane + 1) * 8 + hA]; glf0 = GIF[(t0_ + 2 * lane) * 8 + 4 + hA]; glf1 = GIF[(t0_ + 2 * lane + 1) * 8 + 4 + hA]; } } while (0)
#define ML_LOAD_Q(c_) do { const bf16_t* qp = Q2 + (tb + 128 * (c_) + 16 * wq + l15) * 1024 + hA * 256 + 64 * qq; _Pragma("unroll") for (int ks = 0; ks < 8; ++ks) qf[ks] = *(const bf16x8*)(qp + 8 * ks); } while (0)
#define ML_WRITE_STAGE() do { \
        { unsigned char* dst = shm + ML_KL + krow_s * 528 + kpart * 128; _Pragma("unroll") for (int e = 0; e < 8; ++e) *(u32x4*)(dst + 16 * e) = stK[e]; } \
        { unsigned char* dst = shm + ML_VT + vdv * 272 + vpart * 32; *(u32x4*)dst = stV[0]; *(u32x4*)(dst + 16) = stV[1]; } \
        _Pragma("unroll") for (int dkb = 0; dkb < 2; ++dkb) { \
            _Pragma("unroll") for (int dvb = 0; dvb < 4; ++dvb) { u32x2 o; o.x = cvt_pk_bf16(Cacc[dkb][dvb][0], Cacc[dkb][dvb][1]); o.y = cvt_pk_bf16(Cacc[dkb][dvb][2], Cacc[dkb][dvb][3]); \
                *(u32x2*)(shm + ML_CT + (16 * dvb + l15) * 528 + (32 * w + 16 * dkb + 4 * qq) * 2) = o; } \
            if (l15 == 0) *(f32x4*)(sN + 32 * w + 16 * dkb + 4 * qq) = Nacc[dkb]; } \
        if (w == 0) { \
            float cs = glf0 + glf1; \
            _Pragma("unroll") for (int o = 1; o < 64; o <<= 1) { const float v = __shfl_up(cs, o); if (lane >= o) cs += v; } \
            const float b1 = cs, b0 = cs - glf1; const float a0 = gli0 - b0, a1 = gli1 - b1; \
            float pmx = fmaxf(a0, a1); \
            _Pragma("unroll") for (int o = 1; o < 64; o <<= 1) { const float v = __shfl_up(pmx, o); if (lane >= o) pmx = fmaxf(pmx, v); } \
            float ex = __shfl_up(pmx, 1); if (lane == 0) ex = -3.0e38f; \
            const float pm0 = fmaxf(ex, a0), pm1 = pmx; const float mm0 = fmaxf(pm0, m_st), mm1 = fmaxf(pm1, m_st); \
            const float mml = __shfl(mm1, 63), bl = __shfl(b1, 63); \
            sA[2 * lane] = a0; sA[2 * lane + 1] = a1; sMM[2 * lane] = mm0; sMM[2 * lane + 1] = mm1; sBB[2 * lane] = b0; sBB[2 * lane + 1] = b1; \
            sWS[2 * lane] = __expf(a0 - mml); sWS[2 * lane + 1] = __expf(a1 - mml); \
            if (lane == 0) { sMisc[0] = bl; sMisc[1] = mml; } } } while (0)
    ML_LOAD_STAGE(0); ML_LOAD_Q(0);
    ML_WRITE_STAGE();
    for (int c = 0; c < 64; ++c) {
        __syncthreads();
        if (c + 1 < 64) ML_LOAD_STAGE(c + 1);
        const size_t t0 = tb + 128 * c;
        const int tl = 16 * wq + l15;
        const float mm_t = sMM[tl], b_t = sBB[tl], gi = __expf(m_st - mm_t);
        bf16x8 pf[4]; float den = 0.f;
#pragma unroll
        for (int a = 0; a < 4; ++a) {
            pf[a] = (bf16x8){0, 0, 0, 0, 0, 0, 0, 0};
            if (2 * a <= wq) {
                f32x4 S0 = (f32x4){0.f, 0.f, 0.f, 0.f}, S1 = (f32x4){0.f, 0.f, 0.f, 0.f};
                const unsigned char* kp = shm + ML_KL + (32 * a + 8 * (l15 >> 2) + (l15 & 3)) * 528 + 128 * qq;
                ml_chain2(kp, kp + 4 * 528, qf, S0, S1);
                const int key0 = 32 * a + 8 * qq;
                const f32x4 av0 = *(const f32x4*)(sA + key0), av1 = *(const f32x4*)(sA + key0 + 4);
                float pv[8];
#pragma unroll
                for (int i = 0; i < 4; ++i) { pv[i] = (key0 + i <= tl) ? S0[i] * __expf(av0[i] - mm_t) : 0.f; pv[4 + i] = (key0 + 4 + i <= tl) ? S1[i] * __expf(av1[i] - mm_t) : 0.f; den += pv[i] + pv[4 + i]; }
                pf[a] = __builtin_bit_cast(bf16x8, pack8(pv));
            }
        }
        den += __shfl_xor(den, 16); den += __shfl_xor(den, 32);
        f32x4 num[4];
        { const unsigned char* cp = shm + ML_CT + l15 * 528 + 128 * qq;
          f32x4 n0 = (f32x4){0.f, 0.f, 0.f, 0.f}, n1 = n0, n2 = n0, n3 = n0;
          ml_chain2(cp, cp + 16 * 528, qf, n0, n1); ml_chain2(cp + 32 * 528, cp + 48 * 528, qf, n2, n3);
          num[0] = n0 * gi; num[1] = n1 * gi; num[2] = n2 * gi; num[3] = n3 * gi; }
        float qn = 0.f;
#pragma unroll
        for (int ks = 0; ks < 8; ++ks) {
            float qv[8]; unpack8(__builtin_bit_cast(u32x4, qf[ks]), qv);
            const f32x4 n0 = *(const f32x4*)(sN + 64 * qq + 8 * ks), n1 = *(const f32x4*)(sN + 64 * qq + 8 * ks + 4);
            qn += (qv[0] * n0.x + qv[1] * n0.y) + (qv[2] * n0.z + qv[3] * n0.w) + (qv[4] * n1.x + qv[5] * n1.y) + (qv[6] * n1.z + qv[7] * n1.w);
        }
        qn += __shfl_xor(qn, 16); qn += __shfl_xor(qn, 32);
        den += gi * qn;
        ML_SB;
        if (c + 1 < 64) ML_LOAD_Q(c + 1);
        ML_SB;
#pragma unroll
        for (int a = 0; a < 4; ++a) {
            if (2 * a <= wq) {
                const unsigned char* vp = shm + ML_VT + l15 * 272 + (32 * a + 8 * qq) * 2;
                const bf16x8 v0 = *(const bf16x8*)(vp), v1 = *(const bf16x8*)(vp + 16 * 272), v2 = *(const bf16x8*)(vp + 32 * 272), v3 = *(const bf16x8*)(vp + 48 * 272);
                ML_SB;
                num[0] = ML_MFMA(v0, pf[a], num[0]); num[1] = ML_MFMA(v1, pf[a], num[1]); num[2] = ML_MFMA(v2, pf[a], num[2]); num[3] = ML_MFMA(v3, pf[a], num[3]);
            }
        }
        { const float dn = __builtin_amdgcn_rcpf(fmaxf(fabsf(den), __expf(-(b_t + mm_t))));
          bf16_t* hp = HM + (t0 + tl) * D + hA * 512 + 64 * sl + 4 * qq;
#pragma unroll
          for (int dvb = 0; dvb < 4; ++dvb) { u32x2 o; o.x = cvt_pk_bf16(num[dvb][0] * dn, num[dvb][1] * dn); o.y = cvt_pk_bf16(num[dvb][2] * dn, num[dvb][3] * dn); *(u32x2*)(hp + 16 * dvb) = o; } }
        const float b_last = sMisc[0], mm_last = sMisc[1], decay = __expf(m_st - mm_last);
#pragma unroll
        for (int dkb = 0; dkb < 2; ++dkb) { Nacc[dkb] = Nacc[dkb] * decay;
#pragma unroll
            for (int dvb = 0; dvb < 4; ++dvb) Cacc[dkb][dvb] = Cacc[dkb][dvb] * decay; }
#pragma unroll
        for (int a = 0; a < 4; ++a) {
            const f32x4 w0 = *(const f32x4*)(sWS + 32 * a + 8 * qq), w1 = *(const f32x4*)(sWS + 32 * a + 8 * qq + 4);
            const unsigned char* tp = shm + ML_KL + (32 * a + 8 * qq + (l15 >> 2)) * 528 + (32 * w + 4 * (l15 & 3)) * 2;
            const s16x4 t00 = __builtin_amdgcn_ds_read_tr16_b64_v4i16((PG8_LAS s16x4*)(tp)), t01 = __builtin_amdgcn_ds_read_tr16_b64_v4i16((PG8_LAS s16x4*)(tp + 4 * 528));
            const s16x4 t10 = __builtin_amdgcn_ds_read_tr16_b64_v4i16((PG8_LAS s16x4*)(tp + 32)), t11 = __builtin_amdgcn_ds_read_tr16_b64_v4i16((PG8_LAS s16x4*)(tp + 32 + 4 * 528));
            const unsigned char* vp = shm + ML_VT + l15 * 272 + (32 * a + 8 * qq) * 2;
            const u32x4 r0 = *(const u32x4*)(vp), r1 = *(const u32x4*)(vp + 16 * 272), r2 = *(const u32x4*)(vp + 32 * 272), r3 = *(const u32x4*)(vp + 48 * 272);
            ML_SB;
            bf16x8 kt0, kt1;
            kt0[0] = t00[0]; kt0[1] = t00[1]; kt0[2] = t00[2]; kt0[3] = t00[3]; kt0[4] = t01[0]; kt0[5] = t01[1]; kt0[6] = t01[2]; kt0[7] = t01[3];
            kt1[0] = t10[0]; kt1[1] = t10[1]; kt1[2] = t10[2]; kt1[3] = t10[3]; kt1[4] = t11[0]; kt1[5] = t11[1]; kt1[6] = t11[2]; kt1[7] = t11[3];
            float wsv[8] = {w0.x, w0.y, w0.z, w0.w, w1.x, w1.y, w1.z, w1.w};
            float zf[8];
#pragma unroll
            for (int e = 0; e < 8; ++e) zf[e] = (l15 == 0) ? wsv[e] : 0.f;
            const bf16x8 wsf = __builtin_bit_cast(bf16x8, pack8(zf));
            Nacc[0] = ML_MFMA(kt0, wsf, Nacc[0]); Nacc[1] = ML_MFMA(kt1, wsf, Nacc[1]);
            const u32x4 rr[4] = {r0, r1, r2, r3};
#pragma unroll
            for (int dvb = 0; dvb < 4; ++dvb) {
                float vv[8]; unpack8(rr[dvb], vv);
#pragma unroll
                for (int e = 0; e < 8; ++e) vv[e] *= wsv[e];
                const bf16x8 wv = __builtin_bit_cast(bf16x8, pack8(vv));
                Cacc[0][dvb] = ML_MFMA(kt0, wv, Cacc[0][dvb]); Cacc[1][dvb] = ML_MFMA(kt1, wv, Cacc[1][dvb]);
            }
        }
        m_st = b_last + mm_last;
        __syncthreads();
        if (c + 1 < 64) ML_WRITE_STAGE();
    }
#undef ML_LOAD_STAGE
#undef ML_LOAD_Q
#undef ML_WRITE_STAGE
}
#undef ML_SB
#undef ML_MFMA

constexpr int AT_V = 16384, AT_BUF = 32768;
__device__ __forceinline__ void attn_item(const Params& p, unsigned char* shm, int b, int h, int qb, float lam, float M2) {
    int tid_ = threadIdx.x; asm volatile("" : "+v"(tid_)); const int tid = tid_, lane = tid & 63, wave = __builtin_amdgcn_readfirstlane(tid >> 6), c = wave & 1, g = wave >> 1, r = lane & 31, hh = lane >> 5;
    const bf16_t* BQ = (const bf16_t*)(p.ws + WS_BQ); const bf16_t* BK = (const bf16_t*)(p.ws + WS_BK); const bf16_t* VTD = (const bf16_t*)(p.ws + WS_VTD); const bf16_t* GB = (const bf16_t*)(p.ws + WS_GB);
    bf16_t* YB = (bf16_t*)((unsigned char*)p.out + DO_YB);
    float* cmb = (float*)shm;
    const int tq = qb * 128 + 32 * g + r; const size_t rowq = (size_t)b * SEQ + tq;
    bf16x8 qf[8];
    { const bf16_t* qp = BQ + rowq * D + h * 256 + c * 128 + 64 * hh;
#pragma unroll
      for (int ks = 0; ks < 8; ++ks) qf[ks] = *(const bf16x8*)(qp + 8 * ks); }
    {
        float ss = 0.f;
#pragma unroll
        for (int ks = 0; ks < 8; ++ks) { float v[8]; unpack8(__builtin_bit_cast(u32x4, qf[ks]), v);
#pragma unroll
            for (int e = 0; e < 8; ++e) ss += v[e] * v[e]; }
        ss += __shfl_xor(ss, 32);
        const float rq = rsqrtf(ss * (1.f / 128.f) + EPS) * (0.08838834764831845f * LOG2E);
#pragma unroll
        for (int ks = 0; ks < 8; ++ks) { float v[8]; unpack8(__builtin_bit_cast(u32x4, qf[ks]), v);
            const f32x4 g0 = *(const f32x4*)(p.q_norm_g + 64 * hh + 8 * ks), g1 = *(const f32x4*)(p.q_norm_g + 64 * hh + 8 * ks + 4);
            v[0] *= rq * g0.x; v[1] *= rq * g0.y; v[2] *= rq * g0.z; v[3] *= rq * g0.w; v[4] *= rq * g1.x; v[5] *= rq * g1.y; v[6] *= rq * g1.z; v[7] *= rq * g1.w;
            qf[ks] = __builtin_bit_cast(bf16x8, pack8(v)); }
    }
    f32x16 O[8];
#pragma unroll
    for (int db = 0; db < 8; ++db)
#pragma unroll
        for (int i = 0; i < 16; ++i) O[db][i] = 0.f;
    float lsum = 0.f;
    const float slope2 = exp2f(-(float)(h + 1)) * LOG2E;
    const int ntile_w = qb * 4 + g + 1, ntile = qb * 4 + 4;
    int kt0 = (int)ceilf(((float)(qb * 128 - 31) - (150.f + 2.f * M2) / slope2) * (1.f / 32.f)); kt0 = kt0 < 0 ? 0 : kt0;
    const int keyperm = (r & 19) | ((r & 4) << 1) | ((r & 8) >> 1);
    const char* kgb = (const char*)(BK + ((size_t)b * SEQ) * D + h * 256);
    const char* vgb = (const char*)(VTD + ((size_t)(b * 8 + h) * 256) * 8192);
#define AT_ISSUE(kt_, dst_) do { const char* kb_ = kgb + (size_t)(32 * (kt_)) * (D * 2); const char* vb_ = vgb + (size_t)(kt_) * 16384; \
        int ln_ = lane; asm volatile("" : "+v"(ln_)); unsigned kgo[2], vgo[2];   \
        _Pragma("unroll") for (int j = 0; j < 2; ++j) { const int R = 8 * wave + 4 * j + (ln_ >> 4); kgo[j] = (unsigned)((R & 31) * D + (R >> 5) * 128 + 8 * ((ln_ & 15) ^ (R & 15))) * 2u; \
            const int dv = 32 * wave + 16 * j + (ln_ >> 2); vgo[j] = (unsigned)(dv * 32 + 8 * ((ln_ & 3) ^ ((dv >> 2) & 3))) * 2u; } \
        _Pragma("unroll") for (int j = 0; j < 2; ++j) __builtin_amdgcn_global_load_lds((const unsigned*)(kb_ + kgo[j]), (PG8_LAS unsigned*)((dst_) + (2 * wave + j) * 1024), 16, 0, 0); \
        _Pragma("unroll") for (int j = 0; j < 2; ++j) __builtin_amdgcn_global_load_lds((const unsigned*)(vb_ + vgo[j]), (PG8_LAS unsigned*)((dst_) + AT_V + (2 * wave + j) * 1024), 16, 0, 0); } while (0)
    const int krow = (c * 32 + keyperm) * 256, kx = keyperm & 15;
    const int vrow = AT_V + r * 64, vf_ = hh ^ ((r >> 2) & 3);
    __syncthreads();
    const int kt0e = kt0 & ~1, n64 = (ntile - kt0e) >> 1;
    AT_ISSUE(kt0e, shm); AT_ISSUE(kt0e + 1, shm + AT_BUF);
    asm volatile("s_waitcnt vmcnt(0)" ::: "memory");
    __builtin_amdgcn_s_barrier(); asm volatile("" ::: "memory");
    for (int it = 0; it < n64; ++it) {
      unsigned char* slot = shm + (it & 1) * (2 * AT_BUF);
      if (it + 1 < n64) { unsigned char* ns = shm + ((it & 1) ^ 1) * (2 * AT_BUF); AT_ISSUE(kt0e + 2 * it + 2, ns); AT_ISSUE(kt0e + 2 * it + 3, ns + AT_BUF); }
#pragma unroll
      for (int u = 0; u < 2; ++u) {
        const int kt = kt0e + 2 * it + u;
        const int s0 = 32 * kt;
        unsigned char* buf = slot + u * AT_BUF;
        if (kt < ntile_w) {
#define AT_KF(ks_) (*(const bf16x8*)(buf + krow + 16 * ((8 * hh + (ks_)) ^ kx)))
#define AT_VF(i_) (*(const bf16x8*)(buf + vrow + ((i_) & 7) * 2048 + 16 * ((2 * ((i_) >> 3)) ^ vf_)))
#define AT_SB __builtin_amdgcn_sched_barrier(0)
            const float base = slope2 * (float)(s0 + 8 * hh - tq) - M2;
            f32x16 S;
#pragma unroll
            for (int i = 0; i < 16; ++i) S[i] = fmaf(slope2, (float)((i & 3) + 4 * ((i >> 2) & 1) + 16 * (i >> 3)), base);
            bf16x8 f0 = AT_KF(0), f1 = AT_KF(1), f2 = AT_KF(2), f3 = AT_KF(3);
            AT_SB;
            S = __builtin_amdgcn_mfma_f32_32x32x16_bf16(f0, qf[0], S, 0, 0, 0); f0 = AT_KF(4); AT_SB;
            S = __builtin_amdgcn_mfma_f32_32x32x16_bf16(f1, qf[1], S, 0, 0, 0); f1 = AT_KF(5); AT_SB;
            S = __builtin_amdgcn_mfma_f32_32x32x16_bf16(f2, qf[2], S, 0, 0, 0); f2 = AT_KF(6); AT_SB;
            S = __builtin_amdgcn_mfma_f32_32x32x16_bf16(f3, qf[3], S, 0, 0, 0); f3 = AT_KF(7); AT_SB;
            S = __builtin_amdgcn_mfma_f32_32x32x16_bf16(f0, qf[4], S, 0, 0, 0); f0 = AT_VF(0); AT_SB;
            S = __builtin_amdgcn_mfma_f32_32x32x16_bf16(f1, qf[5], S, 0, 0, 0); f1 = AT_VF(1); AT_SB;
            S = __builtin_amdgcn_mfma_f32_32x32x16_bf16(f2, qf[6], S, 0, 0, 0); f2 = AT_VF(2); AT_SB;
            S = __builtin_amdgcn_mfma_f32_32x32x16_bf16(f3, qf[7], S, 0, 0, 0); f3 = AT_VF(3); AT_SB;
            float pv[16];
#pragma unroll
            for (int i = 0; i < 16; ++i) pv[i] = __builtin_amdgcn_exp2f(S[i]);
            if (kt == ntile_w - 1) {
#pragma unroll
                for (int i = 0; i < 16; ++i) { const int key = s0 + (i & 3) + 4 * ((i >> 2) & 1) + 8 * hh + 16 * (i >> 3); pv[i] = (key <= tq) ? pv[i] : 0.f; }
            }
#pragma unroll
            for (int i = 0; i < 16; ++i) lsum += pv[i];
            bf16x8 pf[2];
#pragma unroll
            for (int k2 = 0; k2 < 2; ++k2) { u32x4 u; u.x = cvt_pk_bf16(pv[8 * k2 + 0], pv[8 * k2 + 1]); u.y = cvt_pk_bf16(pv[8 * k2 + 2], pv[8 * k2 + 3]); u.z = cvt_pk_bf16(pv[8 * k2 + 4], pv[8 * k2 + 5]); u.w = cvt_pk_bf16(pv[8 * k2 + 6], pv[8 * k2 + 7]);
                pf[k2] = __builtin_bit_cast(bf16x8, u); }
            AT_SB;
#define AT_PV(i_, f_) do { O[(i_) & 7] = __builtin_amdgcn_mfma_f32_32x32x16_bf16(f_, pf[(i_) >> 3], O[(i_) & 7], 0, 0, 0); if ((i_) + 4 < 16) f_ = AT_VF((i_) + 4); AT_SB; } while (0)
            AT_PV(0, f0); AT_PV(1, f1); AT_PV(2, f2); AT_PV(3, f3); AT_PV(4, f0); AT_PV(5, f1); AT_PV(6, f2); AT_PV(7, f3);
            AT_PV(8, f0); AT_PV(9, f1); AT_PV(10, f2); AT_PV(11, f3); AT_PV(12, f0); AT_PV(13, f1); AT_PV(14, f2); AT_PV(15, f3);
#undef AT_PV
#undef AT_KF
#undef AT_VF
#undef AT_SB
        }
      }
      asm volatile("s_waitcnt vmcnt(0)" ::: "memory");
      asm volatile("s_waitcnt lgkmcnt(0)" ::: "memory");
      __builtin_amdgcn_s_barrier(); asm volatile("" ::: "memory");
    }
#undef AT_ISSUE
    const float ltot = lsum + __shfl_xor(lsum, 32);
    const float inv = 1.f / ltot;
    if (c == 1) {
#pragma unroll
        for (int db = 0; db < 8; ++db)
#pragma unroll
            for (int i = 0; i < 16; ++i) { const int dv = 32 * db + (i & 3) + 8 * (i >> 2) + 4 * hh; cmb[(g * 256 + dv) * 32 + r] = O[db][i] * inv; }
    }
    __syncthreads();
    if (c == 0) {
        float ss = 0.f;
#pragma unroll
        for (int db = 0; db < 8; ++db)
#pragma unroll
            for (int i = 0; i < 16; ++i) { const int dv = 32 * db + (i & 3) + 8 * (i >> 2) + 4 * hh; const float o = O[db][i] * inv - lam * cmb[(g * 256 + dv) * 32 + r]; O[db][i] = o; ss += o * o; }
        ss += __shfl_xor(ss, 32);
        const float rinv = rsqrtf(ss * (1.f / 256.f) + EPS) * 0.8f;
#pragma unroll
        for (int db = 0; db < 8; ++db)
#pragma unroll
            for (int ig = 0; ig < 4; ++ig) {
                const int dv0 = 32 * db + 8 * ig + 4 * hh; const size_t off = rowq * D + h * 256 + dv0;
                const u32x2 gbu = *(const u32x2*)(GB + off); const f32x4 sg = *(const f32x4*)(p.subln_g + dv0);
                u32x2 o; o.x = cvt_pk_bf16(O[db][4 * ig + 0] * rinv * sg.x * bflo(gbu.x), O[db][4 * ig + 1] * rinv * sg.y * bfhi(gbu.x));
                o.y = cvt_pk_bf16(O[db][4 * ig + 2] * rinv * sg.z * bflo(gbu.y), O[db][4 * ig + 3] * rinv * sg.w * bfhi(gbu.y));
                *(u32x2*)(YB + off) = o;
            }
    }
}

__device__ __forceinline__ void phase2b(const Params& p, unsigned char* shm, int rep) {
    int tid_ = threadIdx.x; asm volatile("" : "+v"(tid_)); const int tid = tid_, lane = tid & 63;
    if (blockIdx.x < 128) { const int xcd = blockIdx.x & 7, idx = blockIdx.x >> 3; mlstm_item(p, shm, (xcd * 2 + (idx >> 3)) * 8 + (idx & 7)); }
    float lam, M2;
    { const float a0 = p.diff_lambda[lane] * p.diff_lambda[128 + lane] + p.diff_lambda[64 + lane] * p.diff_lambda[192 + lane];
      const float a1 = p.diff_lambda[256 + lane] * p.diff_lambda[384 + lane] + p.diff_lambda[320 + lane] * p.diff_lambda[448 + lane];
      lam = expf(wave_sum(a0)) - expf(wave_sum(a1)) + 0.2f;
      float mq = fmaxf(fabsf(p.q_norm_g[lane]), fabsf(p.q_norm_g[64 + lane])), mk = fmaxf(fabsf(p.k_norm_g[lane]), fabsf(p.k_norm_g[64 + lane]));
#pragma unroll
      for (int o = 1; o < 64; o <<= 1) { mq = fmaxf(mq, __shfl_xor(mq, o)); mk = fmaxf(mk, __shfl_xor(mk, o)); }
      M2 = 128.f * mq * mk * 0.08838834764831845f * LOG2E * 1.02f;
      lam = __uint_as_float(__builtin_amdgcn_readfirstlane(__float_as_uint(lam))); M2 = __uint_as_float(__builtin_amdgcn_readfirstlane(__float_as_uint(M2))); }
    unsigned* ctr = (unsigned*)(p.ws + WS_CTL) + 128 * rep;
    int* sItem = (int*)(shm + 147456 - 64);
    const int myx = blockIdx.x & 7;
    for (;;) {
        __syncthreads();
        if (tid == 0) { int it = -1;
            for (int k = 0; k < 8; ++k) { const int q = (myx + k) & 7; const unsigned v = atomicAdd(ctr + 16 * q, 1u); if (v < 256u) { it = q * 256 + (int)v; break; } }
            *sItem = it; }
        __syncthreads();
        const int item = *sItem;
        if (item < 0) break;
        const int q = item >> 8, v = item & 255, b = v >> 6, qb = 63 - (v & 63);
        const int h = (b == 0) ? q : (b == 1) ? 7 - q : (b == 2) ? ((q + 4) & 7) : ((3 - q) & 7);
        attn_item(p, shm, b, h, qb, lam, M2);
    }
}

__device__ __forceinline__ void phase3(const Params& p, unsigned char* shm) {
    int tid_ = threadIdx.x; asm volatile("" : "+v"(tid_)); const int tid = tid_, lane = tid & 63, wave = tid >> 6, gw = blockIdx.x * 8 + wave, ngw = gridDim.x * 8;
    float* scr = (float*)(shm + wave * 8448);
    transpose_plain(p.w_out, D, D, (bf16_t*)(p.ws + WS_WOUT), scr, gw, ngw, lane);
    { const int nblk = 2 * DFF / 32, nitems = (D / 64) * nblk; bf16_t* WuT = (bf16_t*)(p.ws + WS_WUP);
      for (int it = gw; it < nitems; it += ngw) { const int kb = it / nblk, nb = it % nblk, n = 32 * nb, pt = n >> 8, j = n & 255;
          transpose_item(p.w_up, (size_t)(2 * DFF), D, WuT, 64 * kb, j < 128 ? 128 * pt + j : DFF + 128 * pt + (j - 128), n, scr, lane); } }
    transpose_plain(p.w_down, DFF, D, (bf16_t*)(p.ws + WS_WDN), scr, gw, ngw, lane);
    const bf16_t* HM = (const bf16_t*)(p.ws + WS_HM); const bf16_t* GA = (const bf16_t*)(p.ws + WS_GA); bf16_t* Y = (bf16_t*)(p.ws + WS_BQ); const bf16_t* YBp = (const bf16_t*)((const unsigned char*)p.out + DO_YB);
    for (int it = gw; it < T * 4; it += ngw) {
        const size_t off = (size_t)(it >> 2) * D + (it & 3) * 512 + 8 * lane;
        float hm[8], ga[8], yb[8]; unpack8(*(const u32x4*)(HM + off), hm); unpack8(*(const u32x4*)(GA + off), ga); unpack8(*(const u32x4*)(YBp + off), yb);
        float ss = 0.f;
#pragma unroll
        for (int e = 0; e < 8; ++e) ss += hm[e] * hm[e];
        const float rinv = rsqrtf(wave_sum(ss) * (1.f / 512.f) + EPS);
        const f32x4 g0 = *(const f32x4*)(p.mlstm_norm_g + (it & 3) * 512 + 8 * lane), g1 = *(const f32x4*)(p.mlstm_norm_g + (it & 3) * 512 + 8 * lane + 4);
        float y[8];
        y[0] = ga[0] * hm[0] * rinv * g0.x + yb[0]; y[1] = ga[1] * hm[1] * rinv * g0.y + yb[1]; y[2] = ga[2] * hm[2] * rinv * g0.z + yb[2]; y[3] = ga[3] * hm[3] * rinv * g0.w + yb[3];
        y[4] = ga[4] * hm[4] * rinv * g1.x + yb[4]; y[5] = ga[5] * hm[5] * rinv * g1.y + yb[5]; y[6] = ga[6] * hm[6] * rinv * g1.z + yb[6]; y[7] = ga[7] * hm[7] * rinv * g1.w + yb[7];
        *(u32x4*)(Y + off) = pack8(y);
    }
}
__device__ __forceinline__ void phase5(const Params& p) {
    int tid_ = threadIdx.x; asm volatile("" : "+v"(tid_)); const int tid = tid_, lane = tid & 63, wave = tid >> 6, gw = blockIdx.x * 8 + wave, ngw = gridDim.x * 8;
    bf16_t* H2 = (bf16_t*)(p.ws + WS_H2);
    for (int row = gw; row < T; row += ngw) {
        const f32x4* xr = (const f32x4*)(p.out + (size_t)row * D) + lane;
        f32x4 v[8]; float ss = 0.f;
#pragma unroll
        for (int j = 0; j < 8; ++j) { v[j] = xr[64 * j]; ss += (v[j].x * v[j].x + v[j].y * v[j].y) + (v[j].z * v[j].z + v[j].w * v[j].w); }
        const float rinv = rsqrtf(wave_sum(ss) * (1.f / D) + EPS);
        u32x2* o8 = (u32x2*)(H2 + (size_t)row * D) + lane;
#pragma unroll
        for (int j = 0; j < 8; ++j) { const f32x4 g = *((const f32x4*)p.norm2_g + lane + 64 * j);
            u32x2 o; o.x = cvt_pk_bf16(v[j].x * rinv * g.x, v[j].y * rinv * g.y); o.y = cvt_pk_bf16(v[j].z * rinv * g.z, v[j].w * rinv * g.w); o8[64 * j] = o; }
    }
}
__device__ __forceinline__ float dpp_ror1(float v) { return __int_as_float(__builtin_amdgcn_update_dpp(0, __float_as_int(v), 0x121, 0xf, 0xf, false)); }
__device__ __forceinline__ float dpp_ror2(float v) { return __int_as_float(__builtin_amdgcn_update_dpp(0, __float_as_int(v), 0x122, 0xf, 0xf, false)); }
struct EpiUp {
    static constexpr bool PERM = true, AFTER_DRAIN = false;
    bf16_t* act; bf16_t* sb; const float* cw; const float* cb;
    __device__ __forceinline__ void operator()(const f32x4 (&acc)[2][2][4][2], const pg8::Unit& u, int wr, int wc, int fr_in, int fq_in) const {
        int fr = fr_in, fq = fq_in; asm volatile("" : "+v"(fr), "+v"(fq));
        const int row0 = u.pm * 256 + wr * 64 + fr;
#pragma unroll
        for (int n = 0; n < 2; ++n) {
            const int cl = u.pn * 128 + wc * 32 + 8 * fq + 4 * n;
            const f32x4 wg0 = *(const f32x4*)(cw + cl), wg1 = *(const f32x4*)(cw + (size_t)2 * DFF + cl), wg2 = *(const f32x4*)(cw + (size_t)4 * DFF + cl);
            const f32x4 wv0 = *(const f32x4*)(cw + DFF + cl), wv1 = *(const f32x4*)(cw + (size_t)3 * DFF + cl), wv2 = *(const f32x4*)(cw + (size_t)5 * DFF + cl);
            const f32x4 bg = *(const f32x4*)(cb + cl), bv = *(const f32x4*)(cb + DFF + cl);
#pragma unroll
            for (int ai = 0; ai < 2; ++ai) {
#pragma unroll
                for (int m = 0; m < 4; ++m) {
                    const int row = row0 + ai * 128 + m * 16;
                    const f32x4 g = acc[ai][0][m][n], v = acc[ai][1][m][n];
                    const f32x4 gp = acc[ai][0][m > 0 ? m - 1 : 0][n], vp = acc[ai][1][m > 0 ? m - 1 : 0][n];
                    if ((m == 0 && fr < 2) || (m == 3 && fr >= 14)) {
                        const int slot = (m == 0) ? fr : fr - 12;
                        bf16_t* d = sb + ((size_t)(row >> 6) * 4 + slot) * (2 * DFF) + cl;
                        u32x2 og, ov; og.x = cvt_pk_bf16(g[0], g[1]); og.y = cvt_pk_bf16(g[2], g[3]); ov.x = cvt_pk_bf16(v[0], v[1]); ov.y = cvt_pk_bf16(v[2], v[3]);
                        *(u32x2*)d = og; *(u32x2*)(d + DFF) = ov;
                    }
                    f32x4 y;
#pragma unroll
                    for (int e = 0; e < 4; ++e) {
                        const float xg1 = dpp_ror1(fr == 15 ? gp[e] : g[e]), xg2 = dpp_ror2(fr >= 14 ? gp[e] : g[e]);
                        const float xv1 = dpp_ror1(fr == 15 ? vp[e] : v[e]), xv2 = dpp_ror2(fr >= 14 ? vp[e] : v[e]);
                        const float ug = bg[e] + wg0[e] * xg2 + wg1[e] * xg1 + wg2[e] * g[e];
                        const float uv = bv[e] + wv0[e] * xv2 + wv1[e] * xv1 + wv2[e] * v[e];
                        y[e] = ug * fsig(ug) * uv;
                    }
                    if (!(m == 0 && fr < 2)) { u32x2 o; o.x = cvt_pk_bf16(y[0], y[1]); o.y = cvt_pk_bf16(y[2], y[3]); *(u32x2*)(act + (size_t)row * DFF + cl) = o; }
                }
            }
        }
    }
};
__device__ __forceinline__ void phase_fix(const Params& p) {
    const bf16_t* SB = (const bf16_t*)(p.ws + WS_SB); bf16_t* ACT = (bf16_t*)(p.ws + WS_ACT);
    int tid_ = threadIdx.x; asm volatile("" : "+v"(tid_)); const int gt = blockIdx.x * 512 + tid_, ngt = gridDim.x * 512;
    for (int idx = gt; idx < (T / 64) * 704; idx += ngt) {
        const int oct = idx % 704, kb = idx / 704, c0 = 8 * oct, r0 = 64 * kb;
        float wg[3][8], wv[3][8], bg[8], bv[8];
#pragma unroll
        for (int j = 0; j < 3; ++j) {
            const f32x4 a = *(const f32x4*)(p.ffn_conv_w + (size_t)j * 2 * DFF + c0), b = *(const f32x4*)(p.ffn_conv_w + (size_t)j * 2 * DFF + c0 + 4);
            const f32x4 c = *(const f32x4*)(p.ffn_conv_w + (size_t)j * 2 * DFF + DFF + c0), d = *(const f32x4*)(p.ffn_conv_w + (size_t)j * 2 * DFF + DFF + c0 + 4);
            wg[j][0] = a.x; wg[j][1] = a.y; wg[j][2] = a.z; wg[j][3] = a.w; wg[j][4] = b.x; wg[j][5] = b.y; wg[j][6] = b.z; wg[j][7] = b.w;
            wv[j][0] = c.x; wv[j][1] = c.y; wv[j][2] = c.z; wv[j][3] = c.w; wv[j][4] = d.x; wv[j][5] = d.y; wv[j][6] = d.z; wv[j][7] = d.w;
        }
        { const f32x4 a = *(const f32x4*)(p.ffn_conv_b + c0), b = *(const f32x4*)(p.ffn_conv_b + c0 + 4), c = *(const f32x4*)(p.ffn_conv_b + DFF + c0), d = *(const f32x4*)(p.ffn_conv_b + DFF + c0 + 4);
          bg[0] = a.x; bg[1] = a.y; bg[2] = a.z; bg[3] = a.w; bg[4] = b.x; bg[5] = b.y; bg[6] = b.z; bg[7] = b.w; bv[0] = c.x; bv[1] = c.y; bv[2] = c.z; bv[3] = c.w; bv[4] = d.x; bv[5] = d.y; bv[6] = d.z; bv[7] = d.w; }
        float g2[8], g1[8], v2[8], v1[8];
        if ((r0 & (SEQ - 1)) != 0) {
            const bf16_t* pr = SB + ((size_t)(kb - 1) * 4 + 2) * (2 * DFF) + c0;
            unpack8(*(const u32x4*)pr, g2); unpack8(*(const u32x4*)(pr + DFF), v2); unpack8(*(const u32x4*)(pr + 2 * DFF), g1); unpack8(*(const u32x4*)(pr + 2 * DFF + DFF), v1);
        } else {
#pragma unroll
            for (int e = 0; e < 8; ++e) { g2[e] = 0.f; g1[e] = 0.f; v2[e] = 0.f; v1[e] = 0.f; }
        }
#pragma unroll
        for (int rr = 0; rr < 2; ++rr) {
            float g0[8], v0[8], y[8];
            const bf16_t* cr = SB + ((size_t)kb * 4 + rr) * (2 * DFF) + c0;
            unpack8(*(const u32x4*)cr, g0); unpack8(*(const u32x4*)(cr + DFF), v0);
#pragma unroll
            for (int e = 0; e < 8; ++e) {
                const float ug = bg[e] + wg[0][e] * g2[e] + wg[1][e] * g1[e] + wg[2][e] * g0[e];
                const float uv = bv[e] + wv[0][e] * v2[e] + wv[1][e] * v1[e] + wv[2][e] * v0[e];
                y[e] = ug * fsig(ug) * uv; g2[e] = g1[e]; g1[e] = g0[e]; v2[e] = v1[e]; v1[e] = v0[e];
            }
            *(u32x4*)(ACT + (size_t)(r0 + rr) * DFF + c0) = pack8(y);
        }
    }
}

#ifndef REP1
#define REP1 1
#endif
#ifndef REP3
#define REP3 1
#endif
__global__ void __launch_bounds__(512, 2) mega(Params p) {
    extern __shared__ __attribute__((aligned(16))) unsigned char shm[];
    cg::grid_group grid = cg::this_grid();
    bf16_t* H = (bf16_t*)((unsigned char*)p.out + DO_H); bf16_t* WinT = (bf16_t*)((unsigned char*)p.out + DO_WIN);
    bf16_t* H2 = (bf16_t*)(p.ws + WS_H2); bf16_t* ACTb = (bf16_t*)(p.ws + WS_ACT);
    const bf16_t* WoT = (const bf16_t*)(p.ws + WS_WOUT); const bf16_t* WuT = (const bf16_t*)(p.ws + WS_WUP); const bf16_t* WdT = (const bf16_t*)(p.ws + WS_WDN);
#define PH(i) (p.ph_lo <= (i) && (i) < p.ph_hi)
#define SYNC(i) do { if (p.ph_lo <= (i) && (i) + 1 < p.ph_hi) grid.sync(); } while (0)
    if (PH(0)) phase0(p, shm);
    SYNC(0);
    for (int rep = 0; rep < REP1; ++rep) { if (rep) grid.sync();
    if (PH(1)) { Epi1 E{(bf16_t*)(p.ws + WS_AQK), (bf16_t*)(p.ws + WS_VTM), (bf16_t*)(p.ws + WS_GA), (bf16_t*)(p.ws + WS_BQ), (bf16_t*)(p.ws + WS_BK), (bf16_t*)(p.ws + WS_VTD), (bf16_t*)(p.ws + WS_GB)};
        run_gemm(shm, H, WinT, T, 16384, D, E); } }
    SYNC(1);
    if (PH(2)) phase2a(p, shm);
    SYNC(2);
    for (int rep = 0; rep < REP3; ++rep) { if (rep) grid.sync(); if (PH(3)) phase2b(p, shm, rep); }
    SYNC(3);
    if (PH(4)) phase3(p, shm);
    SYNC(4);
    if (PH(5)) { EpiRes E{p.out, p.x, D}; run_gemm(shm, (const bf16_t*)(p.ws + WS_BQ), WoT, T, D, D, E); }
    SYNC(5);
    if (PH(6)) phase5(p);
    SYNC(6);
    if (PH(7)) { EpiUp E{ACTb, (bf16_t*)(p.ws + WS_SB), p.ffn_conv_w, p.ffn_conv_b}; run_gemm(shm, H2, WuT, T, 2 * DFF, D, E); }
    SYNC(7);
    if (PH(8)) phase_fix(p);
    SYNC(8);
    if (PH(9)) { EpiRes E{p.out, p.out, D}; run_gemm(shm, ACTb, WdT, T, D, DFF, E); }
#undef PH
#undef SYNC
}

#ifndef N_LAUNCHES
#define N_LAUNCHES 1
#endif
extern "C" void kernel_launch(void* const* d_in, const int* in_sizes, int n_in, void* d_out, int out_size, void* d_ws, size_t ws_size, hipStream_t stream) {
    static int grid = 0;
    if (grid == 0) {
        if (n_in != 17 || out_size != T * D || ws_size < WS_END) { fprintf(stderr, "kernel_launch: unexpected problem (n_in %d, out %d, ws %zu)\n", n_in, out_size, ws_size); grid = -1; return; }
        int dev = 0, cus = 0, per_cu = 0;
        if (hipGetDevice(&dev) != hipSuccess || hipDeviceGetAttribute(&cus, hipDeviceAttributeMultiprocessorCount, dev) != hipSuccess) { grid = -1; return; }
        if (hipFuncSetAttribute((const void*)mega, hipFuncAttributeMaxDynamicSharedMemorySize, LDS_BYTES) != hipSuccess) { fprintf(stderr, "kernel_launch: hipFuncSetAttribute failed\n"); grid = -1; return; }
        if (hipOccupancyMaxActiveBlocksPerMultiprocessor(&per_cu, (const void*)mega, 512, LDS_BYTES) != hipSuccess || per_cu < 1) { fprintf(stderr, "kernel_launch: occupancy query says %d\n", per_cu); per_cu = 1; }
        (void)hipGetLastError();
        grid = cus * per_cu;
    }
    if (grid < 0) return;
    if (hipMemsetAsync((char*)d_ws + WS_CTL, 0, 4096, stream) != hipSuccess) { fprintf(stderr, "kernel_launch: memset failed\n"); return; }
    Params p{};
    const float** pp = (const float**)&p;
    for (int i = 0; i < 17; ++i) pp[i] = (const float*)d_in[i];
    p.out = (float*)d_out; p.ws = (unsigned char*)d_ws;
    constexpr int NPH = 10;
    for (int li = 0; li < N_LAUNCHES; ++li) {
        p.ph_lo = (N_LAUNCHES == 1) ? 0 : li; p.ph_hi = (N_LAUNCHES == 1) ? NPH : li + 1;
        void* args[] = {&p};
        hipError_t e = hipLaunchCooperativeKernel((const void*)mega, dim3(grid), dim3(512), args, LDS_BYTES, stream);
        if (e != hipSuccess) { fprintf(stderr, "cooperative launch failed: %s (grid %d)\n", hipGetErrorString(e), grid); break; }
    }
}
```

```cpp
#include <hip/hip_runtime.h>
#include <hip/hip_cooperative_groups.h>
#include <cstdio>
#include <cstdint>
namespace cg = cooperative_groups;
namespace pg8 {
#define PG8_LAS __attribute__((address_space(3)))
typedef unsigned short bf16_t;
typedef short bf16x8 __attribute__((ext_vector_type(8)));
typedef float f32x4 __attribute__((ext_vector_type(4)));
typedef unsigned u32x4 __attribute__((ext_vector_type(4)));
constexpr int BM = 256, BK = 64, HALF = 128, HTB = HALF * BK * 2  , STAGE_BYTES = 8 * HTB, NXCD = 8, WGM = 8;

__host__ __device__ __forceinline__ int lds_byte(int r, int c) { const int st = (r >> 4) * 2 + (c >> 5), rr = r & 15, cc = c & 31, ob = rr * 64 + cc * 2; return st * 1024 + (ob ^ (((ob >> 9) & 1) << 5)); }
__host__ __device__ __forceinline__ void stage_rc(int b, int& R, int& C) { const int st = b / 1024, sb = b % 1024, swz = sb ^ (((sb >> 9) & 1) << 5); R = (st >> 1) * 16 + swz / 64; C = (st & 1) * 32 + (swz % 64) / 2; }
__host__ __device__ __forceinline__ int perm32(int rho) { const int n = rho >> 4, i = rho & 15; return 8 * (i >> 2) + 4 * n + (i & 3); }

struct Unit { int pm, pn; };
struct Gemm { const bf16_t* A; const bf16_t* Bt; int M, N, K; };

struct StaticOrder {
    int nM, nN, nwg, G, c;
    __host__ __device__ void init(int M, int N, int G_, int c_) { nM = M / BM; nN = N / BM; nwg = nM * nN; G = G_; c = c_; }
    __host__ __device__ bool next(int i, Unit& u) const {
        const long L = (long)i * G + c; if (L >= nwg) return false;
        int wgid = (int)L; { const int q = nwg / NXCD, r = nwg % NXCD, xcd = wgid % NXCD, off = wgid / NXCD; wgid = (xcd < r ? xcd * (q + 1) : r * (q + 1) + (xcd - r) * q) + off; }
        const int nig = WGM * nN, gid = wgid / nig, fm = gid * WGM, gsz = (nM - fm) < WGM ? (nM - fm) : WGM;
        u.pm = fm + ((wgid % nig) % gsz); u.pn = (wgid % nig) / gsz; return true;
    }
    __device__ __forceinline__ void a_ready(const Unit&) const {}
    __device__ __forceinline__ void done(const Unit&) const {}
};
__device__ __forceinline__ unsigned cvt_pk_bf16(float lo, float hi) { unsigned r; asm volatile("v_cvt_pk_bf16_f32 %0, %1, %2" : "=v"(r) : "v"(lo), "v"(hi)); return r; }
template <class Epi, class Sched, bool STAMP = false>
__device__ __forceinline__ void gemm_phase(PG8_LAS unsigned char* lds, const Gemm g, const Sched& S, const Epi& E, unsigned long long* stamps) {
    int tid_ = threadIdx.x; asm volatile("" : "+v"(tid_)); const int tid = tid_, wid = __builtin_amdgcn_readfirstlane(tid >> 6), lane = tid & 63, wr = wid >> 2, wc = wid & 3, fr = lane & 15, fq = lane >> 4;
    const int K = g.K, nt = K / BK;
    int ts_lo = 0, ts_hi = 0, nts = 0; const unsigned long long rt_entry = STAMP ? (unsigned long long)wall_clock64() : 0ull;
#define PG8_STAMP() do { if (STAMP && wid == 0 && nts < 64) { const unsigned long long _c = (unsigned long long)clock64(); \
        ts_lo = (lane == nts) ? (int)(unsigned)_c : ts_lo; ts_hi = (lane == nts) ? (int)(unsigned)(_c >> 32) : ts_hi; ++nts; } } while (0)
    PG8_STAMP();
    unsigned voffA[2], voffB[2];
#pragma unroll
    for (int i = 0; i < 2; ++i) { int R, C; stage_rc(tid * 16 + i * 8192, R, C); const int Rb = Epi::PERM ? ((R & ~31) + perm32(R & 31)) : R;
        voffA[i] = (unsigned)(R * K + C) * 2u; voffB[i] = (unsigned)(Rb * K + C) * 2u; }
    const size_t kstep = (size_t)(BK * 2);
    const size_t hstep = (size_t)HALF * K * 2;
    const size_t tstep = 2 * hstep;
    const unsigned ldsw = (unsigned)wid * 1024u;
    const int aoff = lds_byte(wr * 64 + fr, fq * 8), boff = lds_byte(wc * 32 + fr, fq * 8);
#define PG8_SA(b, h) (((b) * 2 + (h)) * HTB)
#define PG8_SB(b, h) ((4 + (b) * 2 + (h)) * HTB)
#define PG8_STAGE(bufoff, gbase, voff) do { _Pragma("unroll") for (int _i = 0; _i < 2; ++_i) \
        __builtin_amdgcn_global_load_lds((const unsigned*)((const char*)(gbase) + (voff)[_i]), (PG8_LAS unsigned*)(lds + (bufoff) + ldsw + _i * 8192), 16, 0, 0); } while (0)
#define PG8_LDA(dst, b, h) do { _Pragma("unroll") for (int m = 0; m < 4; ++m) _Pragma("unroll") for (int k = 0; k < 2; ++k) dst[m][k] = *(const PG8_LAS bf16x8*)(lds + PG8_SA(b, h) + aoff + m * 2048 + k * 1024); } while (0)
#define PG8_LDB(dst, b, h) do { _Pragma("unroll") for (int n = 0; n < 2; ++n) _Pragma("unroll") for (int k = 0; k < 2; ++k) dst[n][k] = *(const PG8_LAS bf16x8*)(lds + PG8_SB(b, h) + boff + n * 2048 + k * 1024); } while (0)
#define PG8_MMA(ai, bj, At, Bt) do { __builtin_amdgcn_s_setprio(1); _Pragma("unroll") for (int m = 0; m < 4; ++m) _Pragma("unroll") for (int n = 0; n < 2; ++n) _Pragma("unroll") for (int k = 0; k < 2; ++k) \
        acc[ai][bj][m][n] = __builtin_amdgcn_mfma_f32_16x16x32_bf16(Bt[n][k], At[m][k], acc[ai][bj][m][n], 0, 0, 0); __builtin_amdgcn_s_setprio(0); } while (0)
#define PG8_WAIT_V(n) asm volatile("s_waitcnt vmcnt(" #n ")" ::: "memory")
#define PG8_WAIT_L(n) asm volatile("s_waitcnt lgkmcnt(" #n ")" ::: "memory")
#define PG8_BAR __builtin_amdgcn_s_barrier()
#define PG8_SCHED __builtin_amdgcn_sched_barrier(0)
    Unit cur, nxt; int ui = 0;
    if (!S.next(0, cur)) return;
    f32x4 acc[2][2][4][2];
#pragma unroll
    for (int a = 0; a < 2; ++a)
#pragma unroll
        for (int b = 0; b < 2; ++b)
#pragma unroll
            for (int m = 0; m < 4; ++m)
#pragma unroll
                for (int n = 0; n < 2; ++n) acc[a][b][m][n] = (f32x4){0.f, 0.f, 0.f, 0.f};
    bf16x8 At[4][2], B0[2][2], B1[2][2];
    const char* cA = (const char*)g.A + (size_t)cur.pm * tstep; const char* cB = (const char*)g.Bt + (size_t)cur.pn * tstep;
    S.a_ready(cur);
    PG8_STAGE(PG8_SB(0, 0), cB, voffB); PG8_STAGE(PG8_SA(0, 0), cA, voffA); PG8_STAGE(PG8_SB(0, 1), cB + hstep, voffB); PG8_STAGE(PG8_SA(0, 1), cA + hstep, voffA);
    if (wr == 1) PG8_BAR;
    PG8_WAIT_V(4); PG8_BAR;
    PG8_STAGE(PG8_SB(1, 0), cB + kstep, voffB); PG8_STAGE(PG8_SA(1, 0), cA + kstep, voffA); PG8_STAGE(PG8_SB(1, 1), cB + hstep + kstep, voffB);
    PG8_WAIT_V(6); PG8_BAR;
    PG8_STAMP();
    for (;;) {
        const bool has_next = S.next(ui + 1, nxt);
        const char* nA = has_next ? (const char*)g.A + (size_t)nxt.pm * tstep : cA; const char* nB = has_next ? (const char*)g.Bt + (size_t)nxt.pn * tstep : cB;
        for (int t = 0; t < nt; t += 2) {
            const bool last = (t == nt - 2);
            const char* a1 = cA + (size_t)(t + 1) * kstep;
            const char* a2 = last ? nA : cA + (size_t)(t + 2) * kstep; const char* b2 = last ? nB : cB + (size_t)(t + 2) * kstep;
            const char* a3 = a2 + kstep; const char* b3 = b2 + kstep;
            if (last && has_next) S.a_ready(nxt);
            PG8_LDB(B0, 0, 0); PG8_SCHED; PG8_LDA(At, 0, 0); PG8_STAGE(PG8_SA(1, 1), a1 + hstep, voffA);
            PG8_WAIT_L(8); PG8_BAR; PG8_WAIT_L(0); PG8_MMA(0, 0, At, B0); PG8_BAR; PG8_SCHED;
            PG8_LDB(B1, 0, 1); PG8_STAGE(PG8_SB(0, 0), b2, voffB);
            PG8_BAR; PG8_WAIT_L(0); PG8_MMA(0, 1, At, B1); PG8_BAR;
            PG8_LDA(At, 0, 1); PG8_STAGE(PG8_SA(0, 0), a2, voffA);
            PG8_BAR; PG8_WAIT_L(0); PG8_MMA(1, 0, At, B0); PG8_BAR; PG8_SCHED;
            PG8_STAGE(PG8_SB(0, 1), b2 + hstep, voffB);
            PG8_WAIT_V(6); PG8_BAR; PG8_MMA(1, 1, At, B1); PG8_BAR;
            PG8_LDB(B0, 1, 0); PG8_SCHED; PG8_LDA(At, 1, 0); PG8_STAGE(PG8_SA(0, 1), a2 + hstep, voffA);
            PG8_WAIT_L(8); PG8_BAR; PG8_WAIT_L(0); PG8_MMA(0, 0, At, B0); PG8_BAR; PG8_SCHED;
            PG8_LDB(B1, 1, 1); PG8_STAGE(PG8_SB(1, 0), b3, voffB);
            PG8_BAR; PG8_WAIT_L(0); PG8_MMA(0, 1, At, B1); PG8_BAR;
            PG8_LDA(At, 1, 1); PG8_STAGE(PG8_SA(1, 0), a3, voffA);
            PG8_BAR; PG8_WAIT_L(0); PG8_MMA(1, 0, At, B0); PG8_BAR; PG8_SCHED;
            PG8_STAGE(PG8_SB(1, 1), b3 + hstep, voffB);
            PG8_WAIT_V(6); PG8_BAR; PG8_MMA(1, 1, At, B1); PG8_BAR;
        }
        PG8_STAMP();
        if constexpr (!Epi::AFTER_DRAIN) { E(acc, cur, wr, wc, fr, fq); S.done(cur); }
        PG8_STAMP();
        if (!has_next) break;
#pragma unroll
        for (int a = 0; a < 2; ++a)
#pragma unroll
            for (int b = 0; b < 2; ++b)
#pragma unroll
                for (int m = 0; m < 4; ++m)
#pragma unroll
                    for (int n = 0; n < 2; ++n) acc[a][b][m][n] = (f32x4){0.f, 0.f, 0.f, 0.f};
        cur = nxt; cA = nA; cB = nB; ++ui;
    }
    PG8_WAIT_V(0);
    if (wr == 0) PG8_BAR;
    PG8_BAR;
    if constexpr (Epi::AFTER_DRAIN) { E.fused(acc, cur, wr, wc, fr, fq, lds, wid, lane); S.done(cur); }
    PG8_STAMP();
    if (STAMP && wid == 0) { stamps[lane] = lane < nts ? (((unsigned long long)(unsigned)ts_hi << 32) | (unsigned)ts_lo) : 0ull;
        if (lane == 62) stamps[62] = rt_entry; if (lane == 63) stamps[63] = (unsigned long long)wall_clock64(); }
#undef PG8_STAMP
#undef PG8_SA
#undef PG8_SB
#undef PG8_STAGE
#undef PG8_LDA
#undef PG8_LDB
#undef PG8_MMA
#undef PG8_WAIT_V
#undef PG8_WAIT_L
#undef PG8_BAR
#undef PG8_SCHED
}
}
using pg8::bf16_t; using pg8::bf16x8; using pg8::f32x4; using pg8::u32x4; using pg8::cvt_pk_bf16;
typedef unsigned u32x2 __attribute__((ext_vector_type(2)));
typedef float f32x16 __attribute__((ext_vector_type(16)));

constexpr int T = 32768, D = 2048, SEQ = 8192, PIN = 16392, DFF = 5632, TH = 16384;
constexpr float EPS = 1e-6f, LOG2E = 1.4426950408889634f;
constexpr size_t MiB = (size_t)1 << 20;
constexpr size_t WS_CTL = 0, WS_GIF = 1 * MiB, WS_KT = 2 * MiB, WS_AQK = 66 * MiB, WS_VTM = 194 * MiB, WS_GA = 322 * MiB, WS_BQ = 450 * MiB, WS_BK = 578 * MiB,
                 WS_VTD = 706 * MiB, WS_GB = 834 * MiB, WS_END = 962 * MiB;
constexpr size_t WS_HM = WS_AQK, WS_H2 = WS_AQK, WS_WOUT = WS_VTM, WS_WUP = WS_VTM + 8 * MiB, WS_WDN = WS_VTM + 52 * MiB, WS_ACT = WS_GA, WS_SB = 674 * MiB;
constexpr size_t DO_H = 0, DO_Q2 = 0, DO_K2 = 64 * MiB, DO_WIN = 128 * MiB, DO_YB = 128 * MiB;
constexpr int LDS_BYTES = 147456;

struct Params {
    const float *x, *norm1_g, *w_in, *if_bias, *qk_conv_w, *qk_conv_b, *mlstm_norm_g, *q_norm_g, *k_norm_g, *diff_lambda, *subln_g, *w_out, *norm2_g, *w_up, *ffn_conv_w, *ffn_conv_b, *w_down;
    float* out; unsigned char* ws; int ph_lo, ph_hi;
};

__device__ __forceinline__ void lds_wait() { asm volatile("s_waitcnt lgkmcnt(0)" ::: "memory"); }
__device__ __forceinline__ float bflo(unsigned u) { return __uint_as_float(u << 16); }
__device__ __forceinline__ float bfhi(unsigned u) { return __uint_as_float(u & 0xffff0000u); }
__device__ __forceinline__ float fsig(float v) { return __builtin_amdgcn_rcpf(1.f + __expf(-v)); }
__device__ __forceinline__ float wave_sum(float v) {
#pragma unroll
    for (int o = 1; o < 64; o <<= 1) v += __shfl_xor(v, o);
    return v;
}
__device__ __forceinline__ void unpack8(u32x4 u, float (&f)[8]) {
    f[0] = bflo(u.x); f[1] = bfhi(u.x); f[2] = bflo(u.y); f[3] = bfhi(u.y); f[4] = bflo(u.z); f[5] = bfhi(u.z); f[6] = bflo(u.w); f[7] = bfhi(u.w);
}
__device__ __forceinline__ u32x4 pack8(const float (&f)[8]) {
    u32x4 o; o.x = cvt_pk_bf16(f[0], f[1]); o.y = cvt_pk_bf16(f[2], f[3]); o.z = cvt_pk_bf16(f[4], f[5]); o.w = cvt_pk_bf16(f[6], f[7]); return o;
}

__device__ __forceinline__ void transpose_item(const float* __restrict__ W, size_t ldw, int K, bf16_t* WT, int k0, int srcn0, int dstn0, float* scr, int lane) {
#pragma unroll 8
    for (int i = 0; i < 32; ++i) { const int kk = 2 * i + (lane >> 5); scr[kk * 33 + (lane & 31)] = W[(size_t)(k0 + kk) * ldw + srcn0 + (lane & 31)]; }
    lds_wait();
    const int c = lane & 7;
#pragma unroll
    for (int j = 0; j < 4; ++j) { const int n = (lane >> 3) + 8 * j; const float* s = scr + (8 * c) * 33 + n;
        u32x4 o; o.x = cvt_pk_bf16(s[0], s[33]); o.y = cvt_pk_bf16(s[66], s[99]); o.z = cvt_pk_bf16(s[132], s[165]); o.w = cvt_pk_bf16(s[198], s[231]);
        *(u32x4*)(WT + (size_t)(dstn0 + n) * K + k0 + 8 * c) = o; }
    lds_wait();
}
__device__ __forceinline__ int win_src(int n) {
    if (n < 4096) return n;
    if (n < 8192) { const int p = (n - 4096) >> 8, j = (n - 4096) & 255; return j < 128 ? 4096 + 128 * p + j : 12296 + 128 * p + (j - 128); }
    if (n < 10240) return 6152 + (n - 8192);
    if (n < 12288) return 8200 + (n - 10240);
    if (n < 14336) return 10248 + (n - 12288);
    return 14344 + (n - 14336);
}
__device__ __forceinline__ void transpose_plain(const float* W, int K, int N, bf16_t* WT, float* scr, int gw, int ngw, int lane) {
    const int nblk = N / 32, nitems = (K / 64) * nblk;
    for (int it = gw; it < nitems; it += ngw) { const int kb = it / nblk, nb = it % nblk; transpose_item(W, (size_t)N, K, WT, 64 * kb, 32 * nb, 32 * nb, scr, lane); }
}

__device__ __forceinline__ void phase0(const Params& p, unsigned char* shm) {
    int tid_ = threadIdx.x; asm volatile("" : "+v"(tid_)); const int tid = tid_, lane = tid & 63, wave = tid >> 6, gw = blockIdx.x * 8 + wave, ngw = gridDim.x * 8;
    float* scr = (float*)(shm + wave * 8448);
    bf16_t* WinT = (bf16_t*)((unsigned char*)p.out + DO_WIN);
    { const int nblk = 16384 / 32, nitems = (D / 64) * nblk;
      for (int it = gw; it < nitems; it += ngw) { const int kb = it / nblk, nb = it % nblk; transpose_item(p.w_in, (size_t)PIN, D, WinT, 64 * kb, win_src(32 * nb), 32 * nb, scr, lane); } }
    float* wifT = (float*)(shm + 69632);
    for (int idx = tid; idx < 8 * D; idx += 512) { const int k = idx >> 3, j = idx & 7; wifT[j * D + k] = p.w_in[(size_t)k * PIN + 6144 + j]; }
    __syncthreads();
    bf16_t* H = (bf16_t*)((unsigned char*)p.out + DO_H);
    float* GIF = (float*)(p.ws + WS_GIF);
    f32x4 g1r[8];
#pragma unroll
    for (int j = 0; j < 8; ++j) g1r[j] = *((const f32x4*)p.norm1_g + lane + 64 * j);
    for (int row = gw; row < T; row += ngw) {
        const f32x4* xr = (const f32x4*)(p.x + (size_t)row * D) + lane;
        f32x4 v[8]; float ss = 0.f;
#pragma unroll
        for (int j = 0; j < 8; ++j) { v[j] = xr[64 * j]; ss += (v[j].x * v[j].x + v[j].y * v[j].y) + (v[j].z * v[j].z + v[j].w * v[j].w); }
        const float rinv = rsqrtf(wave_sum(ss) * (1.f / D) + EPS);
        float ga[8];
#pragma unroll
        for (int j = 0; j < 8; ++j) ga[j] = 0.f;
        u32x2* o8 = (u32x2*)(H + (size_t)row * D) + lane;
#pragma unroll
        for (int j = 0; j < 8; ++j) {
            const f32x4 g = g1r[j];
            f32x4 h; h.x = v[j].x * rinv * g.x; h.y = v[j].y * rinv * g.y; h.z = v[j].z * rinv * g.z; h.w = v[j].w * rinv * g.w;
            u32x2 o; o.x = cvt_pk_bf16(h.x, h.y); o.y = cvt_pk_bf16(h.z, h.w); o8[64 * j] = o;
#pragma unroll
            for (int q = 0; q < 8; ++q) { const f32x4 w = *((const f32x4*)(wifT + q * D) + lane + 64 * j); ga[q] += (h.x * w.x + h.y * w.y) + (h.z * w.z + h.w * w.w); }
        }
#pragma unroll
        for (int q = 0; q < 8; ++q) ga[q] = wave_sum(ga[q]);
        if (lane < 8) {
            float val = 0.f;
#pragma unroll
            for (int q = 0; q < 8; ++q) val = (lane == q) ? ga[q] : val;
            val += p.if_bias[lane];
            if (lane >= 4) val = fminf(val, 0.f) - log1pf(expf(-fabsf(val)));
            GIF[(size_t)row * 8 + lane] = val;
        }
    }
}

struct Epi1 {
    static constexpr bool PERM = true, AFTER_DRAIN = false;
    bf16_t *aqk, *vtm, *ga, *bq, *bk, *vtd, *gb;
    __device__ __forceinline__ void operator()(const f32x4 (&acc)[2][2][4][2], const pg8::Unit& u, int wr, int wc, int fr, int fq) const {
        const int pn = u.pn, row0 = u.pm * 256 + wr * 64 + fr, cw = wc * 32 + 8 * fq;
        if (pn >= 16 && pn < 32) {
            const int cb = 128 * (pn - 16) + cw;
#pragma unroll
            for (int ai = 0; ai < 2; ++ai)
#pragma unroll
                for (int m = 0; m < 4; ++m) {
                    const size_t row = (size_t)(row0 + ai * 128 + m * 16);
                    float f[8];
#pragma unroll
                    for (int j = 0; j < 4; ++j) { f[j] = fsig(acc[ai][0][m][0][j]) * fsig(acc[ai][1][m][0][j]); f[4 + j] = fsig(acc[ai][0][m][1][j]) * fsig(acc[ai][1][m][1][j]); }
                    *(u32x4*)(ga + row * D + cb) = pack8(f);
                }
            return;
        }
        bf16_t* dst; int col0; int mode;
        if (pn < 8) { dst = aqk; col0 = 256 * pn; mode = 0; }
        else if (pn < 16) { dst = vtm; col0 = 256 * (pn - 8); mode = 1; }
        else if (pn < 40) { dst = bq; col0 = 256 * (pn - 32); mode = 0; }
        else if (pn < 48) { dst = bk; col0 = 256 * (pn - 40); mode = 0; }
        else if (pn < 56) { dst = vtd; col0 = 256 * (pn - 48); mode = 3; }
        else { dst = gb; col0 = 256 * (pn - 56); mode = 2; }
#pragma unroll
        for (int ai = 0; ai < 2; ++ai)
#pragma unroll
            for (int m = 0; m < 4; ++m) {
                const int row = row0 + ai * 128 + m * 16;
#pragma unroll
                for (int bj = 0; bj < 2; ++bj) {
                    const int col = col0 + bj * 128 + cw;
                    float f[8];
#pragma unroll
                    for (int j = 0; j < 4; ++j) { f[j] = acc[ai][bj][m][0][j]; f[4 + j] = acc[ai][bj][m][1][j]; }
                    if (mode == 2) {
#pragma unroll
                        for (int j = 0; j < 8; ++j) f[j] = fsig(f[j]);
                    }
                    const u32x4 w = pack8(f);
                    if (mode == 3) {
                        bf16_t* d = dst + (((size_t)((row >> 13) * 8 + (col >> 8)) * 256 + ((row & (SEQ - 1)) >> 5)) * 256 + (col & 255)) * 32 + (row & 31);
                        d[0] = (bf16_t)(w.x & 0xffff); d[32] = (bf16_t)(w.x >> 16); d[64] = (bf16_t)(w.y & 0xffff); d[96] = (bf16_t)(w.y >> 16);
                        d[128] = (bf16_t)(w.z & 0xffff); d[160] = (bf16_t)(w.z >> 16); d[192] = (bf16_t)(w.w & 0xffff); d[224] = (bf16_t)(w.w >> 16);
                    } else if (mode == 1) {
                        bf16_t* d = dst + ((size_t)((row >> 13) * D + col)) * SEQ + (row & (SEQ - 1));
                        d[0 * (size_t)SEQ] = (bf16_t)(w.x & 0xffff); d[1 * (size_t)SEQ] = (bf16_t)(w.x >> 16); d[2 * (size_t)SEQ] = (bf16_t)(w.y & 0xffff); d[3 * (size_t)SEQ] = (bf16_t)(w.y >> 16);
                        d[4 * (size_t)SEQ] = (bf16_t)(w.z & 0xffff); d[5 * (size_t)SEQ] = (bf16_t)(w.z >> 16); d[6 * (size_t)SEQ] = (bf16_t)(w.w & 0xffff); d[7 * (size_t)SEQ] = (bf16_t)(w.w >> 16);
                    } else {
                        *(u32x4*)(dst + (size_t)row * D + col) = w;
                    }
                }
            }
    }
};
struct EpiRes {
    static constexpr bool PERM = false, AFTER_DRAIN = false;
    float* C; const float* R; int ldc;
    __device__ __forceinline__ void operator()(const f32x4 (&acc)[2][2][4][2], const pg8::Unit& u, int wr, int wc, int fr, int fq) const {
        const int row0 = u.pm * 256 + wr * 64 + fr, col0 = u.pn * 256 + wc * 32 + 4 * fq;
#pragma unroll
        for (int ai = 0; ai < 2; ++ai)
#pragma unroll
            for (int m = 0; m < 4; ++m) {
                const size_t off = (size_t)(row0 + ai * 128 + m * 16) * ldc + col0;
#pragma unroll
                for (int bj = 0; bj < 2; ++bj)
#pragma unroll
                    for (int n = 0; n < 2; ++n) { const f32x4 r = *(const f32x4*)(R + off + bj * 128 + n * 16); *(f32x4*)(C + off + bj * 128 + n * 16) = acc[ai][bj][m][n] + r; }
            }
    }
};
struct EpiB {
    static constexpr bool PERM = true, AFTER_DRAIN = false;
    bf16_t* O; int ldc;
    __device__ __forceinline__ void operator()(const f32x4 (&acc)[2][2][4][2], const pg8::Unit& u, int wr, int wc, int fr, int fq) const {
        const int row0 = u.pm * 256 + wr * 64 + fr, col0 = u.pn * 256 + wc * 32 + 8 * fq;
#pragma unroll
        for (int ai = 0; ai < 2; ++ai)
#pragma unroll
            for (int m = 0; m < 4; ++m) {
                bf16_t* rowp = O + (size_t)(row0 + ai * 128 + m * 16) * ldc + col0;
#pragma unroll
                for (int bj = 0; bj < 2; ++bj) {
                    u32x4 w; w.x = cvt_pk_bf16(acc[ai][bj][m][0][0], acc[ai][bj][m][0][1]); w.y = cvt_pk_bf16(acc[ai][bj][m][0][2], acc[ai][bj][m][0][3]);
                    w.z = cvt_pk_bf16(acc[ai][bj][m][1][0], acc[ai][bj][m][1][1]); w.w = cvt_pk_bf16(acc[ai][bj][m][1][2], acc[ai][bj][m][1][3]);
                    *(u32x4*)(rowp + bj * 128) = w;
                }
            }
    }
};
template <class Epi> __device__ __forceinline__ void run_gemm(unsigned char* shm, const bf16_t* A, const bf16_t* Bt, int M, int N, int K, const Epi& E) {
    pg8::Gemm g{A, Bt, M, N, K};
    pg8::StaticOrder S; S.init(M, N, (int)gridDim.x, (int)blockIdx.x);
    pg8::gemm_phase<Epi, pg8::StaticOrder, false>((PG8_LAS unsigned char*)shm, g, S, E, nullptr);
}

__device__ __forceinline__ void phase2a(const Params& p, unsigned char* shm) {
    int tid_ = threadIdx.x; asm volatile("" : "+v"(tid_)); const int tid = tid_, lane = tid & 63, wave = tid >> 6;
    const bf16_t* AQK = (const bf16_t*)(p.ws + WS_AQK);
    bf16_t* Q2 = (bf16_t*)((unsigned char*)p.out + DO_Q2); bf16_t* K2 = (bf16_t*)((unsigned char*)p.out + DO_K2); bf16_t* KT = (bf16_t*)(p.ws + WS_KT);
    bf16_t* tl = (bf16_t*)shm;
    const int nwc = gridDim.x >> 5, cgp = blockIdx.x & 31, oct = tid & 7, rg = tid >> 3, c0 = 64 * cgp + 8 * oct;
    float w[4][8], bias[8];
#pragma unroll
    for (int j = 0; j < 4; ++j) { const f32x4 a = *(const f32x4*)(p.qk_conv_w + j * D + c0), b = *(const f32x4*)(p.qk_conv_w + j * D + c0 + 4);
        w[j][0] = a.x; w[j][1] = a.y; w[j][2] = a.z; w[j][3] = a.w; w[j][4] = b.x; w[j][5] = b.y; w[j][6] = b.z; w[j][7] = b.w; }
    { const f32x4 a = *(const f32x4*)(p.qk_conv_b + c0), b = *(const f32x4*)(p.qk_conv_b + c0 + 4);
      bias[0] = a.x; bias[1] = a.y; bias[2] = a.z; bias[3] = a.w; bias[4] = b.x; bias[5] = b.y; bias[6] = b.z; bias[7] = b.w; }
    for (int ch = (int)(blockIdx.x >> 5); ch < 256 && (int)(blockIdx.x >> 5) < nwc; ch += nwc) {
        const int t0 = ch * 128;
        float in[5][8];
        const int rl0 = 2 * rg;
#pragma unroll
        for (int k = 0; k < 5; ++k) {
            const int rl = rl0 - 3 + k; const int sp = (t0 & (SEQ - 1)) + rl;
            if (sp >= 0) { const u32x4 u = *(const u32x4*)(AQK + (size_t)(t0 + rl) * D + c0); unpack8(u, in[k]); }
            else {
#pragma unroll
                for (int e = 0; e < 8; ++e) in[k][e] = 0.f; }
        }
        const bool isq = cgp < 16;
#pragma unroll
        for (int rr = 0; rr < 2; ++rr) {
            float y[8];
#pragma unroll
            for (int e = 0; e < 8; ++e) { float a = bias[e]; a += w[0][e] * in[rr][e]; a += w[1][e] * in[rr + 1][e]; a += w[2][e] * in[rr + 2][e]; a += w[3][e] * in[rr + 3][e];
                a = a * fsig(a); y[e] = isq ? a * 0.0625f : a; }
            const u32x4 o = pack8(y);
            const size_t row = (size_t)(t0 + rl0 + rr);
            if (isq) *(u32x4*)(Q2 + row * 1024 + c0) = o;
            else {
                *(u32x4*)(K2 + row * 1024 + (c0 - 1024)) = o;
            }
        }
    }
    {
        bf16_t* BQ = (bf16_t*)(p.ws + WS_BQ); bf16_t* BK = (bf16_t*)(p.ws + WS_BK);
        const int e16 = lane & 15, sub = lane >> 4;
        const float qs = 0.08838834764831845f * LOG2E;
        const f32x4 gq0 = *(const f32x4*)(p.q_norm_g + 8 * e16), gq1 = *(const f32x4*)(p.q_norm_g + 8 * e16 + 4);
        const f32x4 gk0 = *(const f32x4*)(p.k_norm_g + 8 * e16), gk1 = *(const f32x4*)(p.k_norm_g + 8 * e16 + 4);
        const int gwv = blockIdx.x * 8 + wave, ngw = gridDim.x * 8;
        for (int it = gwv; it < T * 16 / 4; it += ngw) {
            const int gid = it * 4 + sub, t = gid >> 4, grp = 16 + (gid & 15);
            const bool isq = false;
            bf16_t* ptr = (isq ? BQ : BK) + (size_t)t * D + 128 * (grp & 15) + 8 * e16;
            float f[8]; unpack8(*(const u32x4*)ptr, f);
            float ss = 0.f;
#pragma unroll
            for (int e = 0; e < 8; ++e) ss += f[e] * f[e];
            ss += __shfl_xor(ss, 1); ss += __shfl_xor(ss, 2); ss += __shfl_xor(ss, 4); ss += __shfl_xor(ss, 8);
            const float rinv = rsqrtf(ss * (1.f / 128.f) + EPS) * (isq ? qs : 1.f);
            const f32x4 g0 = isq ? gq0 : gk0, g1 = isq ? gq1 : gk1;
            f[0] *= rinv * g0.x; f[1] *= rinv * g0.y; f[2] *= rinv * g0.z; f[3] *= rinv * g0.w; f[4] *= rinv * g1.x; f[5] *= rinv * g1.y; f[6] *= rinv * g1.z; f[7] *= rinv * g1.w;
            *(u32x4*)ptr = pack8(f);
        }
    }
}

constexpr int ML_KL = 0, ML_CT = 67584, ML_VT = 101376, ML_A = 118784, ML_MM = 119296, ML_BB = 119808, ML_WS = 120320, ML_N = 120832, ML_MISC = 121856;
typedef short s16x4 __attribute__((ext_vector_type(4)));
#define ML_SB __builtin_amdgcn_sched_barrier(0)
#define ML_MFMA(a_, b_, c_) __builtin_amdgcn_mfma_f32_16x16x32_bf16(a_, b_, c_, 0, 0, 0)
__device__ __forceinline__ void ml_chain2(const unsigned char* baseA, const unsigned char* baseB, const bf16x8 (&qf)[8], f32x4& SA, f32x4& SB) {
    bf16x8 f0 = *(const bf16x8*)(baseA), f1 = *(const bf16x8*)(baseB), f2 = *(const bf16x8*)(baseA + 16), f3 = *(const bf16x8*)(baseB + 16);
    ML_SB;
#pragma unroll
    for (int ks = 0; ks < 8; ks += 2) {
        SA = ML_MFMA(f0, qf[ks], SA); if (ks + 2 < 8) f0 = *(const bf16x8*)(baseA + 16 * (ks + 2)); ML_SB;
        SB = ML_MFMA(f1, qf[ks], SB); if (ks + 2 < 8) f1 = *(const bf16x8*)(baseB + 16 * (ks + 2)); ML_SB;
        SA = ML_MFMA(f2, qf[ks + 1], SA); if (ks + 3 < 8) f2 = *(const bf16x8*)(baseA + 16 * (ks + 3)); ML_SB;
        SB = ML_MFMA(f3, qf[ks + 1], SB); if (ks + 3 < 8) f3 = *(const bf16x8*)(baseB + 16 * (ks + 3)); ML_SB;
    }
}
__device__ __forceinline__ void mlstm_item(const Params& p, unsigned char* shm, int item) {
    int tid_ = threadIdx.x; asm volatile("" : "+v"(tid_)); const int tid = tid_, lane = tid & 63, w = __builtin_amdgcn_readfirstlane(tid >> 6), l15 = lane & 15, qq = lane >> 4;
    const int sl = item & 7, hA = (item >> 3) & 3, b = item >> 5;
    const int wq = w < 4 ? w : 11 - w;
    const bf16_t* Q2 = (const bf16_t*)((const unsigned char*)p.out + DO_Q2); const bf16_t* K2 = (const bf16_t*)((const unsigned char*)p.out + DO_K2);
    const bf16_t* VTM = (const bf16_t*)(p.ws + WS_VTM); const float* GIF = (const float*)(p.ws + WS_GIF);
    bf16_t* HM = (bf16_t*)(p.ws + WS_HM);
    float* sA = (float*)(shm + ML_A); float* sMM = (float*)(shm + ML_MM); float* sBB = (float*)(shm + ML_BB); float* sWS = (float*)(shm + ML_WS); float* sN = (float*)(shm + ML_N); float* sMisc = (float*)(shm + ML_MISC);
    f32x4 Cacc[2][4], Nacc[2];
#pragma unroll
    for (int a = 0; a < 2; ++a) { Nacc[a] = (f32x4){0.f, 0.f, 0.f, 0.f};
#pragma unroll
        for (int c = 0; c < 4; ++c) Cacc[a][c] = (f32x4){0.f, 0.f, 0.f, 0.f}; }
    float m_st = 0.f;
    const bf16_t* vtrow0 = VTM + ((size_t)((b * 4 + hA) * 512 + 64 * sl)) * SEQ;
    const size_t tb = (size_t)b * SEQ;
    u32x4 stK[8], stV[2]; float gli0 = 0.f, gli1 = 0.f, glf0 = 0.f, glf1 = 0.f; bf16x8 qf[8];
    const int krow_s = tid >> 2, kpart = tid & 3, vdv = tid >> 3, vpart = tid & 7;
#define ML_LOAD_STAGE(c_) do { const size_t t0_ = tb + 128 * (c_); \
        { const bf16_t* src = K2 + (t0_ + krow_s) * 1024 + hA * 256 + kpart * 64; _Pragma("unroll") for (int e = 0; e < 8; ++e) stK[e] = *(const u32x4*)(src + 8 * e); } \
        { const bf16_t* src = vtrow0 + (size_t)vdv * SEQ + 128 * (c_) + vpart * 16; stV[0] = *(const u32x4*)src; stV[1] = *(const u32x4*)(src + 8); } \
        if (w == 0) { gli0 = GIF[(t0_ + 2 * lane) * 8 + hA]; gli1 = GIF[(t0_ + 2 * lane + 1) * 8 + hA]; glf0 = GIF[(t0_ + 2 * lane) * 8 + 4 + hA]; glf1 = GIF[(t0_ + 2 * lane + 1) * 8 + 4 + hA]; } } while (0)
#define ML_LOAD_Q(c_) do { const bf16_t* qp = Q2 + (tb + 128 * (c_) + 16 * wq + l15) * 1024 + hA * 256 + 64 * qq; _Pragma("unroll") for (int ks = 0; ks < 8; ++ks) qf[ks] = *(const bf16x8*)(qp + 8 * ks); } while (0)
#define ML_WRITE_STAGE() do { \
        { unsigned char* dst = shm + ML_KL + krow_s * 528 + kpart * 128; _Pragma("unroll") for (int e = 0; e < 8; ++e) *(u32x4*)(dst + 16 * e) = stK[e]; } \
        { unsigned char* dst = shm + ML_VT + vdv * 272 + vpart * 32; *(u32x4*)dst = stV[0]; *(u32x4*)(dst + 16) = stV[1]; } \
        _Pragma("unroll") for (int dkb = 0; dkb < 2; ++dkb) { \
            _Pragma("unroll") for (int dvb = 0; dvb < 4; ++dvb) { u32x2 o; o.x = cvt_pk_bf16(Cacc[dkb][dvb][0], Cacc[dkb][dvb][1]); o.y = cvt_pk_bf16(Cacc[dkb][dvb][2], Cacc[dkb][dvb][3]); \
                *(u32x2*)(shm + ML_CT + (16 * dvb + l15) * 528 + (32 * w + 16 * dkb + 4 * qq) * 2) = o; } \
            if (l15 == 0) *(f32x4*)(sN + 32 * w + 16 * dkb + 4 * qq) = Nacc[dkb]; } \
        if (w == 0) { \
            float cs = glf0 + glf1; \
            _Pragma("unroll") for (int o = 1; o < 64; o <<= 1) { const float v = __shfl_up(cs, o); if (lane >= o) cs += v; } \
            const float b1 = cs, b0 = cs - glf1; const float a0 = gli0 - b0, a1 = gli1 - b1; \
            float pmx = fmaxf(a0, a1); \
            _Pragma("unroll") for (int o = 1; o < 64; o <<= 1) { const float v = __shfl_up(pmx, o); if (lane >= o) pmx = fmaxf(pmx, v); } \
            float ex = __shfl_up(pmx, 1); if (lane == 0) ex = -3.0e38f; \
            const float pm0 = fmaxf(ex, a0), pm1 = pmx; const float mm0 = fmaxf(pm0, m_st), mm1 = fmaxf(pm1, m_st); \
            const float mml = __shfl(mm1, 63), bl = __shfl(b1, 63); \
            sA[2 * lane] = a0; sA[2 * lane + 1] = a1; sMM[2 * lane] = mm0; sMM[2 * lane + 1] = mm1; sBB[2 * lane] = b0; sBB[2 * lane + 1] = b1; \
            sWS[2 * lane] = __expf(a0 - mml); sWS[2 * lane + 1] = __expf(a1 - mml); \
            if (lane == 0) { sMisc[0] = bl; sMisc[1] = mml; } } } while (0)
    ML_LOAD_STAGE(0); ML_LOAD_Q(0);
    ML_WRITE_STAGE();
    for (int c = 0; c < 64; ++c) {
        __syncthreads();
        if (c + 1 < 64) ML_LOAD_STAGE(c + 1);
        const size_t t0 = tb + 128 * c;
        const int tl = 16 * wq + l15;
        const float mm_t = sMM[tl], b_t = sBB[tl], gi = __expf(m_st - mm_t);
        bf16x8 pf[4]; float den = 0.f;
#pragma unroll
        for (int a = 0; a < 4; ++a) {
            pf[a] = (bf16x8){0, 0, 0, 0, 0, 0, 0, 0};
            if (2 * a <= wq) {
                f32x4 S0 = (f32x4){0.f, 0.f, 0.f, 0.f}, S1 = (f32x4){0.f, 0.f, 0.f, 0.f};
                const unsigned char* kp = shm + ML_KL + (32 * a + 8 * (l15 >> 2) + (l15 & 3)) * 528 + 128 * qq;
                ml_chain2(kp, kp + 4 * 528, qf, S0, S1);
                const int key0 = 32 * a + 8 * qq;
                const f32x4 av0 = *(const f32x4*)(sA + key0), av1 = *(const f32x4*)(sA + key0 + 4);
                float pv[8];
#pragma unroll
                for (int i = 0; i < 4; ++i) { pv[i] = (key0 + i <= tl) ? S0[i] * __expf(av0[i] - mm_t) : 0.f; pv[4 + i] = (key0 + 4 + i <= tl) ? S1[i] * __expf(av1[i] - mm_t) : 0.f; den += pv[i] + pv[4 + i]; }
                pf[a] = __builtin_bit_cast(bf16x8, pack8(pv));
            }
        }
        den += __shfl_xor(den, 16); den += __shfl_xor(den, 32);
        f32x4 num[4];
        { const unsigned char* cp = shm + ML_CT + l15 * 528 + 128 * qq;
          f32x4 n0 = (f32x4){0.f, 0.f, 0.f, 0.f}, n1 = n0, n2 = n0, n3 = n0;
          ml_chain2(cp, cp + 16 * 528, qf, n0, n1); ml_chain2(cp + 32 * 528, cp + 48 * 528, qf, n2, n3);
          num[0] = n0 * gi; num[1] = n1 * gi; num[2] = n2 * gi; num[3] = n3 * gi; }
        float qn = 0.f;
#pragma unroll
        for (int ks = 0; ks < 8; ++ks) {
            float qv[8]; unpack8(__builtin_bit_cast(u32x4, qf[ks]), qv);
            const f32x4 n0 = *(const f32x4*)(sN + 64 * qq + 8 * ks), n1 = *(const f32x4*)(sN + 64 * qq + 8 * ks + 4);
            qn += (qv[0] * n0.x + qv[1] * n0.y) + (qv[2] * n0.z + qv[3] * n0.w) + (qv[4] * n1.x + qv[5] * n1.y) + (qv[6] * n1.z + qv[7] * n1.w);
        }
        qn += __shfl_xor(qn, 16); qn += __shfl_xor(qn, 32);
        den += gi * qn;
        ML_SB;
        if (c + 1 < 64) ML_LOAD_Q(c + 1);
        ML_SB;
#pragma unroll
        for (int a = 0; a < 4; ++a) {
            if (2 * a <= wq) {
                const unsigned char* vp = shm + ML_VT + l15 * 272 + (32 * a + 8 * qq) * 2;
                const bf16x8 v0 = *(const bf16x8*)(vp), v1 = *(const bf16x8*)(vp + 16 * 272), v2 = *(const bf16x8*)(vp + 32 * 272), v3 = *(const bf16x8*)(vp + 48 * 272);
                ML_SB;
                num[0] = ML_MFMA(v0, pf[a], num[0]); num[1] = ML_MFMA(v1, pf[a], num[1]); num[2] = ML_MFMA(v2, pf[a], num[2]); num[3] = ML_MFMA(v3, pf[a], num[3]);
            }
        }
        { const float dn = __builtin_amdgcn_rcpf(fmaxf(fabsf(den), __expf(-(b_t + mm_t))));
          bf16_t* hp = HM + (t0 + tl) * D + hA * 512 + 64 * sl + 4 * qq;
#pragma unroll
          for (int dvb = 0; dvb < 4; ++dvb) { u32x2 o; o.x = cvt_pk_bf16(num[dvb][0] * dn, num[dvb][1] * dn); o.y = cvt_pk_bf16(num[dvb][2] * dn, num[dvb][3] * dn); *(u32x2*)(hp + 16 * dvb) = o; } }
        const float b_last = sMisc[0], mm_last = sMisc[1], decay = __expf(m_st - mm_last);
#pragma unroll
        for (int dkb = 0; dkb < 2; ++dkb) { Nacc[dkb] = Nacc[dkb] * decay;
#pragma unroll
            for (int dvb = 0; dvb < 4; ++dvb) Cacc[dkb][dvb] = Cacc[dkb][dvb] * decay; }
#pragma unroll
        for (int a = 0; a < 4; ++a) {
            const f32x4 w0 = *(const f32x4*)(sWS + 32 * a + 8 * qq), w1 = *(const f32x4*)(sWS + 32 * a + 8 * qq + 4);
            const unsigned char* tp = shm + ML_KL + (32 * a + 8 * qq + (l15 >> 2)) * 528 + (32 * w + 4 * (l15 & 3)) * 2;
            const s16x4 t00 = __builtin_amdgcn_ds_read_tr16_b64_v4i16((PG8_LAS s16x4*)(tp)), t01 = __builtin_amdgcn_ds_read_tr16_b64_v4i16((PG8_LAS s16x4*)(tp + 4 * 528));
            const s16x4 t10 = __builtin_amdgcn_ds_read_tr16_b64_v4i16((PG8_LAS s16x4*)(tp + 32)), t11 = __builtin_amdgcn_ds_read_tr16_b64_v4i16((PG8_LAS s16x4*)(tp + 32 + 4 * 528));
            const unsigned char* vp = shm + ML_VT + l15 * 272 + (32 * a + 8 * qq) * 2;
            const u32x4 r0 = *(const u32x4*)(vp), r1 = *(const u32x4*)(vp + 16 * 272), r2 = *(const u32x4*)(vp + 32 * 272), r3 = *(const u32x4*)(vp + 48 * 272);
            ML_SB;
            bf16x8 kt0, kt1;
            kt0[0] = t00[0]; kt0[1] = t00[1]; kt0[2] = t00[2]; kt0[3] = t00[3]; kt0[4] = t01[0]; kt0[5] = t01[1]; kt0[6] = t01[2]; kt0[7] = t01[3];
            kt1[0] = t10[0]; kt1[1] = t10[1]; kt1[2] = t10[2]; kt1[3] = t10[3]; kt1[4] = t11[0]; kt1[5] = t11[1]; kt1[6] = t11[2]; kt1[7] = t11[3];
            float wsv[8] = {w0.x, w0.y, w0.z, w0.w, w1.x, w1.y, w1.z, w1.w};
            float zf[8];
#pragma unroll
            for (int e = 0; e < 8; ++e) zf[e] = (l15 == 0) ? wsv[e] : 0.f;
            const bf16x8 wsf = __builtin_bit_cast(bf16x8, pack8(zf));
            Nacc[0] = ML_MFMA(kt0, wsf, Nacc[0]); Nacc[1] = ML_MFMA(kt1, wsf, Nacc[1]);
            const u32x4 rr[4] = {r0, r1, r2, r3};
#pragma unroll
            for (int dvb = 0; dvb < 4; ++dvb) {
                float vv[8]; unpack8(rr[dvb], vv);
#pragma unroll
                for (int e = 0; e < 8; ++e) vv[e] *= wsv[e];
                const bf16x8 wv = __builtin_bit_cast(bf16x8, pack8(vv));
                Cacc[0][dvb] = ML_MFMA(kt0, wv, Cacc[0][dvb]); Cacc[1][dvb] = ML_MFMA(kt1, wv, Cacc[1][dvb]);
            }
        }
        m_st = b_last + mm_last;
        __syncthreads();
        if (c + 1 < 64) ML_WRITE_STAGE();
    }
#undef ML_LOAD_STAGE
#undef ML_LOAD_Q
#undef ML_WRITE_STAGE
}
#undef ML_SB
#undef ML_MFMA

constexpr int AT_V = 16384, AT_BUF = 32768;
__device__ __forceinline__ void attn_item(const Params& p, unsigned char* shm, int b, int h, int qb, float lam, float M2) {
    int tid_ = threadIdx.x; asm volatile("" : "+v"(tid_)); const int tid = tid_, lane = tid & 63, wave = __builtin_amdgcn_readfirstlane(tid >> 6), c = wave & 1, g = wave >> 1, r = lane & 31, hh = lane >> 5;
    const bf16_t* BQ = (const bf16_t*)(p.ws + WS_BQ); const bf16_t* BK = (const bf16_t*)(p.ws + WS_BK); const bf16_t* VTD = (const bf16_t*)(p.ws + WS_VTD); const bf16_t* GB = (const bf16_t*)(p.ws + WS_GB);
    bf16_t* YB = (bf16_t*)((unsigned char*)p.out + DO_YB);
    float* cmb = (float*)shm;
    const int tq = qb * 128 + 32 * g + r; const size_t rowq = (size_t)b * SEQ + tq;
    bf16x8 qf[8];
    { const bf16_t* qp = BQ + rowq * D + h * 256 + c * 128 + 64 * hh;
#pragma unroll
      for (int ks = 0; ks < 8; ++ks) qf[ks] = *(const bf16x8*)(qp + 8 * ks); }
    {
        float ss = 0.f;
#pragma unroll
        for (int ks = 0; ks < 8; ++ks) { float v[8]; unpack8(__builtin_bit_cast(u32x4, qf[ks]), v);
#pragma unroll
            for (int e = 0; e < 8; ++e) ss += v[e] * v[e]; }
        ss += __shfl_xor(ss, 32);
        const float rq = rsqrtf(ss * (1.f / 128.f) + EPS) * (0.08838834764831845f * LOG2E);
#pragma unroll
        for (int ks = 0; ks < 8; ++ks) { float v[8]; unpack8(__builtin_bit_cast(u32x4, qf[ks]), v);
            const f32x4 g0 = *(const f32x4*)(p.q_norm_g + 64 * hh + 8 * ks), g1 = *(const f32x4*)(p.q_norm_g + 64 * hh + 8 * ks + 4);
            v[0] *= rq * g0.x; v[1] *= rq * g0.y; v[2] *= rq * g0.z; v[3] *= rq * g0.w; v[4] *= rq * g1.x; v[5] *= rq * g1.y; v[6] *= rq * g1.z; v[7] *= rq * g1.w;
            qf[ks] = __builtin_bit_cast(bf16x8, pack8(v)); }
    }
    f32x16 O[8];
#pragma unroll
    for (int db = 0; db < 8; ++db)
#pragma unroll
        for (int i = 0; i < 16; ++i) O[db][i] = 0.f;
    float lsum = 0.f;
    const float slope2 = exp2f(-(float)(h + 1)) * LOG2E;
    const int ntile_w = qb * 4 + g + 1, ntile = qb * 4 + 4;
    int kt0 = (int)ceilf(((float)(qb * 128 - 31) - (150.f + 2.f * M2) / slope2) * (1.f / 32.f)); kt0 = kt0 < 0 ? 0 : kt0;
    const int keyperm = (r & 19) | ((r & 4) << 1) | ((r & 8) >> 1);
    const char* kgb = (const char*)(BK + ((size_t)b * SEQ) * D + h * 256);
    const char* vgb = (const char*)(VTD + ((size_t)(b * 8 + h) * 256) * 8192);
#define AT_ISSUE(kt_, dst_) do { const char* kb_ = kgb + (size_t)(32 * (kt_)) * (D * 2); const char* vb_ = vgb + (size_t)(kt_) * 16384; \
        int ln_ = lane; asm volatile("" : "+v"(ln_)); unsigned kgo[2], vgo[2];   \
        _Pragma("unroll") for (int j = 0; j < 2; ++j) { const int R = 8 * wave + 4 * j + (ln_ >> 4); kgo[j] = (unsigned)((R & 31) * D + (R >> 5) * 128 + 8 * ((ln_ & 15) ^ (R & 15))) * 2u; \
            const int dv = 32 * wave + 16 * j + (ln_ >> 2); vgo[j] = (unsigned)(dv * 32 + 8 * ((ln_ & 3) ^ ((dv >> 2) & 3))) * 2u; } \
        _Pragma("unroll") for (int j = 0; j < 2; ++j) __builtin_amdgcn_global_load_lds((const unsigned*)(kb_ + kgo[j]), (PG8_LAS unsigned*)((dst_) + (2 * wave + j) * 1024), 16, 0, 0); \
        _Pragma("unroll") for (int j = 0; j < 2; ++j) __builtin_amdgcn_global_load_lds((const unsigned*)(vb_ + vgo[j]), (PG8_LAS unsigned*)((dst_) + AT_V + (2 * wave + j) * 1024), 16, 0, 0); } while (0)
    const int krow = (c * 32 + keyperm) * 256, kx = keyperm & 15;
    const int vrow = AT_V + r * 64, vf_ = hh ^ ((r >> 2) & 3);
    __syncthreads();
    const int kt0e = kt0 & ~1, n64 = (ntile - kt0e) >> 1;
    AT_ISSUE(kt0e, shm); AT_ISSUE(kt0e + 1, shm + AT_BUF);
    asm volatile("s_waitcnt vmcnt(0)" ::: "memory");
    __builtin_amdgcn_s_barrier(); asm volatile("" ::: "memory");
    for (int it = 0; it < n64; ++it) {
      unsigned char* slot = shm + (it & 1) * (2 * AT_BUF);
      if (it + 1 < n64) { unsigned char* ns = shm + ((it & 1) ^ 1) * (2 * AT_BUF); AT_ISSUE(kt0e + 2 * it + 2, ns); AT_ISSUE(kt0e + 2 * it + 3, ns + AT_BUF); }
#pragma unroll
      for (int u = 0; u < 2; ++u) {
        const int kt = kt0e + 2 * it + u;
        const int s0 = 32 * kt;
        unsigned char* buf = slot + u * AT_BUF;
        if (kt < ntile_w) {
#define AT_KF(ks_) (*(const bf16x8*)(buf + krow + 16 * ((8 * hh + (ks_)) ^ kx)))
#define AT_VF(i_) (*(const bf16x8*)(buf + vrow + ((i_) & 7) * 2048 + 16 * ((2 * ((i_) >> 3)) ^ vf_)))
#define AT_SB __builtin_amdgcn_sched_barrier(0)
            const float base = slope2 * (float)(s0 + 8 * hh - tq) - M2;
            f32x16 S;
#pragma unroll
            for (int i = 0; i < 16; ++i) S[i] = fmaf(slope2, (float)((i & 3) + 4 * ((i >> 2) & 1) + 16 * (i >> 3)), base);
            bf16x8 f0 = AT_KF(0), f1 = AT_KF(1), f2 = AT_KF(2), f3 = AT_KF(3);
            AT_SB;
            S = __builtin_amdgcn_mfma_f32_32x32x16_bf16(f0, qf[0], S, 0, 0, 0); f0 = AT_KF(4); AT_SB;
            S = __builtin_amdgcn_mfma_f32_32x32x16_bf16(f1, qf[1], S, 0, 0, 0); f1 = AT_KF(5); AT_SB;
            S = __builtin_amdgcn_mfma_f32_32x32x16_bf16(f2, qf[2], S, 0, 0, 0); f2 = AT_KF(6); AT_SB;
            S = __builtin_amdgcn_mfma_f32_32x32x16_bf16(f3, qf[3], S, 0, 0, 0); f3 = AT_KF(7); AT_SB;
            S = __builtin_amdgcn_mfma_f32_32x32x16_bf16(f0, qf[4], S, 0, 0, 0); f0 = AT_VF(0); AT_SB;
            S = __builtin_amdgcn_mfma_f32_32x32x16_bf16(f1, qf[5], S, 0, 0, 0); f1 = AT_VF(1); AT_SB;
            S = __builtin_amdgcn_mfma_f32_32x32x16_bf16(f2, qf[6], S, 0, 0, 0); f2 = AT_VF(2); AT_SB;
            S = __builtin_amdgcn_mfma_f32_32x32x16_bf16(f3, qf[7], S, 0, 0, 0); f3 = AT_VF(3); AT_SB;
            float pv[16];
#pragma unroll
            for (int i = 0; i < 16; ++i) pv[i] = __builtin_amdgcn_exp2f(S[i]);
            if (kt == ntile_w - 1) {
#pragma unroll
                for (int i = 0; i < 16; ++i) { const int key = s0 + (i & 3) + 4 * ((i >> 2) & 1) + 8 * hh + 16 * (i >> 3); pv[i] = (key <= tq) ? pv[i] : 0.f; }
            }
#pragma unroll
            for (int i = 0; i < 16; ++i) lsum += pv[i];
            bf16x8 pf[2];
#pragma unroll
            for (int k2 = 0; k2 < 2; ++k2) { u32x4 u; u.x = cvt_pk_bf16(pv[8 * k2 + 0], pv[8 * k2 + 1]); u.y = cvt_pk_bf16(pv[8 * k2 + 2], pv[8 * k2 + 3]); u.z = cvt_pk_bf16(pv[8 * k2 + 4], pv[8 * k2 + 5]); u.w = cvt_pk_bf16(pv[8 * k2 + 6], pv[8 * k2 + 7]);
                pf[k2] = __builtin_bit_cast(bf16x8, u); }
            AT_SB;
#define AT_PV(i_, f_) do { O[(i_) & 7] = __builtin_amdgcn_mfma_f32_32x32x16_bf16(f_, pf[(i_) >> 3], O[(i_) & 7], 0, 0, 0); if ((i_) + 4 < 16) f_ = AT_VF((i_) + 4); AT_SB; } while (0)
            AT_PV(0, f0); AT_PV(1, f1); AT_PV(2, f2); AT_PV(3, f3); AT_PV(4, f0); AT_PV(5, f1); AT_PV(6, f2); AT_PV(7, f3);
            AT_PV(8, f0); AT_PV(9, f1); AT_PV(10, f2); AT_PV(11, f3); AT_PV(12, f0); AT_PV(13, f1); AT_PV(14, f2); AT_PV(15, f3);
#undef AT_PV
#undef AT_KF
#undef AT_VF
#undef AT_SB
        }
      }
      asm volatile("s_waitcnt vmcnt(0)" ::: "memory");
      asm volatile("s_waitcnt lgkmcnt(0)" ::: "memory");
      __builtin_amdgcn_s_barrier(); asm volatile("" ::: "memory");
    }
#undef AT_ISSUE
    const float ltot = lsum + __shfl_xor(lsum, 32);
    const float inv = 1.f / ltot;
    if (c == 1) {
#pragma unroll
        for (int db = 0; db < 8; ++db)
#pragma unroll
            for (int i = 0; i < 16; ++i) { const int dv = 32 * db + (i & 3) + 8 * (i >> 2) + 4 * hh; cmb[(g * 256 + dv) * 32 + r] = O[db][i] * inv; }
    }
    __syncthreads();
    if (c == 0) {
        float ss = 0.f;
#pragma unroll
        for (int db = 0; db < 8; ++db)
#pragma unroll
            for (int i = 0; i < 16; ++i) { const int dv = 32 * db + (i & 3) + 8 * (i >> 2) + 4 * hh; const float o = O[db][i] * inv - lam * cmb[(g * 256 + dv) * 32 + r]; O[db][i] = o; ss += o * o; }
        ss += __shfl_xor(ss, 32);
        const float rinv = rsqrtf(ss * (1.f / 256.f) + EPS) * 0.8f;
#pragma unroll
        for (int db = 0; db < 8; ++db)
#pragma unroll
            for (int ig = 0; ig < 4; ++ig) {
                const int dv0 = 32 * db + 8 * ig + 4 * hh; const size_t off = rowq * D + h * 256 + dv0;
                const u32x2 gbu = *(const u32x2*)(GB + off); const f32x4 sg = *(const f32x4*)(p.subln_g + dv0);
                u32x2 o; o.x = cvt_pk_bf16(O[db][4 * ig + 0] * rinv * sg.x * bflo(gbu.x), O[db][4 * ig + 1] * rinv * sg.y * bfhi(gbu.x));
                o.y = cvt_pk_bf16(O[db][4 * ig + 2] * rinv * sg.z * bflo(gbu.y), O[db][4 * ig + 3] * rinv * sg.w * bfhi(gbu.y));
                *(u32x2*)(YB + off) = o;
            }
    }
}

__device__ __forceinline__ void phase2b(const Params& p, unsigned char* shm, int rep) {
    int tid_ = threadIdx.x; asm volatile("" : "+v"(tid_)); const int tid = tid_, lane = tid & 63;
    if (blockIdx.x < 128) { const int xcd = blockIdx.x & 7, idx = blockIdx.x >> 3; mlstm_item(p, shm, (xcd * 2 + (idx >> 3)) * 8 + (idx & 7)); }
    float lam, M2;
    { const float a0 = p.diff_lambda[lane] * p.diff_lambda[128 + lane] + p.diff_lambda[64 + lane] * p.diff_lambda[192 + lane];
      const float a1 = p.diff_lambda[256 + lane] * p.diff_lambda[384 + lane] + p.diff_lambda[320 + lane] * p.diff_lambda[448 + lane];
      lam = expf(wave_sum(a0)) - expf(wave_sum(a1)) + 0.2f;
      float mq = fmaxf(fabsf(p.q_norm_g[lane]), fabsf(p.q_norm_g[64 + lane])), mk = fmaxf(fabsf(p.k_norm_g[lane]), fabsf(p.k_norm_g[64 + lane]));
#pragma unroll
      for (int o = 1; o < 64; o <<= 1) { mq = fmaxf(mq, __shfl_xor(mq, o)); mk = fmaxf(mk, __shfl_xor(mk, o)); }
      M2 = 128.f * mq * mk * 0.08838834764831845f * LOG2E * 1.02f;
      lam = __uint_as_float(__builtin_amdgcn_readfirstlane(__float_as_uint(lam))); M2 = __uint_as_float(__builtin_amdgcn_readfirstlane(__float_as_uint(M2))); }
    unsigned* ctr = (unsigned*)(p.ws + WS_CTL) + 128 * rep;
    int* sItem = (int*)(shm + 147456 - 64);
    const int myx = blockIdx.x & 7;
    for (;;) {
        __syncthreads();
        if (tid == 0) { int it = -1;
            for (int k = 0; k < 8; ++k) { const int q = (myx + k) & 7; const unsigned v = atomicAdd(ctr + 16 * q, 1u); if (v < 256u) { it = q * 256 + (int)v; break; } }
            *sItem = it; }
        __syncthreads();
        const int item = *sItem;
        if (item < 0) break;
        const int q = item >> 8, v = item & 255, b = v >> 6, qb = 63 - (v & 63);
        const int h = (b == 0) ? q : (b == 1) ? 7 - q : (b == 2) ? ((q + 4) & 7) : ((3 - q) & 7);
        attn_item(p, shm, b, h, qb, lam, M2);
    }
}

__device__ __forceinline__ void phase3(const Params& p, unsigned char* shm) {
    int tid_ = threadIdx.x; asm volatile("" : "+v"(tid_)); const int tid = tid_, lane = tid & 63, wave = tid >> 6, gw = blockIdx.x * 8 + wave, ngw = gridDim.x * 8;
    float* scr = (float*)(shm + wave * 8448);
    transpose_plain(p.w_out, D, D, (bf16_t*)(p.ws + WS_WOUT), scr, gw, ngw, lane);
    { const int nblk = 2 * DFF / 32, nitems = (D / 64) * nblk; bf16_t* WuT = (bf16_t*)(p.ws + WS_WUP);
      for (int it = gw; it < nitems; it += ngw) { const int kb = it / nblk, nb = it % nblk, n = 32 * nb, pt = n >> 8, j = n & 255;
          transpose_item(p.w_up, (size_t)(2 * DFF), D, WuT, 64 * kb, j < 128 ? 128 * pt + j : DFF + 128 * pt + (j - 128), n, scr, lane); } }
    transpose_plain(p.w_down, DFF, D, (bf16_t*)(p.ws + WS_WDN), scr, gw, ngw, lane);
    const bf16_t* HM = (const bf16_t*)(p.ws + WS_HM); const bf16_t* GA = (const bf16_t*)(p.ws + WS_GA); bf16_t* Y = (bf16_t*)(p.ws + WS_BQ); const bf16_t* YBp = (const bf16_t*)((const unsigned char*)p.out + DO_YB);
    for (int it = gw; it < T * 4; it += ngw) {
        const size_t off = (size_t)(it >> 2) * D + (it & 3) * 512 + 8 * lane;
        float hm[8], ga[8], yb[8]; unpack8(*(const u32x4*)(HM + off), hm); unpack8(*(const u32x4*)(GA + off), ga); unpack8(*(const u32x4*)(YBp + off), yb);
        float ss = 0.f;
#pragma unroll
        for (int e = 0; e < 8; ++e) ss += hm[e] * hm[e];
        const float rinv = rsqrtf(wave_sum(ss) * (1.f / 512.f) + EPS);
        const f32x4 g0 = *(const f32x4*)(p.mlstm_norm_g + (it & 3) * 512 + 8 * lane), g1 = *(const f32x4*)(p.mlstm_norm_g + (it & 3) * 512 + 8 * lane + 4);
        float y[8];
        y[0] = ga[0] * hm[0] * rinv * g0.x + yb[0]; y[1] = ga[1] * hm[1] * rinv * g0.y + yb[1]; y[2] = ga[2] * hm[2] * rinv * g0.z + yb[2]; y[3] = ga[3] * hm[3] * rinv * g0.w + yb[3];
        y[4] = ga[4] * hm[4] * rinv * g1.x + yb[4]; y[5] = ga[5] * hm[5] * rinv * g1.y + yb[5]; y[6] = ga[6] * hm[6] * rinv * g1.z + yb[6]; y[7] = ga[7] * hm[7] * rinv * g1.w + yb[7];
        *(u32x4*)(Y + off) = pack8(y);
    }
}
__device__ __forceinline__ void phase5(const Params& p) {
    int tid_ = threadIdx.x; asm volatile("" : "+v"(tid_)); const int tid = tid_, lane = tid & 63, wave = tid >> 6, gw = blockIdx.x * 8 + wave, ngw = gridDim.x * 8;
    bf16_t* H2 = (bf16_t*)(p.ws + WS_H2);
    f32x4 g2r[8];
#pragma unroll
    for (int j = 0; j < 8; ++j) g2r[j] = *((const f32x4*)p.norm2_g + lane + 64 * j);
    for (int row = gw; row < T; row += ngw) {
        const f32x4* xr = (const f32x4*)(p.out + (size_t)row * D) + lane;
        f32x4 v[8]; float ss = 0.f;
#pragma unroll
        for (int j = 0; j < 8; ++j) { v[j] = xr[64 * j]; ss += (v[j].x * v[j].x + v[j].y * v[j].y) + (v[j].z * v[j].z + v[j].w * v[j].w); }
        const float rinv = rsqrtf(wave_sum(ss) * (1.f / D) + EPS);
        u32x2* o8 = (u32x2*)(H2 + (size_t)row * D) + lane;
#pragma unroll
        for (int j = 0; j < 8; ++j) { const f32x4 g = g2r[j];
            u32x2 o; o.x = cvt_pk_bf16(v[j].x * rinv * g.x, v[j].y * rinv * g.y); o.y = cvt_pk_bf16(v[j].z * rinv * g.z, v[j].w * rinv * g.w); o8[64 * j] = o; }
    }
}
__device__ __forceinline__ float dpp_ror1(float v) { return __int_as_float(__builtin_amdgcn_update_dpp(0, __float_as_int(v), 0x121, 0xf, 0xf, false)); }
__device__ __forceinline__ float dpp_ror2(float v) { return __int_as_float(__builtin_amdgcn_update_dpp(0, __float_as_int(v), 0x122, 0xf, 0xf, false)); }
struct EpiUp {
    static constexpr bool PERM = true, AFTER_DRAIN = false;
    bf16_t* act; bf16_t* sb; const float* cw; const float* cb;
    __device__ __forceinline__ void operator()(const f32x4 (&acc)[2][2][4][2], const pg8::Unit& u, int wr, int wc, int fr_in, int fq_in) const {
        int fr = fr_in, fq = fq_in; asm volatile("" : "+v"(fr), "+v"(fq));
        const int row0 = u.pm * 256 + wr * 64 + fr;
#pragma unroll
        for (int n = 0; n < 2; ++n) {
            const int cl = u.pn * 128 + wc * 32 + 8 * fq + 4 * n;
            const f32x4 wg0 = *(const f32x4*)(cw + cl), wg1 = *(const f32x4*)(cw + (size_t)2 * DFF + cl), wg2 = *(const f32x4*)(cw + (size_t)4 * DFF + cl);
            const f32x4 wv0 = *(const f32x4*)(cw + DFF + cl), wv1 = *(const f32x4*)(cw + (size_t)3 * DFF + cl), wv2 = *(const f32x4*)(cw + (size_t)5 * DFF + cl);
            const f32x4 bg = *(const f32x4*)(cb + cl), bv = *(const f32x4*)(cb + DFF + cl);
#pragma unroll
            for (int ai = 0; ai < 2; ++ai) {
#pragma unroll
                for (int m = 0; m < 4; ++m) {
                    const int row = row0 + ai * 128 + m * 16;
                    const f32x4 g = acc[ai][0][m][n], v = acc[ai][1][m][n];
                    const f32x4 gp = acc[ai][0][m > 0 ? m - 1 : 0][n], vp = acc[ai][1][m > 0 ? m - 1 : 0][n];
                    if ((m == 0 && fr < 2) || (m == 3 && fr >= 14)) {
                        const int slot = (m == 0) ? fr : fr - 12;
                        bf16_t* d = sb + ((size_t)(row >> 6) * 4 + slot) * (2 * DFF) + cl;
                        u32x2 og, ov; og.x = cvt_pk_bf16(g[0], g[1]); og.y = cvt_pk_bf16(g[2], g[3]); ov.x = cvt_pk_bf16(v[0], v[1]); ov.y = cvt_pk_bf16(v[2], v[3]);
                        *(u32x2*)d = og; *(u32x2*)(d + DFF) = ov;
                    }
                    f32x4 y;
#pragma unroll
                    for (int e = 0; e < 4; ++e) {
                        const float xg1 = dpp_ror1(fr == 15 ? gp[e] : g[e]), xg2 = dpp_ror2(fr >= 14 ? gp[e] : g[e]);
                        const float xv1 = dpp_ror1(fr == 15 ? vp[e] : v[e]), xv2 = dpp_ror2(fr >= 14 ? vp[e] : v[e]);
                        const float ug = bg[e] + wg0[e] * xg2 + wg1[e] * xg1 + wg2[e] * g[e];
                        const float uv = bv[e] + wv0[e] * xv2 + wv1[e] * xv1 + wv2[e] * v[e];
                        y[e] = ug * fsig(ug) * uv;
                    }
                    if (!(m == 0 && fr < 2)) { u32x2 o; o.x = cvt_pk_bf16(y[0], y[1]); o.y = cvt_pk_bf16(y[2], y[3]); *(u32x2*)(act + (size_t)row * DFF + cl) = o; }
                }
            }
        }
    }
};
__device__ __forceinline__ void phase_fix(const Params& p) {
    const bf16_t* SB = (const bf16_t*)(p.ws + WS_SB); bf16_t* ACT = (bf16_t*)(p.ws + WS_ACT);
    int tid_ = threadIdx.x; asm volatile("" : "+v"(tid_)); const int gt = blockIdx.x * 512 + tid_, ngt = gridDim.x * 512;
    for (int idx = gt; idx < (T / 64) * 704; idx += ngt) {
        const int oct = idx % 704, kb = idx / 704, c0 = 8 * oct, r0 = 64 * kb;
        float wg[3][8], wv[3][8], bg[8], bv[8];
#pragma unroll
        for (int j = 0; j < 3; ++j) {
            const f32x4 a = *(const f32x4*)(p.ffn_conv_w + (size_t)j * 2 * DFF + c0), b = *(const f32x4*)(p.ffn_conv_w + (size_t)j * 2 * DFF + c0 + 4);
            const f32x4 c = *(const f32x4*)(p.ffn_conv_w + (size_t)j * 2 * DFF + DFF + c0), d = *(const f32x4*)(p.ffn_conv_w + (size_t)j * 2 * DFF + DFF + c0 + 4);
            wg[j][0] = a.x; wg[j][1] = a.y; wg[j][2] = a.z; wg[j][3] = a.w; wg[j][4] = b.x; wg[j][5] = b.y; wg[j][6] = b.z; wg[j][7] = b.w;
            wv[j][0] = c.x; wv[j][1] = c.y; wv[j][2] = c.z; wv[j][3] = c.w; wv[j][4] = d.x; wv[j][5] = d.y; wv[j][6] = d.z; wv[j][7] = d.w;
        }
        { const f32x4 a = *(const f32x4*)(p.ffn_conv_b + c0), b = *(const f32x4*)(p.ffn_conv_b + c0 + 4), c = *(const f32x4*)(p.ffn_conv_b + DFF + c0), d = *(const f32x4*)(p.ffn_conv_b + DFF + c0 + 4);
          bg[0] = a.x; bg[1] = a.y; bg[2] = a.z; bg[3] = a.w; bg[4] = b.x; bg[5] = b.y; bg[6] = b.z; bg[7] = b.w; bv[0] = c.x; bv[1] = c.y; bv[2] = c.z; bv[3] = c.w; bv[4] = d.x; bv[5] = d.y; bv[6] = d.z; bv[7] = d.w; }
        float g2[8], g1[8], v2[8], v1[8];
        if ((r0 & (SEQ - 1)) != 0) {
            const bf16_t* pr = SB + ((size_t)(kb - 1) * 4 + 2) * (2 * DFF) + c0;
            unpack8(*(const u32x4*)pr, g2); unpack8(*(const u32x4*)(pr + DFF), v2); unpack8(*(const u32x4*)(pr + 2 * DFF), g1); unpack8(*(const u32x4*)(pr + 2 * DFF + DFF), v1);
        } else {
#pragma unroll
            for (int e = 0; e < 8; ++e) { g2[e] = 0.f; g1[e] = 0.f; v2[e] = 0.f; v1[e] = 0.f; }
        }
#pragma unroll
        for (int rr = 0; rr < 2; ++rr) {
            float g0[8], v0[8], y[8];
            const bf16_t* cr = SB + ((size_t)kb * 4 + rr) * (2 * DFF) + c0;
            unpack8(*(const u32x4*)cr, g0); unpack8(*(const u32x4*)(cr + DFF), v0);
#pragma unroll
            for (int e = 0; e < 8; ++e) {
                const float ug = bg[e] + wg[0][e] * g2[e] + wg[1][e] * g1[e] + wg[2][e] * g0[e];
                const float uv = bv[e] + wv[0][e] * v2[e] + wv[1][e] * v1[e] + wv[2][e] * v0[e];
                y[e] = ug * fsig(ug) * uv; g2[e] = g1[e]; g1[e] = g0[e]; v2[e] = v1[e]; v1[e] = v0[e];
            }
            *(u32x4*)(ACT + (size_t)(r0 + rr) * DFF + c0) = pack8(y);
        }
    }
}

#ifndef REP1
#define REP1 1
#endif
#ifndef REP3
#define REP3 1
#endif
__global__ void __launch_bounds__(512, 2) mega(Params p) {
    extern __shared__ __attribute__((aligned(16))) unsigned char shm[];
    cg::grid_group grid = cg::this_grid();
    bf16_t* H = (bf16_t*)((unsigned char*)p.out + DO_H); bf16_t* WinT = (bf16_t*)((unsigned char*)p.out + DO_WIN);
    bf16_t* H2 = (bf16_t*)(p.ws + WS_H2); bf16_t* ACTb = (bf16_t*)(p.ws + WS_ACT);
    const bf16_t* WoT = (const bf16_t*)(p.ws + WS_WOUT); const bf16_t* WuT = (const bf16_t*)(p.ws + WS_WUP); const bf16_t* WdT = (const bf16_t*)(p.ws + WS_WDN);
#define PH(i) (p.ph_lo <= (i) && (i) < p.ph_hi)
#define SYNC(i) do { if (p.ph_lo <= (i) && (i) + 1 < p.ph_hi) grid.sync(); } while (0)
    if (PH(0)) phase0(p, shm);
    SYNC(0);
    for (int rep = 0; rep < REP1; ++rep) { if (rep) grid.sync();
    if (PH(1)) { Epi1 E{(bf16_t*)(p.ws + WS_AQK), (bf16_t*)(p.ws + WS_VTM), (bf16_t*)(p.ws + WS_GA), (bf16_t*)(p.ws + WS_BQ), (bf16_t*)(p.ws + WS_BK), (bf16_t*)(p.ws + WS_VTD), (bf16_t*)(p.ws + WS_GB)};
        run_gemm(shm, H, WinT, T, 16384, D, E); } }
    SYNC(1);
    if (PH(2)) phase2a(p, shm);
    SYNC(2);
    for (int rep = 0; rep < REP3; ++rep) { if (rep) grid.sync(); if (PH(3)) phase2b(p, shm, rep); }
    SYNC(3);
    if (PH(4)) phase3(p, shm);
    SYNC(4);
    if (PH(5)) { EpiRes E{p.out, p.x, D}; run_gemm(shm, (const bf16_t*)(p.ws + WS_BQ), WoT, T, D, D, E); }
    SYNC(5);
    if (PH(6)) phase5(p);
    SYNC(6);
    if (PH(7)) { EpiUp E{ACTb, (bf16_t*)(p.ws + WS_SB), p.ffn_conv_w, p.ffn_conv_b}; run_gemm(shm, H2, WuT, T, 2 * DFF, D, E); }
    SYNC(7);
    if (PH(8)) phase_fix(p);
    SYNC(8);
    if (PH(9)) { EpiRes E{p.out, p.out, D}; run_gemm(shm, ACTb, WdT, T, D, DFF, E); }
#undef PH
#undef SYNC
}

#ifndef N_LAUNCHES
#define N_LAUNCHES 1
#endif
extern "C" void kernel_launch(void* const* d_in, const int* in_sizes, int n_in, void* d_out, int out_size, void* d_ws, size_t ws_size, hipStream_t stream) {
    static int grid = 0;
    if (grid == 0) {
        if (n_in != 17 || out_size != T * D || ws_size < WS_END) { fprintf(stderr, "kernel_launch: unexpected problem (n_in %d, out %d, ws %zu)\n", n_in, out_size, ws_size); grid = -1; return; }
        int dev = 0, cus = 0, per_cu = 0;
        if (hipGetDevice(&dev) != hipSuccess || hipDeviceGetAttribute(&cus, hipDeviceAttributeMultiprocessorCount, dev) != hipSuccess) { grid = -1; return; }
        if (hipFuncSetAttribute((const void*)mega, hipFuncAttributeMaxDynamicSharedMemorySize, LDS_BYTES) != hipSuccess) { fprintf(stderr, "kernel_launch: hipFuncSetAttribute failed\n"); grid = -1; return; }
        if (hipOccupancyMaxActiveBlocksPerMultiprocessor(&per_cu, (const void*)mega, 512, LDS_BYTES) != hipSuccess || per_cu < 1) { fprintf(stderr, "kernel_launch: occupancy query says %d\n", per_cu); per_cu = 1; }
        (void)hipGetLastError();
        grid = cus * per_cu;
    }
    if (grid < 0) return;
    if (hipMemsetAsync((char*)d_ws + WS_CTL, 0, 4096, stream) != hipSuccess) { fprintf(stderr, "kernel_launch: memset failed\n"); return; }
    Params p{};
    const float** pp = (const float**)&p;
    for (int i = 0; i < 17; ++i) pp[i] = (const float*)d_in[i];
    p.out = (float*)d_out; p.ws = (unsigned char*)d_ws;
    constexpr int NPH = 10;
    for (int li = 0; li < N_LAUNCHES; ++li) {
        p.ph_lo = (N_LAUNCHES == 1) ? 0 : li; p.ph_hi = (N_LAUNCHES == 1) ? NPH : li + 1;
        void* args[] = {&p};
        hipError_t e = hipLaunchCooperativeKernel((const void*)mega, dim3(grid), dim3(512), args, LDS_BYTES, stream);
        if (e != hipSuccess) { fprintf(stderr, "cooperative launch failed: %s (grid %d)\n", hipGetErrorString(e), grid); break; }
    }
}
```

```cpp
#include <hip/hip_runtime.h>
#include <hip/hip_cooperative_groups.h>
#include <cstdio>
#include <cstdint>
namespace cg = cooperative_groups;
namespace pg8 {
#define PG8_LAS __attribute__((address_space(3)))
typedef unsigned short bf16_t;
typedef short bf16x8 __attribute__((ext_vector_type(8)));
typedef float f32x4 __attribute__((ext_vector_type(4)));
typedef unsigned u32x4 __attribute__((ext_vector_type(4)));
constexpr int BM = 256, BK = 64, HALF = 128, HTB = HALF * BK * 2  , STAGE_BYTES = 8 * HTB, NXCD = 8, WGM = 8;

__host__ __device__ __forceinline__ int lds_byte(int r, int c) { const int st = (r >> 4) * 2 + (c >> 5), rr = r & 15, cc = c & 31, ob = rr * 64 + cc * 2; return st * 1024 + (ob ^ (((ob >> 9) & 1) << 5)); }
__host__ __device__ __forceinline__ void stage_rc(int b, int& R, int& C) { const int st = b / 1024, sb = b % 1024, swz = sb ^ (((sb >> 9) & 1) << 5); R = (st >> 1) * 16 + swz / 64; C = (st & 1) * 32 + (swz % 64) / 2; }
__host__ __device__ __forceinline__ int perm32(int rho) { const int n = rho >> 4, i = rho & 15; return 8 * (i >> 2) + 4 * n + (i & 3); }

struct Unit { int pm, pn; };
struct Gemm { const bf16_t* A; const bf16_t* Bt; int M, N, K; };

struct StaticOrder {
    int nM, nN, nwg, G, c;
    __host__ __device__ void init(int M, int N, int G_, int c_) { nM = M / BM; nN = N / BM; nwg = nM * nN; G = G_; c = c_; }
    __host__ __device__ bool next(int i, Unit& u) const {
        const long L = (long)i * G + c; if (L >= nwg) return false;
        int wgid = (int)L; { const int q = nwg / NXCD, r = nwg % NXCD, xcd = wgid % NXCD, off = wgid / NXCD; wgid = (xcd < r ? xcd * (q + 1) : r * (q + 1) + (xcd - r) * q) + off; }
        const int nig = WGM * nN, gid = wgid / nig, fm = gid * WGM, gsz = (nM - fm) < WGM ? (nM - fm) : WGM;
        u.pm = fm + ((wgid % nig) % gsz); u.pn = (wgid % nig) / gsz; return true;
    }
    __device__ __forceinline__ void a_ready(const Unit&) const {}
    __device__ __forceinline__ void done(const Unit&) const {}
};
__device__ __forceinline__ unsigned cvt_pk_bf16(float lo, float hi) { unsigned r; asm volatile("v_cvt_pk_bf16_f32 %0, %1, %2" : "=v"(r) : "v"(lo), "v"(hi)); return r; }
template <class Epi, class Sched, bool STAMP = false>
__device__ __forceinline__ void gemm_phase(PG8_LAS unsigned char* lds, const Gemm g, const Sched& S, const Epi& E, unsigned long long* stamps) {
    int tid_ = threadIdx.x; asm volatile("" : "+v"(tid_)); const int tid = tid_, wid = __builtin_amdgcn_readfirstlane(tid >> 6), lane = tid & 63, wr = wid >> 2, wc = wid & 3, fr = lane & 15, fq = lane >> 4;
    const int K = g.K, nt = K / BK;
    int ts_lo = 0, ts_hi = 0, nts = 0; const unsigned long long rt_entry = STAMP ? (unsigned long long)wall_clock64() : 0ull;
#define PG8_STAMP() do { if (STAMP && wid == 0 && nts < 64) { const unsigned long long _c = (unsigned long long)clock64(); \
        ts_lo = (lane == nts) ? (int)(unsigned)_c : ts_lo; ts_hi = (lane == nts) ? (int)(unsigned)(_c >> 32) : ts_hi; ++nts; } } while (0)
    PG8_STAMP();
    unsigned voffA[2], voffB[2];
#pragma unroll
    for (int i = 0; i < 2; ++i) { int R, C; stage_rc(tid * 16 + i * 8192, R, C); const int Rb = Epi::PERM ? ((R & ~31) + perm32(R & 31)) : R;
        voffA[i] = (unsigned)(R * K + C) * 2u; voffB[i] = (unsigned)(Rb * K + C) * 2u; }
    const size_t kstep = (size_t)(BK * 2);
    const size_t hstep = (size_t)HALF * K * 2;
    const size_t tstep = 2 * hstep;
    const unsigned ldsw = (unsigned)wid * 1024u;
    const int aoff = lds_byte(wr * 64 + fr, fq * 8), boff = lds_byte(wc * 32 + fr, fq * 8);
#define PG8_SA(b, h) (((b) * 2 + (h)) * HTB)
#define PG8_SB(b, h) ((4 + (b) * 2 + (h)) * HTB)
#define PG8_STAGE(bufoff, gbase, voff) do { _Pragma("unroll") for (int _i = 0; _i < 2; ++_i) \
        __builtin_amdgcn_global_load_lds((const unsigned*)((const char*)(gbase) + (voff)[_i]), (PG8_LAS unsigned*)(lds + (bufoff) + ldsw + _i * 8192), 16, 0, 0); } while (0)
#define PG8_LDA(dst, b, h) do { _Pragma("unroll") for (int m = 0; m < 4; ++m) _Pragma("unroll") for (int k = 0; k < 2; ++k) dst[m][k] = *(const PG8_LAS bf16x8*)(lds + PG8_SA(b, h) + aoff + m * 2048 + k * 1024); } while (0)
#define PG8_LDB(dst, b, h) do { _Pragma("unroll") for (int n = 0; n < 2; ++n) _Pragma("unroll") for (int k = 0; k < 2; ++k) dst[n][k] = *(const PG8_LAS bf16x8*)(lds + PG8_SB(b, h) + boff + n * 2048 + k * 1024); } while (0)
#define PG8_MMA(ai, bj, At, Bt) do { __builtin_amdgcn_s_setprio(1); _Pragma("unroll") for (int m = 0; m < 4; ++m) _Pragma("unroll") for (int n = 0; n < 2; ++n) _Pragma("unroll") for (int k = 0; k < 2; ++k) \
        acc[ai][bj][m][n] = __builtin_amdgcn_mfma_f32_16x16x32_bf16(Bt[n][k], At[m][k], acc[ai][bj][m][n], 0, 0, 0); __builtin_amdgcn_s_setprio(0); } while (0)
#define PG8_WAIT_V(n) asm volatile("s_waitcnt vmcnt(" #n ")" ::: "memory")
#define PG8_WAIT_L(n) asm volatile("s_waitcnt lgkmcnt(" #n ")" ::: "memory")
#define PG8_BAR __builtin_amdgcn_s_barrier()
#define PG8_SCHED __builtin_amdgcn_sched_barrier(0)
    Unit cur, nxt; int ui = 0;
    if (!S.next(0, cur)) return;
    f32x4 acc[2][2][4][2];
#pragma unroll
    for (int a = 0; a < 2; ++a)
#pragma unroll
        for (int b = 0; b < 2; ++b)
#pragma unroll
            for (int m = 0; m < 4; ++m)
#pragma unroll
                for (int n = 0; n < 2; ++n) acc[a][b][m][n] = (f32x4){0.f, 0.f, 0.f, 0.f};
    bf16x8 At[4][2], B0[2][2], B1[2][2];
    const char* cA = (const char*)g.A + (size_t)cur.pm * tstep; const char* cB = (const char*)g.Bt + (size_t)cur.pn * tstep;
    S.a_ready(cur);
    PG8_STAGE(PG8_SB(0, 0), cB, voffB); PG8_STAGE(PG8_SA(0, 0), cA, voffA); PG8_STAGE(PG8_SB(0, 1), cB + hstep, voffB); PG8_STAGE(PG8_SA(0, 1), cA + hstep, voffA);
    if (wr == 1) PG8_BAR;
    PG8_WAIT_V(4); PG8_BAR;
    PG8_STAGE(PG8_SB(1, 0), cB + kstep, voffB); PG8_STAGE(PG8_SA(1, 0), cA + kstep, voffA); PG8_STAGE(PG8_SB(1, 1), cB + hstep + kstep, voffB);
    PG8_WAIT_V(6); PG8_BAR;
    PG8_STAMP();
    for (;;) {
        const bool has_next = S.next(ui + 1, nxt);
        const char* nA = has_next ? (const char*)g.A + (size_t)nxt.pm * tstep : cA; const char* nB = has_next ? (const char*)g.Bt + (size_t)nxt.pn * tstep : cB;
        for (int t = 0; t < nt; t += 2) {
            const bool last = (t == nt - 2);
            const char* a1 = cA + (size_t)(t + 1) * kstep;
            const char* a2 = last ? nA : cA + (size_t)(t + 2) * kstep; const char* b2 = last ? nB : cB + (size_t)(t + 2) * kstep;
            const char* a3 = a2 + kstep; const char* b3 = b2 + kstep;
            if (last && has_next) S.a_ready(nxt);
            PG8_LDB(B0, 0, 0); PG8_SCHED; PG8_LDA(At, 0, 0); PG8_STAGE(PG8_SA(1, 1), a1 + hstep, voffA);
            PG8_WAIT_L(8); PG8_BAR; PG8_WAIT_L(0); PG8_MMA(0, 0, At, B0); PG8_BAR; PG8_SCHED;
            PG8_LDB(B1, 0, 1); PG8_STAGE(PG8_SB(0, 0), b2, voffB);
            PG8_BAR; PG8_WAIT_L(0); PG8_MMA(0, 1, At, B1); PG8_BAR;
            PG8_LDA(At, 0, 1); PG8_STAGE(PG8_SA(0, 0), a2, voffA);
            PG8_BAR; PG8_WAIT_L(0); PG8_MMA(1, 0, At, B0); PG8_BAR; PG8_SCHED;
            PG8_STAGE(PG8_SB(0, 1), b2 + hstep, voffB);
            PG8_WAIT_V(6); PG8_BAR; PG8_MMA(1, 1, At, B1); PG8_BAR;
            PG8_LDB(B0, 1, 0); PG8_SCHED; PG8_LDA(At, 1, 0); PG8_STAGE(PG8_SA(0, 1), a2 + hstep, voffA);
            PG8_WAIT_L(8); PG8_BAR; PG8_WAIT_L(0); PG8_MMA(0, 0, At, B0); PG8_BAR; PG8_SCHED;
            PG8_LDB(B1, 1, 1); PG8_STAGE(PG8_SB(1, 0), b3, voffB);
            PG8_BAR; PG8_WAIT_L(0); PG8_MMA(0, 1, At, B1); PG8_BAR;
            PG8_LDA(At, 1, 1); PG8_STAGE(PG8_SA(1, 0), a3, voffA);
            PG8_BAR; PG8_WAIT_L(0); PG8_MMA(1, 0, At, B0); PG8_BAR; PG8_SCHED;
            PG8_STAGE(PG8_SB(1, 1), b3 + hstep, voffB);
            PG8_WAIT_V(6); PG8_BAR; PG8_MMA(1, 1, At, B1); PG8_BAR;
        }
        PG8_STAMP();
        if constexpr (!Epi::AFTER_DRAIN) { E(acc, cur, wr, wc, fr, fq); S.done(cur); }
        PG8_STAMP();
        if (!has_next) break;
#pragma unroll
        for (int a = 0; a < 2; ++a)
#pragma unroll
            for (int b = 0; b < 2; ++b)
#pragma unroll
                for (int m = 0; m < 4; ++m)
#pragma unroll
                    for (int n = 0; n < 2; ++n) acc[a][b][m][n] = (f32x4){0.f, 0.f, 0.f, 0.f};
        cur = nxt; cA = nA; cB = nB; ++ui;
    }
    PG8_WAIT_V(0);
    if (wr == 0) PG8_BAR;
    PG8_BAR;
    if constexpr (Epi::AFTER_DRAIN) { E.fused(acc, cur, wr, wc, fr, fq, lds, wid, lane); S.done(cur); }
    PG8_STAMP();
    if (STAMP && wid == 0) { stamps[lane] = lane < nts ? (((unsigned long long)(unsigned)ts_hi << 32) | (unsigned)ts_lo) : 0ull;
        if (lane == 62) stamps[62] = rt_entry; if (lane == 63) stamps[63] = (unsigned long long)wall_clock64(); }
#undef PG8_STAMP
#undef PG8_SA
#undef PG8_SB
#undef PG8_STAGE
#undef PG8_LDA
#undef PG8_LDB
#undef PG8_MMA
#undef PG8_WAIT_V
#undef PG8_WAIT_L
#undef PG8_BAR
#undef PG8_SCHED
}
}
using pg8::bf16_t; using pg8::bf16x8; using pg8::f32x4; using pg8::u32x4; using pg8::cvt_pk_bf16;
typedef unsigned u32x2 __attribute__((ext_vector_type(2)));
typedef float f32x16 __attribute__((ext_vector_type(16)));

constexpr int T = 32768, D = 2048, SEQ = 8192, PIN = 16392, DFF = 5632, TH = 16384;
constexpr float EPS = 1e-6f, LOG2E = 1.4426950408889634f;
constexpr size_t MiB = (size_t)1 << 20;
constexpr size_t WS_CTL = 0, WS_GIF = 1 * MiB, WS_KT = 2 * MiB, WS_AQK = 66 * MiB, WS_VTM = 194 * MiB, WS_GA = 322 * MiB, WS_BQ = 450 * MiB, WS_BK = 578 * MiB,
                 WS_VTD = 706 * MiB, WS_GB = 834 * MiB, WS_END = 962 * MiB;
constexpr size_t WS_HM = WS_AQK, WS_H2 = WS_AQK, WS_WOUT = WS_VTM, WS_WUP = WS_VTM + 8 * MiB, WS_WDN = WS_VTM + 52 * MiB, WS_ACT = WS_GA, WS_SB = 674 * MiB;
constexpr size_t DO_H = 0, DO_Q2 = 0, DO_K2 = 64 * MiB, DO_WIN = 128 * MiB, DO_YB = 128 * MiB;
constexpr int LDS_BYTES = 147456;

struct Params {
    const float *x, *norm1_g, *w_in, *if_bias, *qk_conv_w, *qk_conv_b, *mlstm_norm_g, *q_norm_g, *k_norm_g, *diff_lambda, *subln_g, *w_out, *norm2_g, *w_up, *ffn_conv_w, *ffn_conv_b, *w_down;
    float* out; unsigned char* ws; int ph_lo, ph_hi;
};

__device__ __forceinline__ void lds_wait() { asm volatile("s_waitcnt lgkmcnt(0)" ::: "memory"); }
__device__ __forceinline__ float bflo(unsigned u) { return __uint_as_float(u << 16); }
__device__ __forceinline__ float bfhi(unsigned u) { return __uint_as_float(u & 0xffff0000u); }
__device__ __forceinline__ float fsig(float v) { return __builtin_amdgcn_rcpf(1.f + __expf(-v)); }
__device__ __forceinline__ float wave_sum(float v) {
#pragma unroll
    for (int o = 1; o < 64; o <<= 1) v += __shfl_xor(v, o);
    return v;
}
__device__ __forceinline__ void unpack8(u32x4 u, float (&f)[8]) {
    f[0] = bflo(u.x); f[1] = bfhi(u.x); f[2] = bflo(u.y); f[3] = bfhi(u.y); f[4] = bflo(u.z); f[5] = bfhi(u.z); f[6] = bflo(u.w); f[7] = bfhi(u.w);
}
__device__ __forceinline__ u32x4 pack8(const float (&f)[8]) {
    u32x4 o; o.x = cvt_pk_bf16(f[0], f[1]); o.y = cvt_pk_bf16(f[2], f[3]); o.z = cvt_pk_bf16(f[4], f[5]); o.w = cvt_pk_bf16(f[6], f[7]); return o;
}

__device__ __forceinline__ void transpose_item(const float* __restrict__ W, size_t ldw, int K, bf16_t* WT, int k0, int srcn0, int dstn0, float* scr, int lane) {
#pragma unroll 8
    for (int i = 0; i < 32; ++i) { const int kk = 2 * i + (lane >> 5); scr[kk * 33 + (lane & 31)] = W[(size_t)(k0 + kk) * ldw + srcn0 + (lane & 31)]; }
    lds_wait();
    const int c = lane & 7;
#pragma unroll
    for (int j = 0; j < 4; ++j) { const int n = (lane >> 3) + 8 * j; const float* s = scr + (8 * c) * 33 + n;
        u32x4 o; o.x = cvt_pk_bf16(s[0], s[33]); o.y = cvt_pk_bf16(s[66], s[99]); o.z = cvt_pk_bf16(s[132], s[165]); o.w = cvt_pk_bf16(s[198], s[231]);
        *(u32x4*)(WT + (size_t)(dstn0 + n) * K + k0 + 8 * c) = o; }
    lds_wait();
}
__device__ __forceinline__ int win_src(int n) {
    if (n < 4096) return n;
    if (n < 8192) { const int p = (n - 4096) >> 8, j = (n - 4096) & 255; return j < 128 ? 4096 + 128 * p + j : 12296 + 128 * p + (j - 128); }
    if (n < 10240) return 6152 + (n - 8192);
    if (n < 12288) return 8200 + (n - 10240);
    if (n < 14336) return 10248 + (n - 12288);
    return 14344 + (n - 14336);
}
__device__ __forceinline__ void transpose_plain(const float* W, int K, int N, bf16_t* WT, float* scr, int gw, int ngw, int lane) {
    const int nblk = N / 32, nitems = (K / 64) * nblk;
    for (int it = gw; it < nitems; it += ngw) { const int kb = it / nblk, nb = it % nblk; transpose_item(W, (size_t)N, K, WT, 64 * kb, 32 * nb, 32 * nb, scr, lane); }
}

__device__ __forceinline__ void phase0(const Params& p, unsigned char* shm) {
    int tid_ = threadIdx.x; asm volatile("" : "+v"(tid_)); const int tid = tid_, lane = tid & 63, wave = tid >> 6, gw = blockIdx.x * 8 + wave, ngw = gridDim.x * 8;
    float* scr = (float*)(shm + wave * 8448);
    bf16_t* WinT = (bf16_t*)((unsigned char*)p.out + DO_WIN);
    { const int nblk = 16384 / 32, nitems = (D / 64) * nblk;
      for (int it = gw; it < nitems; it += ngw) { const int kb = it / nblk, nb = it % nblk; transpose_item(p.w_in, (size_t)PIN, D, WinT, 64 * kb, win_src(32 * nb), 32 * nb, scr, lane); } }
    float* wifT = (float*)(shm + 69632);
    for (int idx = tid; idx < 8 * D; idx += 512) { const int k = idx >> 3, j = idx & 7; wifT[j * D + k] = p.w_in[(size_t)k * PIN + 6144 + j]; }
    __syncthreads();
    bf16_t* H = (bf16_t*)((unsigned char*)p.out + DO_H);
    float* GIF = (float*)(p.ws + WS_GIF);
    f32x4 g1r[8];
#pragma unroll
    for (int j = 0; j < 8; ++j) g1r[j] = *((const f32x4*)p.norm1_g + lane + 64 * j);
    for (int row = gw; row < T; row += ngw) {
        const f32x4* xr = (const f32x4*)(p.x + (size_t)row * D) + lane;
        f32x4 v[8]; float ss = 0.f;
#pragma unroll
        for (int j = 0; j < 8; ++j) { v[j] = xr[64 * j]; ss += (v[j].x * v[j].x + v[j].y * v[j].y) + (v[j].z * v[j].z + v[j].w * v[j].w); }
        const float rinv = rsqrtf(wave_sum(ss) * (1.f / D) + EPS);
        float ga[8];
#pragma unroll
        for (int j = 0; j < 8; ++j) ga[j] = 0.f;
        u32x2* o8 = (u32x2*)(H + (size_t)row * D) + lane;
#pragma unroll
        for (int j = 0; j < 8; ++j) {
            const f32x4 g = g1r[j];
            f32x4 h; h.x = v[j].x * rinv * g.x; h.y = v[j].y * rinv * g.y; h.z = v[j].z * rinv * g.z; h.w = v[j].w * rinv * g.w;
            u32x2 o; o.x = cvt_pk_bf16(h.x, h.y); o.y = cvt_pk_bf16(h.z, h.w); o8[64 * j] = o;
#pragma unroll
            for (int q = 0; q < 8; ++q) { const f32x4 w = *((const f32x4*)(wifT + q * D) + lane + 64 * j); ga[q] += (h.x * w.x + h.y * w.y) + (h.z * w.z + h.w * w.w); }
        }
#pragma unroll
        for (int q = 0; q < 8; ++q) ga[q] = wave_sum(ga[q]);
        if (lane < 8) {
            float val = 0.f;
#pragma unroll
            for (int q = 0; q < 8; ++q) val = (lane == q) ? ga[q] : val;
            val += p.if_bias[lane];
            if (lane >= 4) val = fminf(val, 0.f) - log1pf(expf(-fabsf(val)));
            GIF[(size_t)row * 8 + lane] = val;
        }
    }
}

struct Epi1 {
    static constexpr bool PERM = true, AFTER_DRAIN = false;
    bf16_t *aqk, *vtm, *ga, *bq, *bk, *vtd, *gb;
    __device__ __forceinline__ void operator()(const f32x4 (&acc)[2][2][4][2], const pg8::Unit& u, int wr, int wc, int fr, int fq) const {
        const int pn = u.pn, row0 = u.pm * 256 + wr * 64 + fr, cw = wc * 32 + 8 * fq;
        if (pn >= 16 && pn < 32) {
            const int cb = 128 * (pn - 16) + cw;
#pragma unroll
            for (int ai = 0; ai < 2; ++ai)
#pragma unroll
                for (int m = 0; m < 4; ++m) {
                    const size_t row = (size_t)(row0 + ai * 128 + m * 16);
                    float f[8];
#pragma unroll
                    for (int j = 0; j < 4; ++j) { f[j] = fsig(acc[ai][0][m][0][j]) * fsig(acc[ai][1][m][0][j]); f[4 + j] = fsig(acc[ai][0][m][1][j]) * fsig(acc[ai][1][m][1][j]); }
                    *(u32x4*)(ga + row * D + cb) = pack8(f);
                }
            return;
        }
        bf16_t* dst; int col0; int mode;
        if (pn < 8) { dst = aqk; col0 = 256 * pn; mode = 0; }
        else if (pn < 16) { dst = vtm; col0 = 256 * (pn - 8); mode = 1; }
        else if (pn < 40) { dst = bq; col0 = 256 * (pn - 32); mode = 0; }
        else if (pn < 48) { dst = bk; col0 = 256 * (pn - 40); mode = 0; }
        else if (pn < 56) { dst = vtd; col0 = 256 * (pn - 48); mode = 3; }
        else { dst = gb; col0 = 256 * (pn - 56); mode = 2; }
#pragma unroll
        for (int ai = 0; ai < 2; ++ai)
#pragma unroll
            for (int m = 0; m < 4; ++m) {
                const int row = row0 + ai * 128 + m * 16;
#pragma unroll
                for (int bj = 0; bj < 2; ++bj) {
                    const int col = col0 + bj * 128 + cw;
                    float f[8];
#pragma unroll
                    for (int j = 0; j < 4; ++j) { f[j] = acc[ai][bj][m][0][j]; f[4 + j] = acc[ai][bj][m][1][j]; }
                    if (mode == 2) {
#pragma unroll
                        for (int j = 0; j < 8; ++j) f[j] = fsig(f[j]);
                    }
                    const u32x4 w = pack8(f);
                    if (mode == 3) {
                        bf16_t* d = dst + (((size_t)((row >> 13) * 8 + (col >> 8)) * 256 + ((row & (SEQ - 1)) >> 5)) * 256 + (col & 255)) * 32 + (row & 31);
                        d[0] = (bf16_t)(w.x & 0xffff); d[32] = (bf16_t)(w.x >> 16); d[64] = (bf16_t)(w.y & 0xffff); d[96] = (bf16_t)(w.y >> 16);
                        d[128] = (bf16_t)(w.z & 0xffff); d[160] = (bf16_t)(w.z >> 16); d[192] = (bf16_t)(w.w & 0xffff); d[224] = (bf16_t)(w.w >> 16);
                    } else if (mode == 1) {
                        bf16_t* d = dst + ((size_t)((row >> 13) * D + col)) * SEQ + (row & (SEQ - 1));
                        d[0 * (size_t)SEQ] = (bf16_t)(w.x & 0xffff); d[1 * (size_t)SEQ] = (bf16_t)(w.x >> 16); d[2 * (size_t)SEQ] = (bf16_t)(w.y & 0xffff); d[3 * (size_t)SEQ] = (bf16_t)(w.y >> 16);
                        d[4 * (size_t)SEQ] = (bf16_t)(w.z & 0xffff); d[5 * (size_t)SEQ] = (bf16_t)(w.z >> 16); d[6 * (size_t)SEQ] = (bf16_t)(w.w & 0xffff); d[7 * (size_t)SEQ] = (bf16_t)(w.w >> 16);
                    } else {
                        *(u32x4*)(dst + (size_t)row * D + col) = w;
                    }
                }
            }
    }
};
struct EpiRes {
    static constexpr bool PERM = false, AFTER_DRAIN = false;
    float* C; const float* R; int ldc;
    __device__ __forceinline__ void operator()(const f32x4 (&acc)[2][2][4][2], const pg8::Unit& u, int wr, int wc, int fr, int fq) const {
        const int row0 = u.pm * 256 + wr * 64 + fr, col0 = u.pn * 256 + wc * 32 + 4 * fq;
#pragma unroll
        for (int ai = 0; ai < 2; ++ai)
#pragma unroll
            for (int m = 0; m < 4; ++m) {
                const size_t off = (size_t)(row0 + ai * 128 + m * 16) * ldc + col0;
#pragma unroll
                for (int bj = 0; bj < 2; ++bj)
#pragma unroll
                    for (int n = 0; n < 2; ++n) { const f32x4 r = *(const f32x4*)(R + off + bj * 128 + n * 16); *(f32x4*)(C + off + bj * 128 + n * 16) = acc[ai][bj][m][n] + r; }
            }
    }
};
struct EpiB {
    static constexpr bool PERM = true, AFTER_DRAIN = false;
    bf16_t* O; int ldc;
    __device__ __forceinline__ void operator()(const f32x4 (&acc)[2][2][4][2], const pg8::Unit& u, int wr, int wc, int fr, int fq) const {
        const int row0 = u.pm * 256 + wr * 64 + fr, col0 = u.pn * 256 + wc * 32 + 8 * fq;
#pragma unroll
        for (int ai = 0; ai < 2; ++ai)
#pragma unroll
            for (int m = 0; m < 4; ++m) {
                bf16_t* rowp = O + (size_t)(row0 + ai * 128 + m * 16) * ldc + col0;
#pragma unroll
                for (int bj = 0; bj < 2; ++bj) {
                    u32x4 w; w.x = cvt_pk_bf16(acc[ai][bj][m][0][0], acc[ai][bj][m][0][1]); w.y = cvt_pk_bf16(acc[ai][bj][m][0][2], acc[ai][bj][m][0][3]);
                    w.z = cvt_pk_bf16(acc[ai][bj][m][1][0], acc[ai][bj][m][1][1]); w.w = cvt_pk_bf16(acc[ai][bj][m][1][2], acc[ai][bj][m][1][3]);
                    *(u32x4*)(rowp + bj * 128) = w;
                }
            }
    }
};
template <class Epi> __device__ __forceinline__ void run_gemm(unsigned char* shm, const bf16_t* A, const bf16_t* Bt, int M, int N, int K, const Epi& E) {
    pg8::Gemm g{A, Bt, M, N, K};
    pg8::StaticOrder S; S.init(M, N, (int)gridDim.x, (int)blockIdx.x);
    pg8::gemm_phase<Epi, pg8::StaticOrder, false>((PG8_LAS unsigned char*)shm, g, S, E, nullptr);
}

__device__ __forceinline__ void phase2a(const Params& p, unsigned char* shm) {
    int tid_ = threadIdx.x; asm volatile("" : "+v"(tid_)); const int tid = tid_, lane = tid & 63, wave = tid >> 6;
    const bf16_t* AQK = (const bf16_t*)(p.ws + WS_AQK);
    bf16_t* Q2 = (bf16_t*)((unsigned char*)p.out + DO_Q2); bf16_t* K2 = (bf16_t*)((unsigned char*)p.out + DO_K2); bf16_t* KT = (bf16_t*)(p.ws + WS_KT);
    bf16_t* tl = (bf16_t*)shm;
    const int nwc = gridDim.x >> 5, cgp = blockIdx.x & 31, oct = tid & 7, rg = tid >> 3, c0 = 64 * cgp + 8 * oct;
    float w[4][8], bias[8];
#pragma unroll
    for (int j = 0; j < 4; ++j) { const f32x4 a = *(const f32x4*)(p.qk_conv_w + j * D + c0), b = *(const f32x4*)(p.qk_conv_w + j * D + c0 + 4);
        w[j][0] = a.x; w[j][1] = a.y; w[j][2] = a.z; w[j][3] = a.w; w[j][4] = b.x; w[j][5] = b.y; w[j][6] = b.z; w[j][7] = b.w; }
    { const f32x4 a = *(const f32x4*)(p.qk_conv_b + c0), b = *(const f32x4*)(p.qk_conv_b + c0 + 4);
      bias[0] = a.x; bias[1] = a.y; bias[2] = a.z; bias[3] = a.w; bias[4] = b.x; bias[5] = b.y; bias[6] = b.z; bias[7] = b.w; }
    for (int ch = (int)(blockIdx.x >> 5); ch < 256 && (int)(blockIdx.x >> 5) < nwc; ch += nwc) {
        const int t0 = ch * 128;
        float in[5][8];
        const int rl0 = 2 * rg;
#pragma unroll
        for (int k = 0; k < 5; ++k) {
            const int rl = rl0 - 3 + k; const int sp = (t0 & (SEQ - 1)) + rl;
            if (sp >= 0) { const u32x4 u = *(const u32x4*)(AQK + (size_t)(t0 + rl) * D + c0); unpack8(u, in[k]); }
            else {
#pragma unroll
                for (int e = 0; e < 8; ++e) in[k][e] = 0.f; }
        }
        const bool isq = cgp < 16;
#pragma unroll
        for (int rr = 0; rr < 2; ++rr) {
            float y[8];
#pragma unroll
            for (int e = 0; e < 8; ++e) { float a = bias[e]; a += w[0][e] * in[rr][e]; a += w[1][e] * in[rr + 1][e]; a += w[2][e] * in[rr + 2][e]; a += w[3][e] * in[rr + 3][e];
                a = a * fsig(a); y[e] = isq ? a * 0.0625f : a; }
            const u32x4 o = pack8(y);
            const size_t row = (size_t)(t0 + rl0 + rr);
            if (isq) *(u32x4*)(Q2 + row * 1024 + c0) = o;
            else {
                *(u32x4*)(K2 + row * 1024 + (c0 - 1024)) = o;
            }
        }
    }
    {
        bf16_t* BQ = (bf16_t*)(p.ws + WS_BQ); bf16_t* BK = (bf16_t*)(p.ws + WS_BK);
        const int e16 = lane & 15, sub = lane >> 4;
        const float qs = 0.08838834764831845f * LOG2E;
        const f32x4 gq0 = *(const f32x4*)(p.q_norm_g + 8 * e16), gq1 = *(const f32x4*)(p.q_norm_g + 8 * e16 + 4);
        const f32x4 gk0 = *(const f32x4*)(p.k_norm_g + 8 * e16), gk1 = *(const f32x4*)(p.k_norm_g + 8 * e16 + 4);
        const int gwv = blockIdx.x * 8 + wave, ngw = gridDim.x * 8;
        for (int it = gwv; it < T * 16 / 4; it += ngw) {
            const int gid = it * 4 + sub, t = gid >> 4, grp = 16 + (gid & 15);
            const bool isq = false;
            bf16_t* ptr = (isq ? BQ : BK) + (size_t)t * D + 128 * (grp & 15) + 8 * e16;
            float f[8]; unpack8(*(const u32x4*)ptr, f);
            float ss = 0.f;
#pragma unroll
            for (int e = 0; e < 8; ++e) ss += f[e] * f[e];
            ss += __shfl_xor(ss, 1); ss += __shfl_xor(ss, 2); ss += __shfl_xor(ss, 4); ss += __shfl_xor(ss, 8);
            const float rinv = rsqrtf(ss * (1.f / 128.f) + EPS) * (isq ? qs : 1.f);
            const f32x4 g0 = isq ? gq0 : gk0, g1 = isq ? gq1 : gk1;
            f[0] *= rinv * g0.x; f[1] *= rinv * g0.y; f[2] *= rinv * g0.z; f[3] *= rinv * g0.w; f[4] *= rinv * g1.x; f[5] *= rinv * g1.y; f[6] *= rinv * g1.z; f[7] *= rinv * g1.w;
            *(u32x4*)ptr = pack8(f);
        }
    }
}

constexpr int ML_KL = 0, ML_CT = 67584, ML_VT = 101376, ML_A = 118784, ML_MM = 119296, ML_BB = 119808, ML_WS = 120320, ML_N = 120832, ML_MISC = 121856;
typedef short s16x4 __attribute__((ext_vector_type(4)));
#define ML_SB __builtin_amdgcn_sched_barrier(0)
#define ML_MFMA(a_, b_, c_) __builtin_amdgcn_mfma_f32_16x16x32_bf16(a_, b_, c_, 0, 0, 0)
__device__ __forceinline__ void ml_chain2(const unsigned char* baseA, const unsigned char* baseB, const bf16x8 (&qf)[8], f32x4& SA, f32x4& SB) {
    bf16x8 f0 = *(const bf16x8*)(baseA), f1 = *(const bf16x8*)(baseB), f2 = *(const bf16x8*)(baseA + 16), f3 = *(const bf16x8*)(baseB + 16);
    ML_SB;
#pragma unroll
    for (int ks = 0; ks < 8; ks += 2) {
        SA = ML_MFMA(f0, qf[ks], SA); if (ks + 2 < 8) f0 = *(const bf16x8*)(baseA + 16 * (ks + 2)); ML_SB;
        SB = ML_MFMA(f1, qf[ks], SB); if (ks + 2 < 8) f1 = *(const bf16x8*)(baseB + 16 * (ks + 2)); ML_SB;
        SA = ML_MFMA(f2, qf[ks + 1], SA); if (ks + 3 < 8) f2 = *(const bf16x8*)(baseA + 16 * (ks + 3)); ML_SB;
        SB = ML_MFMA(f3, qf[ks + 1], SB); if (ks + 3 < 8) f3 = *(const bf16x8*)(baseB + 16 * (ks + 3)); ML_SB;
    }
}
__device__ __forceinline__ void mlstm_item(const Params& p, unsigned char* shm, int item) {
    int tid_ = threadIdx.x; asm volatile("" : "+v"(tid_)); const int tid = tid_, lane = tid & 63, w = __builtin_amdgcn_readfirstlane(tid >> 6), l15 = lane & 15, qq = lane >> 4;
    const int sl = item & 7, hA = (item >> 3) & 3, b = item >> 5;
    const int wq = w < 4 ? w : 11 - w;
    const bf16_t* Q2 = (const bf16_t*)((const unsigned char*)p.out + DO_Q2); const bf16_t* K2 = (const bf16_t*)((const unsigned char*)p.out + DO_K2);
    const bf16_t* VTM = (const bf16_t*)(p.ws + WS_VTM); const float* GIF = (const float*)(p.ws + WS_GIF);
    bf16_t* HM = (bf16_t*)(p.ws + WS_HM);
    float* sA = (float*)(shm + ML_A); float* sMM = (float*)(shm + ML_MM); float* sBB = (float*)(shm + ML_BB); float* sWS = (float*)(shm + ML_WS); float* sN = (float*)(shm + ML_N); float* sMisc = (float*)(shm + ML_MISC);
    f32x4 Cacc[2][4], Nacc[2];
#pragma unroll
    for (int a = 0; a < 2; ++a) { Nacc[a] = (f32x4){0.f, 0.f, 0.f, 0.f};
#pragma unroll
        for (int c = 0; c < 4; ++c) Cacc[a][c] = (f32x4){0.f, 0.f, 0.f, 0.f}; }
    float m_st = 0.f;
    const bf16_t* vtrow0 = VTM + ((size_t)((b * 4 + hA) * 512 + 64 * sl)) * SEQ;
    const size_t tb = (size_t)b * SEQ;
    u32x4 stK[8], stV[2]; float gli0 = 0.f, gli1 = 0.f, glf0 = 0.f, glf1 = 0.f; bf16x8 qf[8];
    const int krow_s = tid >> 2, kpart = tid & 3, vdv = tid >> 3, vpart = tid & 7;
#define ML_LOAD_STAGE(c_) do { const size_t t0_ = tb + 128 * (c_); \
        { const bf16_t* src = K2 + (t0_ + krow_s) * 1024 + hA * 256 + kpart * 64; _Pragma("unroll") for (int e = 0; e < 8; ++e) stK[e] = *(const u32x4*)(src + 8 * e); } \
        { const bf16_t* src = vtrow0 + (size_t)vdv * SEQ + 128 * (c_) + vpart * 16; stV[0] = *(const u32x4*)src; stV[1] = *(const u32x4*)(src + 8); } \
        if (w == 0) { gli0 = GIF[(t0_ + 2 * lane) * 8 + hA]; gli1 = GIF[(t0_ + 2 * lane + 1) * 8 + hA]; glf0 = GIF[(t0_ + 2 * lane) * 8 + 4 + hA]; glf1 = GIF[(t0_ + 2 * lane + 1) * 8 + 4 + hA]; } } while (0)
#define ML_LOAD_Q(c_) do { const bf16_t* qp = Q2 + (tb + 128 * (c_) + 16 * wq + l15) * 1024 + hA * 256 + 64 * qq; _Pragma("unroll") for (int ks = 0; ks < 8; ++ks) qf[ks] = *(const bf16x8*)(qp + 8 * ks); } while (0)
#define ML_WRITE_STAGE() do { \
        { unsigned char* dst = shm + ML_KL + krow_s * 528 + kpart * 128; _Pragma("unroll") for (int e = 0; e < 8; ++e) *(u32x4*)(dst + 16 * e) = stK[e]; } \
        { unsigned char* dst = shm + ML_VT + vdv * 272 + vpart * 32; *(u32x4*)dst = stV[0]; *(u32x4*)(dst + 16) = stV[1]; } \
        _Pragma("unroll") for (int dkb = 0; dkb < 2; ++dkb) { \
            _Pragma("unroll") for (int dvb = 0; dvb < 4; ++dvb) { u32x2 o; o.x = cvt_pk_bf16(Cacc[dkb][dvb][0], Cacc[dkb][dvb][1]); o.y = cvt_pk_bf16(Cacc[dkb][dvb][2], Cacc[dkb][dvb][3]); \
                *(u32x2*)(shm + ML_CT + (16 * dvb + l15) * 528 + (32 * w + 16 * dkb + 4 * qq) * 2) = o; } \
            if (l15 == 0) *(f32x4*)(sN + 32 * w + 16 * dkb + 4 * qq) = Nacc[dkb]; } \
        if (w == 0) { \
            float cs = glf0 + glf1; \
            _Pragma("unroll") for (int o = 1; o < 64; o <<= 1) { const float v = __shfl_up(cs, o); if (lane >= o) cs += v; } \
            const float b1 = cs, b0 = cs - glf1; const float a0 = gli0 - b0, a1 = gli1 - b1; \
            float pmx = fmaxf(a0, a1); \
            _Pragma("unroll") for (int o = 1; o < 64; o <<= 1) { const float v = __shfl_up(pmx, o); if (lane >= o) pmx = fmaxf(pmx, v); } \
            float ex = __shfl_up(pmx, 1); if (lane == 0) ex = -3.0e38f; \
            const float pm0 = fmaxf(ex, a0), pm1 = pmx; const float mm0 = fmaxf(pm0, m_st), mm1 = fmaxf(pm1, m_st); \
            const float mml = __shfl(mm1, 63), bl = __shfl(b1, 63); \
            sA[2 * lane] = a0; sA[2 * lane + 1] = a1; sMM[2 * lane] = mm0; sMM[2 * lane + 1] = mm1; sBB[2 * lane] = b0; sBB[2 * lane + 1] = b1; \
            sWS[2 * lane] = __expf(a0 - mml); sWS[2 * lane + 1] = __expf(a1 - mml); \
            if (lane == 0) { sMisc[0] = bl; sMisc[1] = mml; } } } while (0)
    ML_LOAD_STAGE(0); ML_LOAD_Q(0);
    ML_WRITE_STAGE();
    for (int c = 0; c < 64; ++c) {
        __syncthreads();
        if (c + 1 < 64) ML_LOAD_STAGE(c + 1);
        const size_t t0 = tb + 128 * c;
        const int tl = 16 * wq + l15;
        const float mm_t = sMM[tl], b_t = sBB[tl], gi = __expf(m_st - mm_t);
        bf16x8 pf[4]; float den = 0.f;
#pragma unroll
        for (int a = 0; a < 4; ++a) {
            pf[a] = (bf16x8){0, 0, 0, 0, 0, 0, 0, 0};
            if (2 * a <= wq) {
                f32x4 S0 = (f32x4){0.f, 0.f, 0.f, 0.f}, S1 = (f32x4){0.f, 0.f, 0.f, 0.f};
                const unsigned char* kp = shm + ML_KL + (32 * a + 8 * (l15 >> 2) + (l15 & 3)) * 528 + 128 * qq;
                ml_chain2(kp, kp + 4 * 528, qf, S0, S1);
                const int key0 = 32 * a + 8 * qq;
                const f32x4 av0 = *(const f32x4*)(sA + key0), av1 = *(const f32x4*)(sA + key0 + 4);
                float pv[8];
#pragma unroll
                for (int i = 0; i < 4; ++i) { pv[i] = (key0 + i <= tl) ? S0[i] * __expf(av0[i] - mm_t) : 0.f; pv[4 + i] = (key0 + 4 + i <= tl) ? S1[i] * __expf(av1[i] - mm_t) : 0.f; den += pv[i] + pv[4 + i]; }
                pf[a] = __builtin_bit_cast(bf16x8, pack8(pv));
            }
        }
        den += __shfl_xor(den, 16); den += __shfl_xor(den, 32);
        f32x4 num[4];
        { const unsigned char* cp = shm + ML_CT + l15 * 528 + 128 * qq;
          f32x4 n0 = (f32x4){0.f, 0.f, 0.f, 0.f}, n1 = n0, n2 = n0, n3 = n0;
          ml_chain2(cp, cp + 16 * 528, qf, n0, n1); ml_chain2(cp + 32 * 528, cp + 48 * 528, qf, n2, n3);
          num[0] = n0 * gi; num[1] = n1 * gi; num[2] = n2 * gi; num[3] = n3 * gi; }
        float qn = 0.f;
#pragma unroll
        for (int ks = 0; ks < 8; ++ks) {
            float qv[8]; unpack8(__builtin_bit_cast(u32x4, qf[ks]), qv);
            const f32x4 n0 = *(const f32x4*)(sN + 64 * qq + 8 * ks), n1 = *(const f32x4*)(sN + 64 * qq + 8 * ks + 4);
            qn += (qv[0] * n0.x + qv[1] * n0.y) + (qv[2] * n0.z + qv[3] * n0.w) + (qv[4] * n1.x + qv[5] * n1.y) + (qv[6] * n1.z + qv[7] * n1.w);
        }
        qn += __shfl_xor(qn, 16); qn += __shfl_xor(qn, 32);
        den += gi * qn;
        ML_SB;
        if (c + 1 < 64) ML_LOAD_Q(c + 1);
        ML_SB;
#pragma unroll
        for (int a = 0; a < 4; ++a) {
            if (2 * a <= wq) {
                const unsigned char* vp = shm + ML_VT + l15 * 272 + (32 * a + 8 * qq) * 2;
                const bf16x8 v0 = *(const bf16x8*)(vp), v1 = *(const bf16x8*)(vp + 16 * 272), v2 = *(const bf16x8*)(vp + 32 * 272), v3 = *(const bf16x8*)(vp + 48 * 272);
                ML_SB;
                num[0] = ML_MFMA(v0, pf[a], num[0]); num[1] = ML_MFMA(v1, pf[a], num[1]); num[2] = ML_MFMA(v2, pf[a], num[2]); num[3] = ML_MFMA(v3, pf[a], num[3]);
            }
        }
        { const float dn = __builtin_amdgcn_rcpf(fmaxf(fabsf(den), __expf(-(b_t + mm_t))));
          bf16_t* hp = HM + (t0 + tl) * D + hA * 512 + 64 * sl + 4 * qq;
#pragma unroll
          for (int dvb = 0; dvb < 4; ++dvb) { u32x2 o; o.x = cvt_pk_bf16(num[dvb][0] * dn, num[dvb][1] * dn); o.y = cvt_pk_bf16(num[dvb][2] * dn, num[dvb][3] * dn); *(u32x2*)(hp + 16 * dvb) = o; } }
        const float b_last = sMisc[0], mm_last = sMisc[1], decay = __expf(m_st - mm_last);
#pragma unroll
        for (int dkb = 0; dkb < 2; ++dkb) { Nacc[dkb] = Nacc[dkb] * decay;
#pragma unroll
            for (int dvb = 0; dvb < 4; ++dvb) Cacc[dkb][dvb] = Cacc[dkb][dvb] * decay; }
#pragma unroll
        for (int a = 0; a < 4; ++a) {
            const f32x4 w0 = *(const f32x4*)(sWS + 32 * a + 8 * qq), w1 = *(const f32x4*)(sWS + 32 * a + 8 * qq + 4);
            const unsigned char* tp = shm + ML_KL + (32 * a + 8 * qq + (l15 >> 2)) * 528 + (32 * w + 4 * (l15 & 3)) * 2;
            const s16x4 t00 = __builtin_amdgcn_ds_read_tr16_b64_v4i16((PG8_LAS s16x4*)(tp)), t01 = __builtin_amdgcn_ds_read_tr16_b64_v4i16((PG8_LAS s16x4*)(tp + 4 * 528));
            const s16x4 t10 = __builtin_amdgcn_ds_read_tr16_b64_v4i16((PG8_LAS s16x4*)(tp + 32)), t11 = __builtin_amdgcn_ds_read_tr16_b64_v4i16((PG8_LAS s16x4*)(tp + 32 + 4 * 528));
            const unsigned char* vp = shm + ML_VT + l15 * 272 + (32 * a + 8 * qq) * 2;
            const u32x4 r0 = *(const u32x4*)(vp), r1 = *(const u32x4*)(vp + 16 * 272), r2 = *(const u32x4*)(vp + 32 * 272), r3 = *(const u32x4*)(vp + 48 * 272);
            ML_SB;
            bf16x8 kt0, kt1;
            kt0[0] = t00[0]; kt0[1] = t00[1]; kt0[2] = t00[2]; kt0[3] = t00[3]; kt0[4] = t01[0]; kt0[5] = t01[1]; kt0[6] = t01[2]; kt0[7] = t01[3];
            kt1[0] = t10[0]; kt1[1] = t10[1]; kt1[2] = t10[2]; kt1[3] = t10[3]; kt1[4] = t11[0]; kt1[5] = t11[1]; kt1[6] = t11[2]; kt1[7] = t11[3];
            float wsv[8] = {w0.x, w0.y, w0.z, w0.w, w1.x, w1.y, w1.z, w1.w};
            float zf[8];
#pragma unroll
            for (int e = 0; e < 8; ++e) zf[e] = (l15 == 0) ? wsv[e] : 0.f;
            const bf16x8 wsf = __builtin_bit_cast(bf16x8, pack8(zf));
            Nacc[0] = ML_MFMA(kt0, wsf, Nacc[0]); Nacc[1] = ML_MFMA(kt1, wsf, Nacc[1]);
            const u32x4 rr[4] = {r0, r1, r2, r3};
#pragma unroll
            for (int dvb = 0; dvb < 4; ++dvb) {
                float vv[8]; unpack8(rr[dvb], vv);
#pragma unroll
                for (int e = 0; e < 8; ++e) vv[e] *= wsv[e];
                const bf16x8 wv = __builtin_bit_cast(bf16x8, pack8(vv));
                Cacc[0][dvb] = ML_MFMA(kt0, wv, Cacc[0][dvb]); Cacc[1][dvb] = ML_MFMA(kt1, wv, Cacc[1][dvb]);
            }
        }
        m_st = b_last + mm_last;
        __syncthreads();
        if (c + 1 < 64) ML_WRITE_STAGE();
    }
#undef ML_LOAD_STAGE
#undef ML_LOAD_Q
#undef ML_WRITE_STAGE
}
#undef ML_SB
#undef ML_MFMA

constexpr int AT_V = 16384, AT_BUF = 32768;
__device__ __forceinline__ void attn_item(const Params& p, unsigned char* shm, int b, int h, int qb, float lam, float M2) {
    int tid_ = threadIdx.x; asm volatile("" : "+v"(tid_)); const int tid = tid_, lane = tid & 63, wave = __builtin_amdgcn_readfirstlane(tid >> 6), c = wave & 1, g = wave >> 1, r = lane & 31, hh = lane >> 5;
    const bf16_t* BQ = (const bf16_t*)(p.ws + WS_BQ); const bf16_t* BK = (const bf16_t*)(p.ws + WS_BK); const bf16_t* VTD = (const bf16_t*)(p.ws + WS_VTD); const bf16_t* GB = (const bf16_t*)(p.ws + WS_GB);
    bf16_t* YB = (bf16_t*)((unsigned char*)p.out + DO_YB);
    float* cmb = (float*)shm;
    const int tq = qb * 128 + 32 * g + r; const size_t rowq = (size_t)b * SEQ + tq;
    bf16x8 qf[8];
    { const bf16_t* qp = BQ + rowq * D + h * 256 + c * 128 + 64 * hh;
#pragma unroll
      for (int ks = 0; ks < 8; ++ks) qf[ks] = *(const bf16x8*)(qp + 8 * ks); }
    {
        float ss = 0.f;
#pragma unroll
        for (int ks = 0; ks < 8; ++ks) { float v[8]; unpack8(__builtin_bit_cast(u32x4, qf[ks]), v);
#pragma unroll
            for (int e = 0; e < 8; ++e) ss += v[e] * v[e]; }
        ss += __shfl_xor(ss, 32);
        const float rq = rsqrtf(ss * (1.f / 128.f) + EPS) * (0.08838834764831845f * LOG2E);
#pragma unroll
        for (int ks = 0; ks < 8; ++ks) { float v[8]; unpack8(__builtin_bit_cast(u32x4, qf[ks]), v);
            const f32x4 g0 = *(const f32x4*)(p.q_norm_g + 64 * hh + 8 * ks), g1 = *(const f32x4*)(p.q_norm_g + 64 * hh + 8 * ks + 4);
            v[0] *= rq * g0.x; v[1] *= rq * g0.y; v[2] *= rq * g0.z; v[3] *= rq * g0.w; v[4] *= rq * g1.x; v[5] *= rq * g1.y; v[6] *= rq * g1.z; v[7] *= rq * g1.w;
            qf[ks] = __builtin_bit_cast(bf16x8, pack8(v)); }
    }
    f32x16 O[8];
#pragma unroll
    for (int db = 0; db < 8; ++db)
#pragma unroll
        for (int i = 0; i < 16; ++i) O[db][i] = 0.f;
    float lsum = 0.f;
    const float slope2 = exp2f(-(float)(h + 1)) * LOG2E;
    const int ntile_w = qb * 4 + g + 1, ntile = qb * 4 + 4;
    int kt0 = (int)ceilf(((float)(qb * 128 - 31) - (150.f + 2.f * M2) / slope2) * (1.f / 32.f)); kt0 = kt0 < 0 ? 0 : kt0;
    const int keyperm = (r & 19) | ((r & 4) << 1) | ((r & 8) >> 1);
    const char* kgb = (const char*)(BK + ((size_t)b * SEQ) * D + h * 256);
    const char* vgb = (const char*)(VTD + ((size_t)(b * 8 + h) * 256) * 8192);
#define AT_ISSUE(kt_, dst_) do { const char* kb_ = kgb + (size_t)(32 * (kt_)) * (D * 2); const char* vb_ = vgb + (size_t)(kt_) * 16384; \
        int ln_ = lane; asm volatile("" : "+v"(ln_)); unsigned kgo[2], vgo[2];   \
        _Pragma("unroll") for (int j = 0; j < 2; ++j) { const int R = 8 * wave + 4 * j + (ln_ >> 4); kgo[j] = (unsigned)((R & 31) * D + (R >> 5) * 128 + 8 * ((ln_ & 15) ^ (R & 15))) * 2u; \
            const int dv = 32 * wave + 16 * j + (ln_ >> 2); vgo[j] = (unsigned)(dv * 32 + 8 * ((ln_ & 3) ^ ((dv >> 2) & 3))) * 2u; } \
        _Pragma("unroll") for (int j = 0; j < 2; ++j) __builtin_amdgcn_global_load_lds((const unsigned*)(kb_ + kgo[j]), (PG8_LAS unsigned*)((dst_) + (2 * wave + j) * 1024), 16, 0, 0); \
        _Pragma("unroll") for (int j = 0; j < 2; ++j) __builtin_amdgcn_global_load_lds((const unsigned*)(vb_ + vgo[j]), (PG8_LAS unsigned*)((dst_) + AT_V + (2 * wave + j) * 1024), 16, 0, 0); } while (0)
    const int krow = (c * 32 + keyperm) * 256, kx = keyperm & 15;
    const int vrow = AT_V + r * 64, vf_ = hh ^ ((r >> 2) & 3);
    __syncthreads();
    const int kt0e = kt0 & ~1, n64 = (ntile - kt0e) >> 1;
    AT_ISSUE(kt0e, shm); AT_ISSUE(kt0e + 1, shm + AT_BUF);
    asm volatile("s_waitcnt vmcnt(0)" ::: "memory");
    __builtin_amdgcn_s_barrier(); asm volatile("" ::: "memory");
    for (int it = 0; it < n64; ++it) {
      unsigned char* slot = shm + (it & 1) * (2 * AT_BUF);
      if (it + 1 < n64) { unsigned char* ns = shm + ((it & 1) ^ 1) * (2 * AT_BUF); AT_ISSUE(kt0e + 2 * it + 2, ns); AT_ISSUE(kt0e + 2 * it + 3, ns + AT_BUF); }
#pragma unroll
      for (int u = 0; u < 2; ++u) {
        const int kt = kt0e + 2 * it + u;
        const int s0 = 32 * kt;
        unsigned char* buf = slot + u * AT_BUF;
        if (kt < ntile_w) {
#define AT_KF(ks_) (*(const bf16x8*)(buf + krow + 16 * ((8 * hh + (ks_)) ^ kx)))
#define AT_VF(i_) (*(const bf16x8*)(buf + vrow + ((i_) & 7) * 2048 + 16 * ((2 * ((i_) >> 3)) ^ vf_)))
#define AT_SB __builtin_amdgcn_sched_barrier(0)
            const float base = slope2 * (float)(s0 + 8 * hh - tq) - M2;
            f32x16 S;
#pragma unroll
            for (int i = 0; i < 16; ++i) S[i] = fmaf(slope2, (float)((i & 3) + 4 * ((i >> 2) & 1) + 16 * (i >> 3)), base);
            bf16x8 f0 = AT_KF(0), f1 = AT_KF(1), f2 = AT_KF(2), f3 = AT_KF(3);
            AT_SB;
            S = __builtin_amdgcn_mfma_f32_32x32x16_bf16(f0, qf[0], S, 0, 0, 0); f0 = AT_KF(4); AT_SB;
            S = __builtin_amdgcn_mfma_f32_32x32x16_bf16(f1, qf[1], S, 0, 0, 0); f1 = AT_KF(5); AT_SB;
            S = __builtin_amdgcn_mfma_f32_32x32x16_bf16(f2, qf[2], S, 0, 0, 0); f2 = AT_KF(6); AT_SB;
            S = __builtin_amdgcn_mfma_f32_32x32x16_bf16(f3, qf[3], S, 0, 0, 0); f3 = AT_KF(7); AT_SB;
            S = __builtin_amdgcn_mfma_f32_32x32x16_bf16(f0, qf[4], S, 0, 0, 0); f0 = AT_VF(0); AT_SB;
            S = __builtin_amdgcn_mfma_f32_32x32x16_bf16(f1, qf[5], S, 0, 0, 0); f1 = AT_VF(1); AT_SB;
            S = __builtin_amdgcn_mfma_f32_32x32x16_bf16(f2, qf[6], S, 0, 0, 0); f2 = AT_VF(2); AT_SB;
            S = __builtin_amdgcn_mfma_f32_32x32x16_bf16(f3, qf[7], S, 0, 0, 0); f3 = AT_VF(3); AT_SB;
            float pv[16];
#pragma unroll
            for (int i = 0; i < 16; ++i) pv[i] = __builtin_amdgcn_exp2f(S[i]);
            if (kt == ntile_w - 1) {
#pragma unroll
                for (int i = 0; i < 16; ++i) { const int key = s0 + (i & 3) + 4 * ((i >> 2) & 1) + 8 * hh + 16 * (i >> 3); pv[i] = (key <= tq) ? pv[i] : 0.f; }
            }
#pragma unroll
            for (int i = 0; i < 16; ++i) lsum += pv[i];
            bf16x8 pf[2];
#pragma unroll
            for (int k2 = 0; k2 < 2; ++k2) { u32x4 u; u.x = cvt_pk_bf16(pv[8 * k2 + 0], pv[8 * k2 + 1]); u.y = cvt_pk_bf16(pv[8 * k2 + 2], pv[8 * k2 + 3]); u.z = cvt_pk_bf16(pv[8 * k2 + 4], pv[8 * k2 + 5]); u.w = cvt_pk_bf16(pv[8 * k2 + 6], pv[8 * k2 + 7]);
                pf[k2] = __builtin_bit_cast(bf16x8, u); }
            AT_SB;
#define AT_PV(i_, f_) do { O[(i_) & 7] = __builtin_amdgcn_mfma_f32_32x32x16_bf16(f_, pf[(i_) >> 3], O[(i_) & 7], 0, 0, 0); if ((i_) + 4 < 16) f_ = AT_VF((i_) + 4); AT_SB; } while (0)
            AT_PV(0, f0); AT_PV(1, f1); AT_PV(2, f2); AT_PV(3, f3); AT_PV(4, f0); AT_PV(5, f1); AT_PV(6, f2); AT_PV(7, f3);
            AT_PV(8, f0); AT_PV(9, f1); AT_PV(10, f2); AT_PV(11, f3); AT_PV(12, f0); AT_PV(13, f1); AT_PV(14, f2); AT_PV(15, f3);
#undef AT_PV
#undef AT_KF
#undef AT_VF
#undef AT_SB
        }
      }
      asm volatile("s_waitcnt vmcnt(0)" ::: "memory");
      asm volatile("s_waitcnt lgkmcnt(0)" ::: "memory");
      __builtin_amdgcn_s_barrier(); asm volatile("" ::: "memory");
    }
#undef AT_ISSUE
    const float ltot = lsum + __shfl_xor(lsum, 32);
    const float inv = 1.f / ltot;
    if (c == 1) {
#pragma unroll
        for (int db = 0; db < 8; ++db)
#pragma unroll
            for (int i = 0; i < 16; ++i) { const int dv = 32 * db + (i & 3) + 8 * (i >> 2) + 4 * hh; cmb[(g * 256 + dv) * 32 + r] = O[db][i] * inv; }
    }
    __syncthreads();
    if (c == 0) {
        float ss = 0.f;
#pragma unroll
        for (int db = 0; db < 8; ++db)
#pragma unroll
            for (int i = 0; i < 16; ++i) { const int dv = 32 * db + (i & 3) + 8 * (i >> 2) + 4 * hh; const float o = O[db][i] * inv - lam * cmb[(g * 256 + dv) * 32 + r]; O[db][i] = o; ss += o * o; }
        ss += __shfl_xor(ss, 32);
        const float rinv = rsqrtf(ss * (1.f / 256.f) + EPS) * 0.8f;
#pragma unroll
        for (int db = 0; db < 8; ++db)
#pragma unroll
            for (int ig = 0; ig < 4; ++ig) {
                const int dv0 = 32 * db + 8 * ig + 4 * hh; const size_t off = rowq * D + h * 256 + dv0;
                const u32x2 gbu = *(const u32x2*)(GB + off); const f32x4 sg = *(const f32x4*)(p.subln_g + dv0);
                u32x2 o; o.x = cvt_pk_bf16(O[db][4 * ig + 0] * rinv * sg.x * bflo(gbu.x), O[db][4 * ig + 1] * rinv * sg.y * bfhi(gbu.x));
                o.y = cvt_pk_bf16(O[db][4 * ig + 2] * rinv * sg.z * bflo(gbu.y), O[db][4 * ig + 3] * rinv * sg.w * bfhi(gbu.y));
                *(u32x2*)(YB + off) = o;
            }
    }
}

__device__ __forceinline__ void phase2b(const Params& p, unsigned char* shm, int rep) {
    int tid_ = threadIdx.x; asm volatile("" : "+v"(tid_)); const int tid = tid_, lane = tid & 63;
    if (blockIdx.x < 128) { const int xcd = blockIdx.x & 7, idx = blockIdx.x >> 3; mlstm_item(p, shm, (xcd * 2 + (idx >> 3)) * 8 + (idx & 7)); }
    float lam, M2;
    { const float a0 = p.diff_lambda[lane] * p.diff_lambda[128 + lane] + p.diff_lambda[64 + lane] * p.diff_lambda[192 + lane];
      const float a1 = p.diff_lambda[256 + lane] * p.diff_lambda[384 + lane] + p.diff_lambda[320 + lane] * p.diff_lambda[448 + lane];
      lam = expf(wave_sum(a0)) - expf(wave_sum(a1)) + 0.2f;
      float mq = fmaxf(fabsf(p.q_norm_g[lane]), fabsf(p.q_norm_g[64 + lane])), mk = fmaxf(fabsf(p.k_norm_g[lane]), fabsf(p.k_norm_g[64 + lane]));
#pragma unroll
      for (int o = 1; o < 64; o <<= 1) { mq = fmaxf(mq, __shfl_xor(mq, o)); mk = fmaxf(mk, __shfl_xor(mk, o)); }
      M2 = 128.f * mq * mk * 0.08838834764831845f * LOG2E * 1.02f;
      lam = __uint_as_float(__builtin_amdgcn_readfirstlane(__float_as_uint(lam))); M2 = __uint_as_float(__builtin_amdgcn_readfirstlane(__float_as_uint(M2))); }
    unsigned* ctr = (unsigned*)(p.ws + WS_CTL) + 128 * rep;
    int* sItem = (int*)(shm + 147456 - 64);
    const int myx = blockIdx.x & 7;
    for (;;) {
        __syncthreads();
        if (tid == 0) { int it = -1;
            for (int k = 0; k < 8; ++k) { const int q = (myx + k) & 7; const unsigned v = atomicAdd(ctr + 16 * q, 1u); if (v < 256u) { it = q * 256 + (int)v; break; } }
            *sItem = it; }
        __syncthreads();
        const int item = *sItem;
        if (item < 0) break;
        const int q = item >> 8, v = item & 255, b = v >> 6, qb = 63 - (v & 63);
        const int h = (b == 0) ? q : (b == 1) ? 7 - q : (b == 2) ? ((q + 4) & 7) : ((3 - q) & 7);
        attn_item(p, shm, b, h, qb, lam, M2);
    }
}

__device__ __forceinline__ void phase3(const Params& p, unsigned char* shm) {
    int tid_ = threadIdx.x; asm volatile("" : "+v"(tid_)); const int tid = tid_, lane = tid & 63, wave = tid >> 6, gw = blockIdx.x * 8 + wave, ngw = gridDim.x * 8;
    float* scr = (float*)(shm + wave * 8448);
    transpose_plain(p.w_out, D, D, (bf16_t*)(p.ws + WS_WOUT), scr, gw, ngw, lane);
    { const int nblk = 2 * DFF / 32, nitems = (D / 64) * nblk; bf16_t* WuT = (bf16_t*)(p.ws + WS_WUP);
      for (int it = gw; it < nitems; it += ngw) { const int kb = it / nblk, nb = it % nblk, n = 32 * nb, pt = n >> 8, j = n & 255;
          transpose_item(p.w_up, (size_t)(2 * DFF), D, WuT, 64 * kb, j < 128 ? 128 * pt + j : DFF + 128 * pt + (j - 128), n, scr, lane); } }
    transpose_plain(p.w_down, DFF, D, (bf16_t*)(p.ws + WS_WDN), scr, gw, ngw, lane);
    const bf16_t* HM = (const bf16_t*)(p.ws + WS_HM); const bf16_t* GA = (const bf16_t*)(p.ws + WS_GA); bf16_t* Y = (bf16_t*)(p.ws + WS_BQ); const bf16_t* YBp = (const bf16_t*)((const unsigned char*)p.out + DO_YB);
    const f32x4 mg0 = *(const f32x4*)(p.mlstm_norm_g + (gw & 3) * 512 + 8 * lane), mg1 = *(const f32x4*)(p.mlstm_norm_g + (gw & 3) * 512 + 8 * lane + 4);
    for (int it = gw; it < T * 4; it += ngw) {
        const size_t off = (size_t)(it >> 2) * D + (it & 3) * 512 + 8 * lane;
        float hm[8], ga[8], yb[8]; unpack8(*(const u32x4*)(HM + off), hm); unpack8(*(const u32x4*)(GA + off), ga); unpack8(*(const u32x4*)(YBp + off), yb);
        float ss = 0.f;
#pragma unroll
        for (int e = 0; e < 8; ++e) ss += hm[e] * hm[e];
        const float rinv = rsqrtf(wave_sum(ss) * (1.f / 512.f) + EPS);
        const bool same = (ngw & 3) == 0;
        const f32x4 g0 = same ? mg0 : *(const f32x4*)(p.mlstm_norm_g + (it & 3) * 512 + 8 * lane), g1 = same ? mg1 : *(const f32x4*)(p.mlstm_norm_g + (it & 3) * 512 + 8 * lane + 4);
        float y[8];
        y[0] = ga[0] * hm[0] * rinv * g0.x + yb[0]; y[1] = ga[1] * hm[1] * rinv * g0.y + yb[1]; y[2] = ga[2] * hm[2] * rinv * g0.z + yb[2]; y[3] = ga[3] * hm[3] * rinv * g0.w + yb[3];
        y[4] = ga[4] * hm[4] * rinv * g1.x + yb[4]; y[5] = ga[5] * hm[5] * rinv * g1.y + yb[5]; y[6] = ga[6] * hm[6] * rinv * g1.z + yb[6]; y[7] = ga[7] * hm[7] * rinv * g1.w + yb[7];
        *(u32x4*)(Y + off) = pack8(y);
    }
}
__device__ __forceinline__ void phase5(const Params& p) {
    int tid_ = threadIdx.x; asm volatile("" : "+v"(tid_)); const int tid = tid_, lane = tid & 63, wave = tid >> 6, gw = blockIdx.x * 8 + wave, ngw = gridDim.x * 8;
    bf16_t* H2 = (bf16_t*)(p.ws + WS_H2);
    f32x4 g2r[8];
#pragma unroll
    for (int j = 0; j < 8; ++j) g2r[j] = *((const f32x4*)p.norm2_g + lane + 64 * j);
    for (int row = gw; row < T; row += ngw) {
        const f32x4* xr = (const f32x4*)(p.out + (size_t)row * D) + lane;
        f32x4 v[8]; float ss = 0.f;
#pragma unroll
        for (int j = 0; j < 8; ++j) { v[j] = xr[64 * j]; ss += (v[j].x * v[j].x + v[j].y * v[j].y) + (v[j].z * v[j].z + v[j].w * v[j].w); }
        const float rinv = rsqrtf(wave_sum(ss) * (1.f / D) + EPS);
        u32x2* o8 = (u32x2*)(H2 + (size_t)row * D) + lane;
#pragma unroll
        for (int j = 0; j < 8; ++j) { const f32x4 g = g2r[j];
            u32x2 o; o.x = cvt_pk_bf16(v[j].x * rinv * g.x, v[j].y * rinv * g.y); o.y = cvt_pk_bf16(v[j].z * rinv * g.z, v[j].w * rinv * g.w); o8[64 * j] = o; }
    }
}
__device__ __forceinline__ float dpp_ror1(float v) { return __int_as_float(__builtin_amdgcn_update_dpp(0, __float_as_int(v), 0x121, 0xf, 0xf, false)); }
__device__ __forceinline__ float dpp_ror2(float v) { return __int_as_float(__builtin_amdgcn_update_dpp(0, __float_as_int(v), 0x122, 0xf, 0xf, false)); }
struct EpiUp {
    static constexpr bool PERM = true, AFTER_DRAIN = false;
    bf16_t* act; bf16_t* sb; const float* cw; const float* cb;
    __device__ __forceinline__ void operator()(const f32x4 (&acc)[2][2][4][2], const pg8::Unit& u, int wr, int wc, int fr_in, int fq_in) const {
        int fr = fr_in, fq = fq_in; asm volatile("" : "+v"(fr), "+v"(fq));
        const int row0 = u.pm * 256 + wr * 64 + fr;
#pragma unroll
        for (int n = 0; n < 2; ++n) {
            const int cl = u.pn * 128 + wc * 32 + 8 * fq + 4 * n;
            const f32x4 wg0 = *(const f32x4*)(cw + cl), wg1 = *(const f32x4*)(cw + (size_t)2 * DFF + cl), wg2 = *(const f32x4*)(cw + (size_t)4 * DFF + cl);
            const f32x4 wv0 = *(const f32x4*)(cw + DFF + cl), wv1 = *(const f32x4*)(cw + (size_t)3 * DFF + cl), wv2 = *(const f32x4*)(cw + (size_t)5 * DFF + cl);
            const f32x4 bg = *(const f32x4*)(cb + cl), bv = *(const f32x4*)(cb + DFF + cl);
#pragma unroll
            for (int ai = 0; ai < 2; ++ai) {
#pragma unroll
                for (int m = 0; m < 4; ++m) {
                    const int row = row0 + ai * 128 + m * 16;
                    const f32x4 g = acc[ai][0][m][n], v = acc[ai][1][m][n];
                    const f32x4 gp = acc[ai][0][m > 0 ? m - 1 : 0][n], vp = acc[ai][1][m > 0 ? m - 1 : 0][n];
                    if ((m == 0 && fr < 2) || (m == 3 && fr >= 14)) {
                        const int slot = (m == 0) ? fr : fr - 12;
                        bf16_t* d = sb + ((size_t)(row >> 6) * 4 + slot) * (2 * DFF) + cl;
                        u32x2 og, ov; og.x = cvt_pk_bf16(g[0], g[1]); og.y = cvt_pk_bf16(g[2], g[3]); ov.x = cvt_pk_bf16(v[0], v[1]); ov.y = cvt_pk_bf16(v[2], v[3]);
                        *(u32x2*)d = og; *(u32x2*)(d + DFF) = ov;
                    }
                    f32x4 y;
#pragma unroll
                    for (int e = 0; e < 4; ++e) {
                        const float xg1 = dpp_ror1(fr == 15 ? gp[e] : g[e]), xg2 = dpp_ror2(fr >= 14 ? gp[e] : g[e]);
                        const float xv1 = dpp_ror1(fr == 15 ? vp[e] : v[e]), xv2 = dpp_ror2(fr >= 14 ? vp[e] : v[e]);
                        const float ug = bg[e] + wg0[e] * xg2 + wg1[e] * xg1 + wg2[e] * g[e];
                        const float uv = bv[e] + wv0[e] * xv2 + wv1[e] * xv1 + wv2[e] * v[e];
                        y[e] = ug * fsig(ug) * uv;
                    }
                    if (!(m == 0 && fr < 2)) { u32x2 o; o.x = cvt_pk_bf16(y[0], y[1]); o.y = cvt_pk_bf16(y[2], y[3]); *(u32x2*)(act + (size_t)row * DFF + cl) = o; }
                }
            }
        }
    }
};
__device__ __forceinline__ void phase_fix(const Params& p) {
    const bf16_t* SB = (const bf16_t*)(p.ws + WS_SB); bf16_t* ACT = (bf16_t*)(p.ws + WS_ACT);
    int tid_ = threadIdx.x; asm volatile("" : "+v"(tid_)); const int gt = blockIdx.x * 512 + tid_, ngt = gridDim.x * 512;
    for (int idx = gt; idx < (T / 64) * 704; idx += ngt) {
        const int oct = idx % 704, kb = idx / 704, c0 = 8 * oct, r0 = 64 * kb;
        float wg[3][8], wv[3][8], bg[8], bv[8];
#pragma unroll
        for (int j = 0; j < 3; ++j) {
            const f32x4 a = *(const f32x4*)(p.ffn_conv_w + (size_t)j * 2 * DFF + c0), b = *(const f32x4*)(p.ffn_conv_w + (size_t)j * 2 * DFF + c0 + 4);
            const f32x4 c = *(const f32x4*)(p.ffn_conv_w + (size_t)j * 2 * DFF + DFF + c0), d = *(const f32x4*)(p.ffn_conv_w + (size_t)j * 2 * DFF + DFF + c0 + 4);
            wg[j][0] = a.x; wg[j][1] = a.y; wg[j][2] = a.z; wg[j][3] = a.w; wg[j][4] = b.x; wg[j][5] = b.y; wg[j][6] = b.z; wg[j][7] = b.w;
            wv[j][0] = c.x; wv[j][1] = c.y; wv[j][2] = c.z; wv[j][3] = c.w; wv[j][4] = d.x; wv[j][5] = d.y; wv[j][6] = d.z; wv[j][7] = d.w;
        }
        { const f32x4 a = *(const f32x4*)(p.ffn_conv_b + c0), b = *(const f32x4*)(p.ffn_conv_b + c0 + 4), c = *(const f32x4*)(p.ffn_conv_b + DFF + c0), d = *(const f32x4*)(p.ffn_conv_b + DFF + c0 + 4);
          bg[0] = a.x; bg[1] = a.y; bg[2] = a.z; bg[3] = a.w; bg[4] = b.x; bg[5] = b.y; bg[6] = b.z; bg[7] = b.w; bv[0] = c.x; bv[1] = c.y; bv[2] = c.z; bv[3] = c.w; bv[4] = d.x; bv[5] = d.y; bv[6] = d.z; bv[7] = d.w; }
        float g2[8], g1[8], v2[8], v1[8];
        if ((r0 & (SEQ - 1)) != 0) {
            const bf16_t* pr = SB + ((size_t)(kb - 1) * 4 + 2) * (2 * DFF) + c0;
            unpack8(*(const u32x4*)pr, g2); unpack8(*(const u32x4*)(pr + DFF), v2); unpack8(*(const u32x4*)(pr + 2 * DFF), g1); unpack8(*(const u32x4*)(pr + 2 * DFF + DFF), v1);
        } else {
#pragma unroll
            for (int e = 0; e < 8; ++e) { g2[e] = 0.f; g1[e] = 0.f; v2[e] = 0.f; v1[e] = 0.f; }
        }
#pragma unroll
        for (int rr = 0; rr < 2; ++rr) {
            float g0[8], v0[8], y[8];
            const bf16_t* cr = SB + ((size_t)kb * 4 + rr) * (2 * DFF) + c0;
            unpack8(*(const u32x4*)cr, g0); unpack8(*(const u32x4*)(cr + DFF), v0);
#pragma unroll
            for (int e = 0; e < 8; ++e) {
                const float ug = bg[e] + wg[0][e] * g2[e] + wg[1][e] * g1[e] + wg[2][e] * g0[e];
                const float uv = bv[e] + wv[0][e] * v2[e] + wv[1][e] * v1[e] + wv[2][e] * v0[e];
                y[e] = ug * fsig(ug) * uv; g2[e] = g1[e]; g1[e] = g0[e]; v2[e] = v1[e]; v1[e] = v0[e];
            }
            *(u32x4*)(ACT + (size_t)(r0 + rr) * DFF + c0) = pack8(y);
        }
    }
}

#ifndef REP1
#define REP1 1
#endif
#ifndef REP3
#define REP3 1
#endif
__global__ void __launch_bounds__(512, 2) mega(Params p) {
    extern __shared__ __attribute__((aligned(16))) unsigned char shm[];
    cg::grid_group grid = cg::this_grid();
    bf16_t* H = (bf16_t*)((unsigned char*)p.out + DO_H); bf16_t* WinT = (bf16_t*)((unsigned char*)p.out + DO_WIN);
    bf16_t* H2 = (bf16_t*)(p.ws + WS_H2); bf16_t* ACTb = (bf16_t*)(p.ws + WS_ACT);
    const bf16_t* WoT = (const bf16_t*)(p.ws + WS_WOUT); const bf16_t* WuT = (const bf16_t*)(p.ws + WS_WUP); const bf16_t* WdT = (const bf16_t*)(p.ws + WS_WDN);
#define PH(i) (p.ph_lo <= (i) && (i) < p.ph_hi)
#define SYNC(i) do { if (p.ph_lo <= (i) && (i) + 1 < p.ph_hi) grid.sync(); } while (0)
    if (PH(0)) phase0(p, shm);
    SYNC(0);
    for (int rep = 0; rep < REP1; ++rep) { if (rep) grid.sync();
    if (PH(1)) { Epi1 E{(bf16_t*)(p.ws + WS_AQK), (bf16_t*)(p.ws + WS_VTM), (bf16_t*)(p.ws + WS_GA), (bf16_t*)(p.ws + WS_BQ), (bf16_t*)(p.ws + WS_BK), (bf16_t*)(p.ws + WS_VTD), (bf16_t*)(p.ws + WS_GB)};
        run_gemm(shm, H, WinT, T, 16384, D, E); } }
    SYNC(1);
    if (PH(2)) phase2a(p, shm);
    SYNC(2);
    for (int rep = 0; rep < REP3; ++rep) { if (rep) grid.sync(); if (PH(3)) phase2b(p, shm, rep); }
    SYNC(3);
    if (PH(4)) phase3(p, shm);
    SYNC(4);
    if (PH(5)) { EpiRes E{p.out, p.x, D}; run_gemm(shm, (const bf16_t*)(p.ws + WS_BQ), WoT, T, D, D, E); }
    SYNC(5);
    if (PH(6)) phase5(p);
    SYNC(6);
    if (PH(7)) { EpiUp E{ACTb, (bf16_t*)(p.ws + WS_SB), p.ffn_conv_w, p.ffn_conv_b}; run_gemm(shm, H2, WuT, T, 2 * DFF, D, E); }
    SYNC(7);
    if (PH(8)) phase_fix(p);
    SYNC(8);
    if (PH(9)) { EpiRes E{p.out, p.out, D}; run_gemm(shm, ACTb, WdT, T, D, DFF, E); }
#undef PH
#undef SYNC
}

#ifndef N_LAUNCHES
#define N_LAUNCHES 1
#endif
extern "C" void kernel_launch(void* const* d_in, const int* in_sizes, int n_in, void* d_out, int out_size, void* d_ws, size_t ws_size, hipStream_t stream) {
    static int grid = 0;
    if (grid == 0) {
        if (n_in != 17 || out_size != T * D || ws_size < WS_END) { fprintf(stderr, "kernel_launch: unexpected problem (n_in %d, out %d, ws %zu)\n", n_in, out_size, ws_size); grid = -1; return; }
        int dev = 0, cus = 0, per_cu = 0;
        if (hipGetDevice(&dev) != hipSuccess || hipDeviceGetAttribute(&cus, hipDeviceAttributeMultiprocessorCount, dev) != hipSuccess) { grid = -1; return; }
        if (hipFuncSetAttribute((const void*)mega, hipFuncAttributeMaxDynamicSharedMemorySize, LDS_BYTES) != hipSuccess) { fprintf(stderr, "kernel_launch: hipFuncSetAttribute failed\n"); grid = -1; return; }
        if (hipOccupancyMaxActiveBlocksPerMultiprocessor(&per_cu, (const void*)mega, 512, LDS_BYTES) != hipSuccess || per_cu < 1) { fprintf(stderr, "kernel_launch: occupancy query says %d\n", per_cu); per_cu = 1; }
        (void)hipGetLastError();
        grid = cus * per_cu;
    }
    if (grid < 0) return;
    if (hipMemsetAsync((char*)d_ws + WS_CTL, 0, 4096, stream) != hipSuccess) { fprintf(stderr, "kernel_launch: memset failed\n"); return; }
    Params p{};
    const float** pp = (const float**)&p;
    for (int i = 0; i < 17; ++i) pp[i] = (const float*)d_in[i];
    p.out = (float*)d_out; p.ws = (unsigned char*)d_ws;
    constexpr int NPH = 10;
    for (int li = 0; li < N_LAUNCHES; ++li) {
        p.ph_lo = (N_LAUNCHES == 1) ? 0 : li; p.ph_hi = (N_LAUNCHES == 1) ? NPH : li + 1;
        void* args[] = {&p};
        hipError_t e = hipLaunchCooperativeKernel((const void*)mega, dim3(grid), dim3(512), args, LDS_BYTES, stream);
        if (e != hipSuccess) { fprintf(stderr, "cooperative launch failed: %s (grid %d)\n", hipGetErrorString(e), grid); break; }
    }
}
```

```cpp
#include <hip/hip_runtime.h>
#include <hip/hip_cooperative_groups.h>
#include <cstdio>
#include <cstdint>
namespace cg = cooperative_groups;
namespace pg8 {
#define PG8_LAS __attribute__((address_space(3)))
typedef unsigned short bf16_t;
typedef short bf16x8 __attribute__((ext_vector_type(8)));
typedef float f32x4 __attribute__((ext_vector_type(4)));
typedef unsigned u32x4 __attribute__((ext_vector_type(4)));
constexpr int BM = 256, BK = 64, HALF = 128, HTB = HALF * BK * 2  , STAGE_BYTES = 8 * HTB, NXCD = 8, WGM = 8;

__host__ __device__ __forceinline__ int lds_byte(int r, int c) { const int st = (r >> 4) * 2 + (c >> 5), rr = r & 15, cc = c & 31, ob = rr * 64 + cc * 2; return st * 1024 + (ob ^ (((ob >> 9) & 1) << 5)); }
__host__ __device__ __forceinline__ void stage_rc(int b, int& R, int& C) { const int st = b / 1024, sb = b % 1024, swz = sb ^ (((sb >> 9) & 1) << 5); R = (st >> 1) * 16 + swz / 64; C = (st & 1) * 32 + (swz % 64) / 2; }
__host__ __device__ __forceinline__ int perm32(int rho) { const int n = rho >> 4, i = rho & 15; return 8 * (i >> 2) + 4 * n + (i & 3); }

struct Unit { int pm, pn; };
struct Gemm { const bf16_t* A; const bf16_t* Bt; int M, N, K; };

struct StaticOrder {
    int nM, nN, nwg, G, c;
    __host__ __device__ void init(int M, int N, int G_, int c_) { nM = M / BM; nN = N / BM; nwg = nM * nN; G = G_; c = c_; }
    __host__ __device__ bool next(int i, Unit& u) const {
        const long L = (long)i * G + c; if (L >= nwg) return false;
        int wgid = (int)L; { const int q = nwg / NXCD, r = nwg % NXCD, xcd = wgid % NXCD, off = wgid / NXCD; wgid = (xcd < r ? xcd * (q + 1) : r * (q + 1) + (xcd - r) * q) + off; }
        const int nig = WGM * nN, gid = wgid / nig, fm = gid * WGM, gsz = (nM - fm) < WGM ? (nM - fm) : WGM;
        u.pm = fm + ((wgid % nig) % gsz); u.pn = (wgid % nig) / gsz; return true;
    }
    __device__ __forceinline__ void a_ready(const Unit&) const {}
    __device__ __forceinline__ void done(const Unit&) const {}
};
__device__ __forceinline__ unsigned cvt_pk_bf16(float lo, float hi) { unsigned r; asm volatile("v_cvt_pk_bf16_f32 %0, %1, %2" : "=v"(r) : "v"(lo), "v"(hi)); return r; }
template <class Epi, class Sched, bool STAMP = false>
__device__ __forceinline__ void gemm_phase(PG8_LAS unsigned char* lds, const Gemm g, const Sched& S, const Epi& E, unsigned long long* stamps) {
    int tid_ = threadIdx.x; asm volatile("" : "+v"(tid_)); const int tid = tid_, wid = __builtin_amdgcn_readfirstlane(tid >> 6), lane = tid & 63, wr = wid >> 2, wc = wid & 3, fr = lane & 15, fq = lane >> 4;
    const int K = g.K, nt = K / BK;
    int ts_lo = 0, ts_hi = 0, nts = 0; const unsigned long long rt_entry = STAMP ? (unsigned long long)wall_clock64() : 0ull;
#define PG8_STAMP() do { if (STAMP && wid == 0 && nts < 64) { const unsigned long long _c = (unsigned long long)clock64(); \
        ts_lo = (lane == nts) ? (int)(unsigned)_c : ts_lo; ts_hi = (lane == nts) ? (int)(unsigned)(_c >> 32) : ts_hi; ++nts; } } while (0)
    PG8_STAMP();
    unsigned voffA[2], voffB[2];
#pragma unroll
    for (int i = 0; i < 2; ++i) { int R, C; stage_rc(tid * 16 + i * 8192, R, C); const int Rb = Epi::PERM ? ((R & ~31) + perm32(R & 31)) : R;
        voffA[i] = (unsigned)(R * K + C) * 2u; voffB[i] = (unsigned)(Rb * K + C) * 2u; }
    const size_t kstep = (size_t)(BK * 2);
    const size_t hstep = (size_t)HALF * K * 2;
    const size_t tstep = 2 * hstep;
    const unsigned ldsw = (unsigned)wid * 1024u;
    const int aoff = lds_byte(wr * 64 + fr, fq * 8), boff = lds_byte(wc * 32 + fr, fq * 8);
#define PG8_SA(b, h) (((b) * 2 + (h)) * HTB)
#define PG8_SB(b, h) ((4 + (b) * 2 + (h)) * HTB)
#define PG8_STAGE(bufoff, gbase, voff) do { _Pragma("unroll") for (int _i = 0; _i < 2; ++_i) \
        __builtin_amdgcn_global_load_lds((const unsigned*)((const char*)(gbase) + (voff)[_i]), (PG8_LAS unsigned*)(lds + (bufoff) + ldsw + _i * 8192), 16, 0, 0); } while (0)
#define PG8_LDA(dst, b, h) do { _Pragma("unroll") for (int m = 0; m < 4; ++m) _Pragma("unroll") for (int k = 0; k < 2; ++k) dst[m][k] = *(const PG8_LAS bf16x8*)(lds + PG8_SA(b, h) + aoff + m * 2048 + k * 1024); } while (0)
#define PG8_LDB(dst, b, h) do { _Pragma("unroll") for (int n = 0; n < 2; ++n) _Pragma("unroll") for (int k = 0; k < 2; ++k) dst[n][k] = *(const PG8_LAS bf16x8*)(lds + PG8_SB(b, h) + boff + n * 2048 + k * 1024); } while (0)
#define PG8_MMA(ai, bj, At, Bt) do { __builtin_amdgcn_s_setprio(1); _Pragma("unroll") for (int m = 0; m < 4; ++m) _Pragma("unroll") for (int n = 0; n < 2; ++n) _Pragma("unroll") for (int k = 0; k < 2; ++k) \
        acc[ai][bj][m][n] = __builtin_amdgcn_mfma_f32_16x16x32_bf16(Bt[n][k], At[m][k], acc[ai][bj][m][n], 0, 0, 0); __builtin_amdgcn_s_setprio(0); } while (0)
#define PG8_WAIT_V(n) asm volatile("s_waitcnt vmcnt(" #n ")" ::: "memory")
#define PG8_WAIT_L(n) asm volatile("s_waitcnt lgkmcnt(" #n ")" ::: "memory")
#define PG8_BAR __builtin_amdgcn_s_barrier()
#define PG8_SCHED __builtin_amdgcn_sched_barrier(0)
    Unit cur, nxt; int ui = 0;
    if (!S.next(0, cur)) return;
    f32x4 acc[2][2][4][2];
#pragma unroll
    for (int a = 0; a < 2; ++a)
#pragma unroll
        for (int b = 0; b < 2; ++b)
#pragma unroll
            for (int m = 0; m < 4; ++m)
#pragma unroll
                for (int n = 0; n < 2; ++n) acc[a][b][m][n] = (f32x4){0.f, 0.f, 0.f, 0.f};
    bf16x8 At[4][2], B0[2][2], B1[2][2];
    const char* cA = (const char*)g.A + (size_t)cur.pm * tstep; const char* cB = (const char*)g.Bt + (size_t)cur.pn * tstep;
    S.a_ready(cur);
    PG8_STAGE(PG8_SB(0, 0), cB, voffB); PG8_STAGE(PG8_SA(0, 0), cA, voffA); PG8_STAGE(PG8_SB(0, 1), cB + hstep, voffB); PG8_STAGE(PG8_SA(0, 1), cA + hstep, voffA);
    if (wr == 1) PG8_BAR;
    PG8_WAIT_V(4); PG8_BAR;
    PG8_STAGE(PG8_SB(1, 0), cB + kstep, voffB); PG8_STAGE(PG8_SA(1, 0), cA + kstep, voffA); PG8_STAGE(PG8_SB(1, 1), cB + hstep + kstep, voffB);
    PG8_WAIT_V(6); PG8_BAR;
    PG8_STAMP();
    for (;;) {
        const bool has_next = S.next(ui + 1, nxt);
        const char* nA = has_next ? (const char*)g.A + (size_t)nxt.pm * tstep : cA; const char* nB = has_next ? (const char*)g.Bt + (size_t)nxt.pn * tstep : cB;
        for (int t = 0; t < nt; t += 2) {
            const bool last = (t == nt - 2);
            const char* a1 = cA + (size_t)(t + 1) * kstep;
            const char* a2 = last ? nA : cA + (size_t)(t + 2) * kstep; const char* b2 = last ? nB : cB + (size_t)(t + 2) * kstep;
            const char* a3 = a2 + kstep; const char* b3 = b2 + kstep;
            if (last && has_next) S.a_ready(nxt);
            PG8_LDB(B0, 0, 0); PG8_SCHED; PG8_LDA(At, 0, 0); PG8_STAGE(PG8_SA(1, 1), a1 + hstep, voffA);
            PG8_WAIT_L(8); PG8_BAR; PG8_WAIT_L(0); PG8_MMA(0, 0, At, B0); PG8_BAR; PG8_SCHED;
            PG8_LDB(B1, 0, 1); PG8_STAGE(PG8_SB(0, 0), b2, voffB);
            PG8_BAR; PG8_WAIT_L(0); PG8_MMA(0, 1, At, B1); PG8_BAR;
            PG8_LDA(At, 0, 1); PG8_STAGE(PG8_SA(0, 0), a2, voffA);
            PG8_BAR; PG8_WAIT_L(0); PG8_MMA(1, 0, At, B0); PG8_BAR; PG8_SCHED;
            PG8_STAGE(PG8_SB(0, 1), b2 + hstep, voffB);
            PG8_WAIT_V(6); PG8_BAR; PG8_MMA(1, 1, At, B1); PG8_BAR;
            PG8_LDB(B0, 1, 0); PG8_SCHED; PG8_LDA(At, 1, 0); PG8_STAGE(PG8_SA(0, 1), a2 + hstep, voffA);
            PG8_WAIT_L(8); PG8_BAR; PG8_WAIT_L(0); PG8_MMA(0, 0, At, B0); PG8_BAR; PG8_SCHED;
            PG8_LDB(B1, 1, 1); PG8_STAGE(PG8_SB(1, 0), b3, voffB);
            PG8_BAR; PG8_WAIT_L(0); PG8_MMA(0, 1, At, B1); PG8_BAR;
            PG8_LDA(At, 1, 1); PG8_STAGE(PG8_SA(1, 0), a3, voffA);
            PG8_BAR; PG8_WAIT_L(0); PG8_MMA(1, 0, At, B0); PG8_BAR; PG8_SCHED;
            PG8_STAGE(PG8_SB(1, 1), b3 + hstep, voffB);
            PG8_WAIT_V(6); PG8_BAR; PG8_MMA(1, 1, At, B1); PG8_BAR;
        }
        PG8_STAMP();
        if constexpr (!Epi::AFTER_DRAIN) { E(acc, cur, wr, wc, fr, fq); S.done(cur); }
        PG8_STAMP();
        if (!has_next) break;
#pragma unroll
        for (int a = 0; a < 2; ++a)
#pragma unroll
            for (int b = 0; b < 2; ++b)
#pragma unroll
                for (int m = 0; m < 4; ++m)
#pragma unroll
                    for (int n = 0; n < 2; ++n) acc[a][b][m][n] = (f32x4){0.f, 0.f, 0.f, 0.f};
        cur = nxt; cA = nA; cB = nB; ++ui;
    }
    PG8_WAIT_V(0);
    if (wr == 0) PG8_BAR;
    PG8_BAR;
    if constexpr (Epi::AFTER_DRAIN) { E.fused(acc, cur, wr, wc, fr, fq, lds, wid, lane); S.done(cur); }
    PG8_STAMP();
    if (STAMP && wid == 0) { stamps[lane] = lane < nts ? (((unsigned long long)(unsigned)ts_hi << 32) | (unsigned)ts_lo) : 0ull;
        if (lane == 62) stamps[62] = rt_entry; if (lane == 63) stamps[63] = (unsigned long long)wall_clock64(); }
#undef PG8_STAMP
#undef PG8_SA
#undef PG8_SB
#undef PG8_STAGE
#undef PG8_LDA
#undef PG8_LDB
#undef PG8_MMA
#undef PG8_WAIT_V
#undef PG8_WAIT_L
#undef PG8_BAR
#undef PG8_SCHED
}
}
using pg8::bf16_t; using pg8::bf16x8; using pg8::f32x4; using pg8::u32x4; using pg8::cvt_pk_bf16;
typedef unsigned u32x2 __attribute__((ext_vector_type(2)));
typedef float f32x16 __attribute__((ext_vector_type(16)));

constexpr int T = 32768, D = 2048, SEQ = 8192, PIN = 16392, DFF = 5632, TH = 16384;
constexpr float EPS = 1e-6f, LOG2E = 1.4426950408889634f;
constexpr size_t MiB = (size_t)1 << 20;
constexpr size_t WS_CTL = 0, WS_GIF = 1 * MiB, WS_KT = 2 * MiB, WS_AQK = 66 * MiB, WS_VTM = 194 * MiB, WS_GA = 322 * MiB, WS_BQ = 450 * MiB, WS_BK = 578 * MiB,
                 WS_VTD = 706 * MiB, WS_GB = 834 * MiB, WS_END = 962 * MiB;
constexpr size_t WS_HM = WS_AQK, WS_H2 = WS_AQK, WS_WOUT = WS_VTM, WS_WUP = WS_VTM + 8 * MiB, WS_WDN = WS_VTM + 52 * MiB, WS_ACT = WS_GA, WS_SB = 674 * MiB;
constexpr size_t DO_H = 0, DO_Q2 = 0, DO_K2 = 64 * MiB, DO_WIN = 128 * MiB, DO_YB = 128 * MiB;
constexpr int LDS_BYTES = 147456;

struct Params {
    const float *x, *norm1_g, *w_in, *if_bias, *qk_conv_w, *qk_conv_b, *mlstm_norm_g, *q_norm_g, *k_norm_g, *diff_lambda, *subln_g, *w_out, *norm2_g, *w_up, *ffn_conv_w, *ffn_conv_b, *w_down;
    float* out; unsigned char* ws; int ph_lo, ph_hi;
};

__device__ __forceinline__ void lds_wait() { asm volatile("s_waitcnt lgkmcnt(0)" ::: "memory"); }
__device__ __forceinline__ float bflo(unsigned u) { return __uint_as_float(u << 16); }
__device__ __forceinline__ float bfhi(unsigned u) { return __uint_as_float(u & 0xffff0000u); }
__device__ __forceinline__ float fsig(float v) { return __builtin_amdgcn_rcpf(1.f + __expf(-v)); }
__device__ __forceinline__ float wave_sum(float v) {
#pragma unroll
    for (int o = 1; o < 64; o <<= 1) v += __shfl_xor(v, o);
    return v;
}
__device__ __forceinline__ void unpack8(u32x4 u, float (&f)[8]) {
    f[0] = bflo(u.x); f[1] = bfhi(u.x); f[2] = bflo(u.y); f[3] = bfhi(u.y); f[4] = bflo(u.z); f[5] = bfhi(u.z); f[6] = bflo(u.w); f[7] = bfhi(u.w);
}
__device__ __forceinline__ u32x4 pack8(const float (&f)[8]) {
    u32x4 o; o.x = cvt_pk_bf16(f[0], f[1]); o.y = cvt_pk_bf16(f[2], f[3]); o.z = cvt_pk_bf16(f[4], f[5]); o.w = cvt_pk_bf16(f[6], f[7]); return o;
}

__device__ __forceinline__ void transpose_item(const float* __restrict__ W, size_t ldw, int K, bf16_t* WT, int k0, int srcn0, int dstn0, float* scr, int lane) {
#pragma unroll 8
    for (int i = 0; i < 32; ++i) { const int kk = 2 * i + (lane >> 5); scr[kk * 33 + (lane & 31)] = W[(size_t)(k0 + kk) * ldw + srcn0 + (lane & 31)]; }
    lds_wait();
    const int c = lane & 7;
#pragma unroll
    for (int j = 0; j < 4; ++j) { const int n = (lane >> 3) + 8 * j; const float* s = scr + (8 * c) * 33 + n;
        u32x4 o; o.x = cvt_pk_bf16(s[0], s[33]); o.y = cvt_pk_bf16(s[66], s[99]); o.z = cvt_pk_bf16(s[132], s[165]); o.w = cvt_pk_bf16(s[198], s[231]);
        *(u32x4*)(WT + (size_t)(dstn0 + n) * K + k0 + 8 * c) = o; }
    lds_wait();
}
__device__ __forceinline__ int win_src(int n) {
    if (n < 4096) return n;
    if (n < 8192) { const int p = (n - 4096) >> 8, j = (n - 4096) & 255; return j < 128 ? 4096 + 128 * p + j : 12296 + 128 * p + (j - 128); }
    if (n < 10240) return 6152 + (n - 8192);
    if (n < 12288) return 8200 + (n - 10240);
    if (n < 14336) return 10248 + (n - 12288);
    return 14344 + (n - 14336);
}
__device__ __forceinline__ void transpose_plain(const float* W, int K, int N, bf16_t* WT, float* scr, int gw, int ngw, int lane) {
    const int nblk = N / 32, nitems = (K / 64) * nblk;
    for (int it = gw; it < nitems; it += ngw) { const int kb = it / nblk, nb = it % nblk; transpose_item(W, (size_t)N, K, WT, 64 * kb, 32 * nb, 32 * nb, scr, lane); }
}

__device__ __forceinline__ void phase0(const Params& p, unsigned char* shm) {
    int tid_ = threadIdx.x; asm volatile("" : "+v"(tid_)); const int tid = tid_, lane = tid & 63, wave = tid >> 6, gw = blockIdx.x * 8 + wave, ngw = gridDim.x * 8;
    float* scr = (float*)(shm + wave * 8448);
    bf16_t* WinT = (bf16_t*)((unsigned char*)p.out + DO_WIN);
    { const int nblk = 16384 / 32, nitems = (D / 64) * nblk;
      for (int it = gw; it < nitems; it += ngw) { const int kb = it / nblk, nb = it % nblk; transpose_item(p.w_in, (size_t)PIN, D, WinT, 64 * kb, win_src(32 * nb), 32 * nb, scr, lane); } }
    float* wifT = (float*)(shm + 69632);
    for (int idx = tid; idx < 8 * D; idx += 512) { const int k = idx >> 3, j = idx & 7; wifT[j * D + k] = p.w_in[(size_t)k * PIN + 6144 + j]; }
    __syncthreads();
    bf16_t* H = (bf16_t*)((unsigned char*)p.out + DO_H);
    float* GIF = (float*)(p.ws + WS_GIF);
    f32x4 g1r[8];
#pragma unroll
    for (int j = 0; j < 8; ++j) g1r[j] = *((const f32x4*)p.norm1_g + lane + 64 * j);
    for (int row = gw; row < T; row += ngw) {
        const f32x4* xr = (const f32x4*)(p.x + (size_t)row * D) + lane;
        f32x4 v[8]; float ss = 0.f;
#pragma unroll
        for (int j = 0; j < 8; ++j) { v[j] = xr[64 * j]; ss += (v[j].x * v[j].x + v[j].y * v[j].y) + (v[j].z * v[j].z + v[j].w * v[j].w); }
        const float rinv = rsqrtf(wave_sum(ss) * (1.f / D) + EPS);
        float ga[8];
#pragma unroll
        for (int j = 0; j < 8; ++j) ga[j] = 0.f;
        u32x2* o8 = (u32x2*)(H + (size_t)row * D) + lane;
#pragma unroll
        for (int j = 0; j < 8; ++j) {
            const f32x4 g = g1r[j];
            f32x4 h; h.x = v[j].x * rinv * g.x; h.y = v[j].y * rinv * g.y; h.z = v[j].z * rinv * g.z; h.w = v[j].w * rinv * g.w;
            u32x2 o; o.x = cvt_pk_bf16(h.x, h.y); o.y = cvt_pk_bf16(h.z, h.w); o8[64 * j] = o;
#pragma unroll
            for (int q = 0; q < 8; ++q) { const f32x4 w = *((const f32x4*)(wifT + q * D) + lane + 64 * j); ga[q] += (h.x * w.x + h.y * w.y) + (h.z * w.z + h.w * w.w); }
        }
#pragma unroll
        for (int q = 0; q < 8; ++q) ga[q] = wave_sum(ga[q]);
        if (lane < 8) {
            float val = 0.f;
#pragma unroll
            for (int q = 0; q < 8; ++q) val = (lane == q) ? ga[q] : val;
            val += p.if_bias[lane];
            if (lane >= 4) val = fminf(val, 0.f) - log1pf(expf(-fabsf(val)));
            GIF[(size_t)row * 8 + lane] = val;
        }
    }
}

struct Epi1 {
    static constexpr bool PERM = true, AFTER_DRAIN = false;
    bf16_t *aqk, *vtm, *ga, *bq, *bk, *vtd, *gb;
    __device__ __forceinline__ void operator()(const f32x4 (&acc)[2][2][4][2], const pg8::Unit& u, int wr, int wc, int fr, int fq) const {
        const int pn = u.pn, row0 = u.pm * 256 + wr * 64 + fr, cw = wc * 32 + 8 * fq;
        if (pn >= 16 && pn < 32) {
            const int cb = 128 * (pn - 16) + cw;
#pragma unroll
            for (int ai = 0; ai < 2; ++ai)
#pragma unroll
                for (int m = 0; m < 4; ++m) {
                    const size_t row = (size_t)(row0 + ai * 128 + m * 16);
                    float f[8];
#pragma unroll
                    for (int j = 0; j < 4; ++j) { f[j] = fsig(acc[ai][0][m][0][j]) * fsig(acc[ai][1][m][0][j]); f[4 + j] = fsig(acc[ai][0][m][1][j]) * fsig(acc[ai][1][m][1][j]); }
                    *(u32x4*)(ga + row * D + cb) = pack8(f);
                }
            return;
        }
        bf16_t* dst; int col0; int mode;
        if (pn < 8) { dst = aqk; col0 = 256 * pn; mode = 0; }
        else if (pn < 16) { dst = vtm; col0 = 256 * (pn - 8); mode = 1; }
        else if (pn < 40) { dst = bq; col0 = 256 * (pn - 32); mode = 0; }
        else if (pn < 48) { dst = bk; col0 = 256 * (pn - 40); mode = 0; }
        else if (pn < 56) { dst = vtd; col0 = 256 * (pn - 48); mode = 3; }
        else { dst = gb; col0 = 256 * (pn - 56); mode = 2; }
#pragma unroll
        for (int ai = 0; ai < 2; ++ai)
#pragma unroll
            for (int m = 0; m < 4; ++m) {
                const int row = row0 + ai * 128 + m * 16;
#pragma unroll
                for (int bj = 0; bj < 2; ++bj) {
                    const int col = col0 + bj * 128 + cw;
                    float f[8];
#pragma unroll
                    for (int j = 0; j < 4; ++j) { f[j] = acc[ai][bj][m][0][j]; f[4 + j] = acc[ai][bj][m][1][j]; }
                    if (mode == 2) {
#pragma unroll
                        for (int j = 0; j < 8; ++j) f[j] = fsig(f[j]);
                    }
                    const u32x4 w = pack8(f);
                    if (mode == 3) {
                        bf16_t* d = dst + (((size_t)((row >> 13) * 8 + (col >> 8)) * 256 + ((row & (SEQ - 1)) >> 5)) * 256 + (col & 255)) * 32 + (row & 31);
                        d[0] = (bf16_t)(w.x & 0xffff); d[32] = (bf16_t)(w.x >> 16); d[64] = (bf16_t)(w.y & 0xffff); d[96] = (bf16_t)(w.y >> 16);
                        d[128] = (bf16_t)(w.z & 0xffff); d[160] = (bf16_t)(w.z >> 16); d[192] = (bf16_t)(w.w & 0xffff); d[224] = (bf16_t)(w.w >> 16);
                    } else if (mode == 1) {
                        bf16_t* d = dst + ((size_t)((row >> 13) * D + col)) * SEQ + (row & (SEQ - 1));
                        d[0 * (size_t)SEQ] = (bf16_t)(w.x & 0xffff); d[1 * (size_t)SEQ] = (bf16_t)(w.x >> 16); d[2 * (size_t)SEQ] = (bf16_t)(w.y & 0xffff); d[3 * (size_t)SEQ] = (bf16_t)(w.y >> 16);
                        d[4 * (size_t)SEQ] = (bf16_t)(w.z & 0xffff); d[5 * (size_t)SEQ] = (bf16_t)(w.z >> 16); d[6 * (size_t)SEQ] = (bf16_t)(w.w & 0xffff); d[7 * (size_t)SEQ] = (bf16_t)(w.w >> 16);
                    } else {
                        *(u32x4*)(dst + (size_t)row * D + col) = w;
                    }
                }
            }
    }
};
struct EpiRes {
    static constexpr bool PERM = false, AFTER_DRAIN = false;
    float* C; const float* R; int ldc;
    __device__ __forceinline__ void operator()(const f32x4 (&acc)[2][2][4][2], const pg8::Unit& u, int wr, int wc, int fr, int fq) const {
        const int row0 = u.pm * 256 + wr * 64 + fr, col0 = u.pn * 256 + wc * 32 + 4 * fq;
#pragma unroll
        for (int ai = 0; ai < 2; ++ai)
#pragma unroll
            for (int m = 0; m < 4; ++m) {
                const size_t off = (size_t)(row0 + ai * 128 + m * 16) * ldc + col0;
#pragma unroll
                for (int bj = 0; bj < 2; ++bj)
#pragma unroll
                    for (int n = 0; n < 2; ++n) { const f32x4 r = *(const f32x4*)(R + off + bj * 128 + n * 16); *(f32x4*)(C + off + bj * 128 + n * 16) = acc[ai][bj][m][n] + r; }
            }
    }
};
struct EpiB {
    static constexpr bool PERM = true, AFTER_DRAIN = false;
    bf16_t* O; int ldc;
    __device__ __forceinline__ void operator()(const f32x4 (&acc)[2][2][4][2], const pg8::Unit& u, int wr, int wc, int fr, int fq) const {
        const int row0 = u.pm * 256 + wr * 64 + fr, col0 = u.pn * 256 + wc * 32 + 8 * fq;
#pragma unroll
        for (int ai = 0; ai < 2; ++ai)
#pragma unroll
            for (int m = 0; m < 4; ++m) {
                bf16_t* rowp = O + (size_t)(row0 + ai * 128 + m * 16) * ldc + col0;
#pragma unroll
                for (int bj = 0; bj < 2; ++bj) {
                    u32x4 w; w.x = cvt_pk_bf16(acc[ai][bj][m][0][0], acc[ai][bj][m][0][1]); w.y = cvt_pk_bf16(acc[ai][bj][m][0][2], acc[ai][bj][m][0][3]);
                    w.z = cvt_pk_bf16(acc[ai][bj][m][1][0], acc[ai][bj][m][1][1]); w.w = cvt_pk_bf16(acc[ai][bj][m][1][2], acc[ai][bj][m][1][3]);
                    *(u32x4*)(rowp + bj * 128) = w;
                }
            }
    }
};
struct RotOrder : pg8::StaticOrder {
    int rot;
    __device__ __forceinline__ bool next(int i, pg8::Unit& u) const { const bool ok = pg8::StaticOrder::next(i, u); if (ok) { u.pn += rot; if (u.pn >= nN) u.pn -= nN; } return ok; }
};
template <class Epi> __device__ __forceinline__ void run_gemm_rot(unsigned char* shm, const bf16_t* A, const bf16_t* Bt, int M, int N, int K, const Epi& E) {
    pg8::Gemm g{A, Bt, M, N, K};
    RotOrder S; S.init(M, N, (int)gridDim.x, (int)blockIdx.x); S.rot = ((int)blockIdx.x & 7) * (N / 256 / 8);
    pg8::gemm_phase<Epi, RotOrder, false>((PG8_LAS unsigned char*)shm, g, S, E, nullptr);
}
template <class Epi> __device__ __forceinline__ void run_gemm(unsigned char* shm, const bf16_t* A, const bf16_t* Bt, int M, int N, int K, const Epi& E) {
    pg8::Gemm g{A, Bt, M, N, K};
    pg8::StaticOrder S; S.init(M, N, (int)gridDim.x, (int)blockIdx.x);
    pg8::gemm_phase<Epi, pg8::StaticOrder, false>((PG8_LAS unsigned char*)shm, g, S, E, nullptr);
}

__device__ __forceinline__ void phase2a(const Params& p, unsigned char* shm) {
    int tid_ = threadIdx.x; asm volatile("" : "+v"(tid_)); const int tid = tid_, lane = tid & 63, wave = tid >> 6;
    const bf16_t* AQK = (const bf16_t*)(p.ws + WS_AQK);
    bf16_t* Q2 = (bf16_t*)((unsigned char*)p.out + DO_Q2); bf16_t* K2 = (bf16_t*)((unsigned char*)p.out + DO_K2); bf16_t* KT = (bf16_t*)(p.ws + WS_KT);
    bf16_t* tl = (bf16_t*)shm;
    const int nwc = gridDim.x >> 5, cgp = blockIdx.x & 31, oct = tid & 7, rg = tid >> 3, c0 = 64 * cgp + 8 * oct;
    float w[4][8], bias[8];
#pragma unroll
    for (int j = 0; j < 4; ++j) { const f32x4 a = *(const f32x4*)(p.qk_conv_w + j * D + c0), b = *(const f32x4*)(p.qk_conv_w + j * D + c0 + 4);
        w[j][0] = a.x; w[j][1] = a.y; w[j][2] = a.z; w[j][3] = a.w; w[j][4] = b.x; w[j][5] = b.y; w[j][6] = b.z; w[j][7] = b.w; }
    { const f32x4 a = *(const f32x4*)(p.qk_conv_b + c0), b = *(const f32x4*)(p.qk_conv_b + c0 + 4);
      bias[0] = a.x; bias[1] = a.y; bias[2] = a.z; bias[3] = a.w; bias[4] = b.x; bias[5] = b.y; bias[6] = b.z; bias[7] = b.w; }
    for (int ch = (int)(blockIdx.x >> 5); ch < 256 && (int)(blockIdx.x >> 5) < nwc; ch += nwc) {
        const int t0 = ch * 128;
        float in[5][8];
        const int rl0 = 2 * rg;
#pragma unroll
        for (int k = 0; k < 5; ++k) {
            const int rl = rl0 - 3 + k; const int sp = (t0 & (SEQ - 1)) + rl;
            if (sp >= 0) { const u32x4 u = *(const u32x4*)(AQK + (size_t)(t0 + rl) * D + c0); unpack8(u, in[k]); }
            else {
#pragma unroll
                for (int e = 0; e < 8; ++e) in[k][e] = 0.f; }
        }
        const bool isq = cgp < 16;
#pragma unroll
        for (int rr = 0; rr < 2; ++rr) {
            float y[8];
#pragma unroll
            for (int e = 0; e < 8; ++e) { float a = bias[e]; a += w[0][e] * in[rr][e]; a += w[1][e] * in[rr + 1][e]; a += w[2][e] * in[rr + 2][e]; a += w[3][e] * in[rr + 3][e];
                a = a * fsig(a); y[e] = isq ? a * 0.0625f : a; }
            const u32x4 o = pack8(y);
            const size_t row = (size_t)(t0 + rl0 + rr);
            if (isq) *(u32x4*)(Q2 + row * 1024 + c0) = o;
            else {
                *(u32x4*)(K2 + row * 1024 + (c0 - 1024)) = o;
            }
        }
    }
    {
        bf16_t* BQ = (bf16_t*)(p.ws + WS_BQ); bf16_t* BK = (bf16_t*)(p.ws + WS_BK);
        const int e16 = lane & 15, sub = lane >> 4;
        const float qs = 0.08838834764831845f * LOG2E;
        const f32x4 gq0 = *(const f32x4*)(p.q_norm_g + 8 * e16), gq1 = *(const f32x4*)(p.q_norm_g + 8 * e16 + 4);
        const f32x4 gk0 = *(const f32x4*)(p.k_norm_g + 8 * e16), gk1 = *(const f32x4*)(p.k_norm_g + 8 * e16 + 4);
        const int gwv = blockIdx.x * 8 + wave, ngw = gridDim.x * 8;
        for (int it = gwv; it < T * 16 / 4; it += ngw) {
            const int gid = it * 4 + sub, t = gid >> 4, grp = 16 + (gid & 15);
            const bool isq = false;
            bf16_t* ptr = (isq ? BQ : BK) + (size_t)t * D + 128 * (grp & 15) + 8 * e16;
            float f[8]; unpack8(*(const u32x4*)ptr, f);
            float ss = 0.f;
#pragma unroll
            for (int e = 0; e < 8; ++e) ss += f[e] * f[e];
            ss += __shfl_xor(ss, 1); ss += __shfl_xor(ss, 2); ss += __shfl_xor(ss, 4); ss += __shfl_xor(ss, 8);
            const float rinv = rsqrtf(ss * (1.f / 128.f) + EPS) * (isq ? qs : 1.f);
            const f32x4 g0 = isq ? gq0 : gk0, g1 = isq ? gq1 : gk1;
            f[0] *= rinv * g0.x; f[1] *= rinv * g0.y; f[2] *= rinv * g0.z; f[3] *= rinv * g0.w; f[4] *= rinv * g1.x; f[5] *= rinv * g1.y; f[6] *= rinv * g1.z; f[7] *= rinv * g1.w;
            *(u32x4*)ptr = pack8(f);
        }
    }
}

constexpr int ML_KL = 0, ML_CT = 67584, ML_VT = 101376, ML_A = 118784, ML_MM = 119296, ML_BB = 119808, ML_WS = 120320, ML_N = 120832, ML_MISC = 121856;
typedef short s16x4 __attribute__((ext_vector_type(4)));
#define ML_SB __builtin_amdgcn_sched_barrier(0)
#define ML_MFMA(a_, b_, c_) __builtin_amdgcn_mfma_f32_16x16x32_bf16(a_, b_, c_, 0, 0, 0)
__device__ __forceinline__ void ml_chain2(const unsigned char* baseA, const unsigned char* baseB, const bf16x8 (&qf)[8], f32x4& SA, f32x4& SB) {
    bf16x8 f0 = *(const bf16x8*)(baseA), f1 = *(const bf16x8*)(baseB), f2 = *(const bf16x8*)(baseA + 16), f3 = *(const bf16x8*)(baseB + 16);
    ML_SB;
#pragma unroll
    for (int ks = 0; ks < 8; ks += 2) {
        SA = ML_MFMA(f0, qf[ks], SA); if (ks + 2 < 8) f0 = *(const bf16x8*)(baseA + 16 * (ks + 2)); ML_SB;
        SB = ML_MFMA(f1, qf[ks], SB); if (ks + 2 < 8) f1 = *(const bf16x8*)(baseB + 16 * (ks + 2)); ML_SB;
        SA = ML_MFMA(f2, qf[ks + 1], SA); if (ks + 3 < 8) f2 = *(const bf16x8*)(baseA + 16 * (ks + 3)); ML_SB;
        SB = ML_MFMA(f3, qf[ks + 1], SB); if (ks + 3 < 8) f3 = *(const bf16x8*)(baseB + 16 * (ks + 3)); ML_SB;
    }
}
__device__ __forceinline__ void mlstm_item(const Params& p, unsigned char* shm, int item) {
    int tid_ = threadIdx.x; asm volatile("" : "+v"(tid_)); const int tid = tid_, lane = tid & 63, w = __builtin_amdgcn_readfirstlane(tid >> 6), l15 = lane & 15, qq = lane >> 4;
    const int sl = item & 7, hA = (item >> 3) & 3, b = item >> 5;
    const int wq = w < 4 ? w : 11 - w;
    const bf16_t* Q2 = (const bf16_t*)((const unsigned char*)p.out + DO_Q2); const bf16_t* K2 = (const bf16_t*)((const unsigned char*)p.out + DO_K2);
    const bf16_t* VTM = (const bf16_t*)(p.ws + WS_VTM); const float* GIF = (const float*)(p.ws + WS_GIF);
    bf16_t* HM = (bf16_t*)(p.ws + WS_HM);
    float* sA = (float*)(shm + ML_A); float* sMM = (float*)(shm + ML_MM); float* sBB = (float*)(shm + ML_BB); float* sWS = (float*)(shm + ML_WS); float* sN = (float*)(shm + ML_N); float* sMisc = (float*)(shm + ML_MISC);
    f32x4 Cacc[2][4], Nacc[2];
#pragma unroll
    for (int a = 0; a < 2; ++a) { Nacc[a] = (f32x4){0.f, 0.f, 0.f, 0.f};
#pragma unroll
        for (int c = 0; c < 4; ++c) Cacc[a][c] = (f32x4){0.f, 0.f, 0.f, 0.f}; }
    float m_st = 0.f;
    const bf16_t* vtrow0 = VTM + ((size_t)((b * 4 + hA) * 512 + 64 * sl)) * SEQ;
    const size_t tb = (size_t)b * SEQ;
    u32x4 stK[8], stV[2]; float gli0 = 0.f, gli1 = 0.f, glf0 = 0.f, glf1 = 0.f; bf16x8 qf[8];
    const int krow_s = tid >> 2, kpart = tid & 3, vdv = tid >> 3, vpart = tid & 7;
#define ML_LOAD_STAGE(c_) do { const size_t t0_ = tb + 128 * (c_); \
        { const bf16_t* src = K2 + (t0_ + krow_s) * 1024 + hA * 256 + kpart * 64; _Pragma("unroll") for (int e = 0; e < 8; ++e) stK[e] = *(const u32x4*)(src + 8 * e); } \
        { const bf16_t* src = vtrow0 + (size_t)vdv * SEQ + 128 * (c_) + vpart * 16; stV[0] = *(const u32x4*)src; stV[1] = *(const u32x4*)(src + 8); } \
        if (w == 0) { gli0 = GIF[(t0_ + 2 * lane) * 8 + hA]; gli1 = GIF[(t0_ + 2 * lane + 1) * 8 + hA]; glf0 = GIF[(t0_ + 2 * lane) * 8 + 4 + hA]; glf1 = GIF[(t0_ + 2 * lane + 1) * 8 + 4 + hA]; } } while (0)
#define ML_LOAD_Q(c_) do { const bf16_t* qp = Q2 + (tb + 128 * (c_) + 16 * wq + l15) * 1024 + hA * 256 + 64 * qq; _Pragma("unroll") for (int ks = 0; ks < 8; ++ks) qf[ks] = *(const bf16x8*)(qp + 8 * ks); } while (0)
#define ML_WRITE_STAGE() do { \
        { unsigned char* dst = shm + ML_KL + krow_s * 528 + kpart * 128; _Pragma("unroll") for (int e = 0; e < 8; ++e) *(u32x4*)(dst + 16 * e) = stK[e]; } \
        { unsigned char* dst = shm + ML_VT + vdv * 272 + vpart * 32; *(u32x4*)dst = stV[0]; *(u32x4*)(dst + 16) = stV[1]; } \
        _Pragma("unroll") for (int dkb = 0; dkb < 2; ++dkb) { \
            _Pragma("unroll") for (int dvb = 0; dvb < 4; ++dvb) { u32x2 o; o.x = cvt_pk_bf16(Cacc[dkb][dvb][0], Cacc[dkb][dvb][1]); o.y = cvt_pk_bf16(Cacc[dkb][dvb][2], Cacc[dkb][dvb][3]); \
                *(u32x2*)(shm + ML_CT + (16 * dvb + l15) * 528 + (32 * w + 16 * dkb + 4 * qq) * 2) = o; } \
            if (l15 == 0) *(f32x4*)(sN + 32 * w + 16 * dkb + 4 * qq) = Nacc[dkb]; } \
        if (w == 0) { \
            float cs = glf0 + glf1; \
            _Pragma("unroll") for (int o = 1; o < 64; o <<= 1) { const float v = __shfl_up(cs, o); if (lane >= o) cs += v; } \
            const float b1 = cs, b0 = cs - glf1; const float a0 = gli0 - b0, a1 = gli1 - b1; \
            float pmx = fmaxf(a0, a1); \
            _Pragma("unroll") for (int o = 1; o < 64; o <<= 1) { const float v = __shfl_up(pmx, o); if (lane >= o) pmx = fmaxf(pmx, v); } \
            float ex = __shfl_up(pmx, 1); if (lane == 0) ex = -3.0e38f; \
            const float pm0 = fmaxf(ex, a0), pm1 = pmx; const float mm0 = fmaxf(pm0, m_st), mm1 = fmaxf(pm1, m_st); \
            const float mml = __shfl(mm1, 63), bl = __shfl(b1, 63); \
            sA[2 * lane] = a0; sA[2 * lane + 1] = a1; sMM[2 * lane] = mm0; sMM[2 * lane + 1] = mm1; sBB[2 * lane] = b0; sBB[2 * lane + 1] = b1; \
            sWS[2 * lane] = __expf(a0 - mml); sWS[2 * lane + 1] = __expf(a1 - mml); \
            if (lane == 0) { sMisc[0] = bl; sMisc[1] = mml; } } } while (0)
    ML_LOAD_STAGE(0); ML_LOAD_Q(0);
    ML_WRITE_STAGE();
    for (int c = 0; c < 64; ++c) {
        __syncthreads();
        if (c + 1 < 64) ML_LOAD_STAGE(c + 1);
        const size_t t0 = tb + 128 * c;
        const int tl = 16 * wq + l15;
        const float mm_t = sMM[tl], b_t = sBB[tl], gi = __expf(m_st - mm_t);
        bf16x8 pf[4]; float den = 0.f;
#pragma unroll
        for (int a = 0; a < 4; ++a) {
            pf[a] = (bf16x8){0, 0, 0, 0, 0, 0, 0, 0};
            if (2 * a <= wq) {
                f32x4 S0 = (f32x4){0.f, 0.f, 0.f, 0.f}, S1 = (f32x4){0.f, 0.f, 0.f, 0.f};
                const unsigned char* kp = shm + ML_KL + (32 * a + 8 * (l15 >> 2) + (l15 & 3)) * 528 + 128 * qq;
                ml_chain2(kp, kp + 4 * 528, qf, S0, S1);
                const int key0 = 32 * a + 8 * qq;
                const f32x4 av0 = *(const f32x4*)(sA + key0), av1 = *(const f32x4*)(sA + key0 + 4);
                float pv[8];
#pragma unroll
                for (int i = 0; i < 4; ++i) { pv[i] = (key0 + i <= tl) ? S0[i] * __expf(av0[i] - mm_t) : 0.f; pv[4 + i] = (key0 + 4 + i <= tl) ? S1[i] * __expf(av1[i] - mm_t) : 0.f; den += pv[i] + pv[4 + i]; }
                pf[a] = __builtin_bit_cast(bf16x8, pack8(pv));
            }
        }
        den += __shfl_xor(den, 16); den += __shfl_xor(den, 32);
        f32x4 num[4];
        { const unsigned char* cp = shm + ML_CT + l15 * 528 + 128 * qq;
          f32x4 n0 = (f32x4){0.f, 0.f, 0.f, 0.f}, n1 = n0, n2 = n0, n3 = n0;
          ml_chain2(cp, cp + 16 * 528, qf, n0, n1); ml_chain2(cp + 32 * 528, cp + 48 * 528, qf, n2, n3);
          num[0] = n0 * gi; num[1] = n1 * gi; num[2] = n2 * gi; num[3] = n3 * gi; }
        float qn = 0.f;
#pragma unroll
        for (int ks = 0; ks < 8; ++ks) {
            float qv[8]; unpack8(__builtin_bit_cast(u32x4, qf[ks]), qv);
            const f32x4 n0 = *(const f32x4*)(sN + 64 * qq + 8 * ks), n1 = *(const f32x4*)(sN + 64 * qq + 8 * ks + 4);
            qn += (qv[0] * n0.x + qv[1] * n0.y) + (qv[2] * n0.z + qv[3] * n0.w) + (qv[4] * n1.x + qv[5] * n1.y) + (qv[6] * n1.z + qv[7] * n1.w);
        }
        qn += __shfl_xor(qn, 16); qn += __shfl_xor(qn, 32);
        den += gi * qn;
        ML_SB;
        if (c + 1 < 64) ML_LOAD_Q(c + 1);
        ML_SB;
#pragma unroll
        for (int a = 0; a < 4; ++a) {
            if (2 * a <= wq) {
                const unsigned char* vp = shm + ML_VT + l15 * 272 + (32 * a + 8 * qq) * 2;
                const bf16x8 v0 = *(const bf16x8*)(vp), v1 = *(const bf16x8*)(vp + 16 * 272), v2 = *(const bf16x8*)(vp + 32 * 272), v3 = *(const bf16x8*)(vp + 48 * 272);
                ML_SB;
                num[0] = ML_MFMA(v0, pf[a], num[0]); num[1] = ML_MFMA(v1, pf[a], num[1]); num[2] = ML_MFMA(v2, pf[a], num[2]); num[3] = ML_MFMA(v3, pf[a], num[3]);
            }
        }
        { const float dn = __builtin_amdgcn_rcpf(fmaxf(fabsf(den), __expf(-(b_t + mm_t))));
          bf16_t* hp = HM + (t0 + tl) * D + hA * 512 + 64 * sl + 4 * qq;
#pragma unroll
          for (int dvb = 0; dvb < 4; ++dvb) { u32x2 o; o.x = cvt_pk_bf16(num[dvb][0] * dn, num[dvb][1] * dn); o.y = cvt_pk_bf16(num[dvb][2] * dn, num[dvb][3] * dn); *(u32x2*)(hp + 16 * dvb) = o; } }
        const float b_last = sMisc[0], mm_last = sMisc[1], decay = __expf(m_st - mm_last);
#pragma unroll
        for (int dkb = 0; dkb < 2; ++dkb) { Nacc[dkb] = Nacc[dkb] * decay;
#pragma unroll
            for (int dvb = 0; dvb < 4; ++dvb) Cacc[dkb][dvb] = Cacc[dkb][dvb] * decay; }
#pragma unroll
        for (int a = 0; a < 4; ++a) {
            const f32x4 w0 = *(const f32x4*)(sWS + 32 * a + 8 * qq), w1 = *(const f32x4*)(sWS + 32 * a + 8 * qq + 4);
            const unsigned char* tp = shm + ML_KL + (32 * a + 8 * qq + (l15 >> 2)) * 528 + (32 * w + 4 * (l15 & 3)) * 2;
            const s16x4 t00 = __builtin_amdgcn_ds_read_tr16_b64_v4i16((PG8_LAS s16x4*)(tp)), t01 = __builtin_amdgcn_ds_read_tr16_b64_v4i16((PG8_LAS s16x4*)(tp + 4 * 528));
            const s16x4 t10 = __builtin_amdgcn_ds_read_tr16_b64_v4i16((PG8_LAS s16x4*)(tp + 32)), t11 = __builtin_amdgcn_ds_read_tr16_b64_v4i16((PG8_LAS s16x4*)(tp + 32 + 4 * 528));
            const unsigned char* vp = shm + ML_VT + l15 * 272 + (32 * a + 8 * qq) * 2;
            const u32x4 r0 = *(const u32x4*)(vp), r1 = *(const u32x4*)(vp + 16 * 272), r2 = *(const u32x4*)(vp + 32 * 272), r3 = *(const u32x4*)(vp + 48 * 272);
            ML_SB;
            bf16x8 kt0, kt1;
            kt0[0] = t00[0]; kt0[1] = t00[1]; kt0[2] = t00[2]; kt0[3] = t00[3]; kt0[4] = t01[0]; kt0[5] = t01[1]; kt0[6] = t01[2]; kt0[7] = t01[3];
            kt1[0] = t10[0]; kt1[1] = t10[1]; kt1[2] = t10[2]; kt1[3] = t10[3]; kt1[4] = t11[0]; kt1[5] = t11[1]; kt1[6] = t11[2]; kt1[7] = t11[3];
            float wsv[8] = {w0.x, w0.y, w0.z, w0.w, w1.x, w1.y, w1.z, w1.w};
            float zf[8];
#pragma unroll
            for (int e = 0; e < 8; ++e) zf[e] = (l15 == 0) ? wsv[e] : 0.f;
            const bf16x8 wsf = __builtin_bit_cast(bf16x8, pack8(zf));
            Nacc[0] = ML_MFMA(kt0, wsf, Nacc[0]); Nacc[1] = ML_MFMA(kt1, wsf, Nacc[1]);
            const u32x4 rr[4] = {r0, r1, r2, r3};
#pragma unroll
            for (int dvb = 0; dvb < 4; ++dvb) {
                float vv[8]; unpack8(rr[dvb], vv);
#pragma unroll
                for (int e = 0; e < 8; ++e) vv[e] *= wsv[e];
                const bf16x8 wv = __builtin_bit_cast(bf16x8, pack8(vv));
                Cacc[0][dvb] = ML_MFMA(kt0, wv, Cacc[0][dvb]); Cacc[1][dvb] = ML_MFMA(kt1, wv, Cacc[1][dvb]);
            }
        }
        m_st = b_last + mm_last;
        __syncthreads();
        if (c + 1 < 64) ML_WRITE_STAGE();
    }
#undef ML_LOAD_STAGE
#undef ML_LOAD_Q
#undef ML_WRITE_STAGE
}
#undef ML_SB
#undef ML_MFMA

constexpr int AT_V = 16384, AT_BUF = 32768;
__device__ __forceinline__ void attn_item(const Params& p, unsigned char* shm, int b, int h, int qb, float lam, float M2) {
    int tid_ = threadIdx.x; asm volatile("" : "+v"(tid_)); const int tid = tid_, lane = tid & 63, wave = __builtin_amdgcn_readfirstlane(tid >> 6), c = wave & 1, g = wave >> 1, r = lane & 31, hh = lane >> 5;
    const bf16_t* BQ = (const bf16_t*)(p.ws + WS_BQ); const bf16_t* BK = (const bf16_t*)(p.ws + WS_BK); const bf16_t* VTD = (const bf16_t*)(p.ws + WS_VTD); const bf16_t* GB = (const bf16_t*)(p.ws + WS_GB);
    bf16_t* YB = (bf16_t*)((unsigned char*)p.out + DO_YB);
    float* cmb = (float*)shm;
    const int tq = qb * 128 + 32 * g + r; const size_t rowq = (size_t)b * SEQ + tq;
    bf16x8 qf[8];
    { const bf16_t* qp = BQ + rowq * D + h * 256 + c * 128 + 64 * hh;
#pragma unroll
      for (int ks = 0; ks < 8; ++ks) qf[ks] = *(const bf16x8*)(qp + 8 * ks); }
    {
        float ss = 0.f;
#pragma unroll
        for (int ks = 0; ks < 8; ++ks) { float v[8]; unpack8(__builtin_bit_cast(u32x4, qf[ks]), v);
#pragma unroll
            for (int e = 0; e < 8; ++e) ss += v[e] * v[e]; }
        ss += __shfl_xor(ss, 32);
        const float rq = rsqrtf(ss * (1.f / 128.f) + EPS) * (0.08838834764831845f * LOG2E);
#pragma unroll
        for (int ks = 0; ks < 8; ++ks) { float v[8]; unpack8(__builtin_bit_cast(u32x4, qf[ks]), v);
            const f32x4 g0 = *(const f32x4*)(p.q_norm_g + 64 * hh + 8 * ks), g1 = *(const f32x4*)(p.q_norm_g + 64 * hh + 8 * ks + 4);
            v[0] *= rq * g0.x; v[1] *= rq * g0.y; v[2] *= rq * g0.z; v[3] *= rq * g0.w; v[4] *= rq * g1.x; v[5] *= rq * g1.y; v[6] *= rq * g1.z; v[7] *= rq * g1.w;
            qf[ks] = __builtin_bit_cast(bf16x8, pack8(v)); }
    }
    f32x16 O[8];
#pragma unroll
    for (int db = 0; db < 8; ++db)
#pragma unroll
        for (int i = 0; i < 16; ++i) O[db][i] = 0.f;
    float lsum = 0.f;
    const float slope2 = exp2f(-(float)(h + 1)) * LOG2E;
    const int ntile_w = qb * 4 + g + 1, ntile = qb * 4 + 4;
    int kt0 = (int)ceilf(((float)(qb * 128 - 31) - (150.f + 2.f * M2) / slope2) * (1.f / 32.f)); kt0 = kt0 < 0 ? 0 : kt0;
    const int keyperm = (r & 19) | ((r & 4) << 1) | ((r & 8) >> 1);
    const char* kgb = (const char*)(BK + ((size_t)b * SEQ) * D + h * 256);
    const char* vgb = (const char*)(VTD + ((size_t)(b * 8 + h) * 256) * 8192);
#define AT_ISSUE(kt_, dst_) do { const char* kb_ = kgb + (size_t)(32 * (kt_)) * (D * 2); const char* vb_ = vgb + (size_t)(kt_) * 16384; \
        int ln_ = lane; asm volatile("" : "+v"(ln_)); unsigned kgo[2], vgo[2];   \
        _Pragma("unroll") for (int j = 0; j < 2; ++j) { const int R = 8 * wave + 4 * j + (ln_ >> 4); kgo[j] = (unsigned)((R & 31) * D + (R >> 5) * 128 + 8 * ((ln_ & 15) ^ (R & 15))) * 2u; \
            const int dv = 32 * wave + 16 * j + (ln_ >> 2); vgo[j] = (unsigned)(dv * 32 + 8 * ((ln_ & 3) ^ ((dv >> 2) & 3))) * 2u; } \
        _Pragma("unroll") for (int j = 0; j < 2; ++j) __builtin_amdgcn_global_load_lds((const unsigned*)(kb_ + kgo[j]), (PG8_LAS unsigned*)((dst_) + (2 * wave + j) * 1024), 16, 0, 0); \
        _Pragma("unroll") for (int j = 0; j < 2; ++j) __builtin_amdgcn_global_load_lds((const unsigned*)(vb_ + vgo[j]), (PG8_LAS unsigned*)((dst_) + AT_V + (2 * wave + j) * 1024), 16, 0, 0); } while (0)
    const int krow = (c * 32 + keyperm) * 256, kx = keyperm & 15;
    const int vrow = AT_V + r * 64, vf_ = hh ^ ((r >> 2) & 3);
    __syncthreads();
    const int kt0e = kt0 & ~1, n64 = (ntile - kt0e) >> 1;
    AT_ISSUE(kt0e, shm); AT_ISSUE(kt0e + 1, shm + AT_BUF);
    asm volatile("s_waitcnt vmcnt(0)" ::: "memory");
    __builtin_amdgcn_s_barrier(); asm volatile("" ::: "memory");
    for (int it = 0; it < n64; ++it) {
      unsigned char* slot = shm + (it & 1) * (2 * AT_BUF);
      if (it + 1 < n64) { unsigned char* ns = shm + ((it & 1) ^ 1) * (2 * AT_BUF); AT_ISSUE(kt0e + 2 * it + 2, ns); AT_ISSUE(kt0e + 2 * it + 3, ns + AT_BUF); }
#pragma unroll
      for (int u = 0; u < 2; ++u) {
        const int kt = kt0e + 2 * it + u;
        const int s0 = 32 * kt;
        unsigned char* buf = slot + u * AT_BUF;
        if (kt < ntile_w) {
#define AT_KF(ks_) (*(const bf16x8*)(buf + krow + 16 * ((8 * hh + (ks_)) ^ kx)))
#define AT_VF(i_) (*(const bf16x8*)(buf + vrow + ((i_) & 7) * 2048 + 16 * ((2 * ((i_) >> 3)) ^ vf_)))
#define AT_SB __builtin_amdgcn_sched_barrier(0)
            const float base = slope2 * (float)(s0 + 8 * hh - tq) - M2;
            f32x16 S;
#pragma unroll
            for (int i = 0; i < 16; ++i) S[i] = fmaf(slope2, (float)((i & 3) + 4 * ((i >> 2) & 1) + 16 * (i >> 3)), base);
            bf16x8 f0 = AT_KF(0), f1 = AT_KF(1), f2 = AT_KF(2), f3 = AT_KF(3);
            AT_SB;
            S = __builtin_amdgcn_mfma_f32_32x32x16_bf16(f0, qf[0], S, 0, 0, 0); f0 = AT_KF(4); AT_SB;
            S = __builtin_amdgcn_mfma_f32_32x32x16_bf16(f1, qf[1], S, 0, 0, 0); f1 = AT_KF(5); AT_SB;
            S = __builtin_amdgcn_mfma_f32_32x32x16_bf16(f2, qf[2], S, 0, 0, 0); f2 = AT_KF(6); AT_SB;
            S = __builtin_amdgcn_mfma_f32_32x32x16_bf16(f3, qf[3], S, 0, 0, 0); f3 = AT_KF(7); AT_SB;
            S = __builtin_amdgcn_mfma_f32_32x32x16_bf16(f0, qf[4], S, 0, 0, 0); f0 = AT_VF(0); AT_SB;
            S = __builtin_amdgcn_mfma_f32_32x32x16_bf16(f1, qf[5], S, 0, 0, 0); f1 = AT_VF(1); AT_SB;
            S = __builtin_amdgcn_mfma_f32_32x32x16_bf16(f2, qf[6], S, 0, 0, 0); f2 = AT_VF(2); AT_SB;
            S = __builtin_amdgcn_mfma_f32_32x32x16_bf16(f3, qf[7], S, 0, 0, 0); f3 = AT_VF(3); AT_SB;
            float pv[16];
#pragma unroll
            for (int i = 0; i < 16; ++i) pv[i] = __builtin_amdgcn_exp2f(S[i]);
            if (kt == ntile_w - 1) {
#pragma unroll
                for (int i = 0; i < 16; ++i) { const int key = s0 + (i & 3) + 4 * ((i >> 2) & 1) + 8 * hh + 16 * (i >> 3); pv[i] = (key <= tq) ? pv[i] : 0.f; }
            }
#pragma unroll
            for (int i = 0; i < 16; ++i) lsum += pv[i];
            bf16x8 pf[2];
#pragma unroll
            for (int k2 = 0; k2 < 2; ++k2) { u32x4 u; u.x = cvt_pk_bf16(pv[8 * k2 + 0], pv[8 * k2 + 1]); u.y = cvt_pk_bf16(pv[8 * k2 + 2], pv[8 * k2 + 3]); u.z = cvt_pk_bf16(pv[8 * k2 + 4], pv[8 * k2 + 5]); u.w = cvt_pk_bf16(pv[8 * k2 + 6], pv[8 * k2 + 7]);
                pf[k2] = __builtin_bit_cast(bf16x8, u); }
            AT_SB;
#define AT_PV(i_, f_) do { O[(i_) & 7] = __builtin_amdgcn_mfma_f32_32x32x16_bf16(f_, pf[(i_) >> 3], O[(i_) & 7], 0, 0, 0); if ((i_) + 4 < 16) f_ = AT_VF((i_) + 4); AT_SB; } while (0)
            AT_PV(0, f0); AT_PV(1, f1); AT_PV(2, f2); AT_PV(3, f3); AT_PV(4, f0); AT_PV(5, f1); AT_PV(6, f2); AT_PV(7, f3);
            AT_PV(8, f0); AT_PV(9, f1); AT_PV(10, f2); AT_PV(11, f3); AT_PV(12, f0); AT_PV(13, f1); AT_PV(14, f2); AT_PV(15, f3);
#undef AT_PV
#undef AT_KF
#undef AT_VF
#undef AT_SB
        }
      }
      asm volatile("s_waitcnt vmcnt(0)" ::: "memory");
      asm volatile("s_waitcnt lgkmcnt(0)" ::: "memory");
      __builtin_amdgcn_s_barrier(); asm volatile("" ::: "memory");
    }
#undef AT_ISSUE
    const float ltot = lsum + __shfl_xor(lsum, 32);
    const float inv = 1.f / ltot;
    if (c == 1) {
#pragma unroll
        for (int db = 0; db < 8; ++db)
#pragma unroll
            for (int i = 0; i < 16; ++i) { const int dv = 32 * db + (i & 3) + 8 * (i >> 2) + 4 * hh; cmb[(g * 256 + dv) * 32 + r] = O[db][i] * inv; }
    }
    __syncthreads();
    if (c == 0) {
        float ss = 0.f;
#pragma unroll
        for (int db = 0; db < 8; ++db)
#pragma unroll
            for (int i = 0; i < 16; ++i) { const int dv = 32 * db + (i & 3) + 8 * (i >> 2) + 4 * hh; const float o = O[db][i] * inv - lam * cmb[(g * 256 + dv) * 32 + r]; O[db][i] = o; ss += o * o; }
        ss += __shfl_xor(ss, 32);
        const float rinv = rsqrtf(ss * (1.f / 256.f) + EPS) * 0.8f;
#pragma unroll
        for (int db = 0; db < 8; ++db)
#pragma unroll
            for (int ig = 0; ig < 4; ++ig) {
                const int dv0 = 32 * db + 8 * ig + 4 * hh; const size_t off = rowq * D + h * 256 + dv0;
                const u32x2 gbu = *(const u32x2*)(GB + off); const f32x4 sg = *(const f32x4*)(p.subln_g + dv0);
                u32x2 o; o.x = cvt_pk_bf16(O[db][4 * ig + 0] * rinv * sg.x * bflo(gbu.x), O[db][4 * ig + 1] * rinv * sg.y * bfhi(gbu.x));
                o.y = cvt_pk_bf16(O[db][4 * ig + 2] * rinv * sg.z * bflo(gbu.y), O[db][4 * ig + 3] * rinv * sg.w * bfhi(gbu.y));
                *(u32x2*)(YB + off) = o;
            }
    }
}

__device__ __forceinline__ void phase2b(const Params& p, unsigned char* shm, int rep) {
    int tid_ = threadIdx.x; asm volatile("" : "+v"(tid_)); const int tid = tid_, lane = tid & 63;
    if (blockIdx.x < 128) { const int xcd = blockIdx.x & 7, idx = blockIdx.x >> 3; mlstm_item(p, shm, (xcd * 2 + (idx >> 3)) * 8 + (idx & 7)); }
    float lam, M2;
    { const float a0 = p.diff_lambda[lane] * p.diff_lambda[128 + lane] + p.diff_lambda[64 + lane] * p.diff_lambda[192 + lane];
      const float a1 = p.diff_lambda[256 + lane] * p.diff_lambda[384 + lane] + p.diff_lambda[320 + lane] * p.diff_lambda[448 + lane];
      lam = expf(wave_sum(a0)) - expf(wave_sum(a1)) + 0.2f;
      float mq = fmaxf(fabsf(p.q_norm_g[lane]), fabsf(p.q_norm_g[64 + lane])), mk = fmaxf(fabsf(p.k_norm_g[lane]), fabsf(p.k_norm_g[64 + lane]));
#pragma unroll
      for (int o = 1; o < 64; o <<= 1) { mq = fmaxf(mq, __shfl_xor(mq, o)); mk = fmaxf(mk, __shfl_xor(mk, o)); }
      M2 = 128.f * mq * mk * 0.08838834764831845f * LOG2E * 1.02f;
      lam = __uint_as_float(__builtin_amdgcn_readfirstlane(__float_as_uint(lam))); M2 = __uint_as_float(__builtin_amdgcn_readfirstlane(__float_as_uint(M2))); }
    unsigned* ctr = (unsigned*)(p.ws + WS_CTL) + 128 * rep;
    int* sItem = (int*)(shm + 147456 - 64);
    const int myx = blockIdx.x & 7;
    for (;;) {
        __syncthreads();
        if (tid == 0) { int it = -1;
            for (int k = 0; k < 8; ++k) { const int q = (myx + k) & 7; const unsigned v = atomicAdd(ctr + 16 * q, 1u); if (v < 256u) { it = q * 256 + (int)v; break; } }
            *sItem = it; }
        __syncthreads();
        const int item = *sItem;
        if (item < 0) break;
        const int q = item >> 8, v = item & 255, b = v >> 6, qb = 63 - (v & 63);
        const int h = (b == 0) ? q : (b == 1) ? 7 - q : (b == 2) ? ((q + 4) & 7) : ((3 - q) & 7);
        attn_item(p, shm, b, h, qb, lam, M2);
    }
}

__device__ __forceinline__ void phase3(const Params& p, unsigned char* shm) {
    int tid_ = threadIdx.x; asm volatile("" : "+v"(tid_)); const int tid = tid_, lane = tid & 63, wave = tid >> 6, gw = blockIdx.x * 8 + wave, ngw = gridDim.x * 8;
    float* scr = (float*)(shm + wave * 8448);
    transpose_plain(p.w_out, D, D, (bf16_t*)(p.ws + WS_WOUT), scr, gw, ngw, lane);
    { const int nblk = 2 * DFF / 32, nitems = (D / 64) * nblk; bf16_t* WuT = (bf16_t*)(p.ws + WS_WUP);
      for (int it = gw; it < nitems; it += ngw) { const int kb = it / nblk, nb = it % nblk, n = 32 * nb, pt = n >> 8, j = n & 255;
          transpose_item(p.w_up, (size_t)(2 * DFF), D, WuT, 64 * kb, j < 128 ? 128 * pt + j : DFF + 128 * pt + (j - 128), n, scr, lane); } }
    transpose_plain(p.w_down, DFF, D, (bf16_t*)(p.ws + WS_WDN), scr, gw, ngw, lane);
    const bf16_t* HM = (const bf16_t*)(p.ws + WS_HM); const bf16_t* GA = (const bf16_t*)(p.ws + WS_GA); bf16_t* Y = (bf16_t*)(p.ws + WS_BQ); const bf16_t* YBp = (const bf16_t*)((const unsigned char*)p.out + DO_YB);
    const f32x4 mg0 = *(const f32x4*)(p.mlstm_norm_g + (gw & 3) * 512 + 8 * lane), mg1 = *(const f32x4*)(p.mlstm_norm_g + (gw & 3) * 512 + 8 * lane + 4);
    for (int it = gw; it < T * 4; it += ngw) {
        const size_t off = (size_t)(it >> 2) * D + (it & 3) * 512 + 8 * lane;
        float hm[8], ga[8], yb[8]; unpack8(*(const u32x4*)(HM + off), hm); unpack8(*(const u32x4*)(GA + off), ga); unpack8(*(const u32x4*)(YBp + off), yb);
        float ss = 0.f;
#pragma unroll
        for (int e = 0; e < 8; ++e) ss += hm[e] * hm[e];
        const float rinv = rsqrtf(wave_sum(ss) * (1.f / 512.f) + EPS);
        const bool same = (ngw & 3) == 0;
        const f32x4 g0 = same ? mg0 : *(const f32x4*)(p.mlstm_norm_g + (it & 3) * 512 + 8 * lane), g1 = same ? mg1 : *(const f32x4*)(p.mlstm_norm_g + (it & 3) * 512 + 8 * lane + 4);
        float y[8];
        y[0] = ga[0] * hm[0] * rinv * g0.x + yb[0]; y[1] = ga[1] * hm[1] * rinv * g0.y + yb[1]; y[2] = ga[2] * hm[2] * rinv * g0.z + yb[2]; y[3] = ga[3] * hm[3] * rinv * g0.w + yb[3];
        y[4] = ga[4] * hm[4] * rinv * g1.x + yb[4]; y[5] = ga[5] * hm[5] * rinv * g1.y + yb[5]; y[6] = ga[6] * hm[6] * rinv * g1.z + yb[6]; y[7] = ga[7] * hm[7] * rinv * g1.w + yb[7];
        *(u32x4*)(Y + off) = pack8(y);
    }
}
__device__ __forceinline__ void phase5(const Params& p) {
    int tid_ = threadIdx.x; asm volatile("" : "+v"(tid_)); const int tid = tid_, lane = tid & 63, wave = tid >> 6, gw = blockIdx.x * 8 + wave, ngw = gridDim.x * 8;
    bf16_t* H2 = (bf16_t*)(p.ws + WS_H2);
    f32x4 g2r[8];
#pragma unroll
    for (int j = 0; j < 8; ++j) g2r[j] = *((const f32x4*)p.norm2_g + lane + 64 * j);
    for (int row = gw; row < T; row += ngw) {
        const f32x4* xr = (const f32x4*)(p.out + (size_t)row * D) + lane;
        f32x4 v[8]; float ss = 0.f;
#pragma unroll
        for (int j = 0; j < 8; ++j) { v[j] = xr[64 * j]; ss += (v[j].x * v[j].x + v[j].y * v[j].y) + (v[j].z * v[j].z + v[j].w * v[j].w); }
        const float rinv = rsqrtf(wave_sum(ss) * (1.f / D) + EPS);
        u32x2* o8 = (u32x2*)(H2 + (size_t)row * D) + lane;
#pragma unroll
        for (int j = 0; j < 8; ++j) { const f32x4 g = g2r[j];
            u32x2 o; o.x = cvt_pk_bf16(v[j].x * rinv * g.x, v[j].y * rinv * g.y); o.y = cvt_pk_bf16(v[j].z * rinv * g.z, v[j].w * rinv * g.w); o8[64 * j] = o; }
    }
}
__device__ __forceinline__ float dpp_ror1(float v) { return __int_as_float(__builtin_amdgcn_update_dpp(0, __float_as_int(v), 0x121, 0xf, 0xf, false)); }
__device__ __forceinline__ float dpp_ror2(float v) { return __int_as_float(__builtin_amdgcn_update_dpp(0, __float_as_int(v), 0x122, 0xf, 0xf, false)); }
struct EpiUp {
    static constexpr bool PERM = true, AFTER_DRAIN = false;
    bf16_t* act; bf16_t* sb; const float* cw; const float* cb;
    __device__ __forceinline__ void operator()(const f32x4 (&acc)[2][2][4][2], const pg8::Unit& u, int wr, int wc, int fr_in, int fq_in) const {
        int fr = fr_in, fq = fq_in; asm volatile("" : "+v"(fr), "+v"(fq));
        const int row0 = u.pm * 256 + wr * 64 + fr;
#pragma unroll
        for (int n = 0; n < 2; ++n) {
            const int cl = u.pn * 128 + wc * 32 + 8 * fq + 4 * n;
            const f32x4 wg0 = *(const f32x4*)(cw + cl), wg1 = *(const f32x4*)(cw + (size_t)2 * DFF + cl), wg2 = *(const f32x4*)(cw + (size_t)4 * DFF + cl);
            const f32x4 wv0 = *(const f32x4*)(cw + DFF + cl), wv1 = *(const f32x4*)(cw + (size_t)3 * DFF + cl), wv2 = *(const f32x4*)(cw + (size_t)5 * DFF + cl);
            const f32x4 bg = *(const f32x4*)(cb + cl), bv = *(const f32x4*)(cb + DFF + cl);
#pragma unroll
            for (int ai = 0; ai < 2; ++ai) {
#pragma unroll
                for (int m = 0; m < 4; ++m) {
                    const int row = row0 + ai * 128 + m * 16;
                    const f32x4 g = acc[ai][0][m][n], v = acc[ai][1][m][n];
                    const f32x4 gp = acc[ai][0][m > 0 ? m - 1 : 0][n], vp = acc[ai][1][m > 0 ? m - 1 : 0][n];
                    if ((m == 0 && fr < 2) || (m == 3 && fr >= 14)) {
                        const int slot = (m == 0) ? fr : fr - 12;
                        bf16_t* d = sb + ((size_t)(row >> 6) * 4 + slot) * (2 * DFF) + cl;
                        u32x2 og, ov; og.x = cvt_pk_bf16(g[0], g[1]); og.y = cvt_pk_bf16(g[2], g[3]); ov.x = cvt_pk_bf16(v[0], v[1]); ov.y = cvt_pk_bf16(v[2], v[3]);
                        *(u32x2*)d = og; *(u32x2*)(d + DFF) = ov;
                    }
                    f32x4 y;
#pragma unroll
                    for (int e = 0; e < 4; ++e) {
                        const float xg1 = dpp_ror1(fr == 15 ? gp[e] : g[e]), xg2 = dpp_ror2(fr >= 14 ? gp[e] : g[e]);
                        const float xv1 = dpp_ror1(fr == 15 ? vp[e] : v[e]), xv2 = dpp_ror2(fr >= 14 ? vp[e] : v[e]);
                        const float ug = bg[e] + wg0[e] * xg2 + wg1[e] * xg1 + wg2[e] * g[e];
                        const float uv = bv[e] + wv0[e] * xv2 + wv1[e] * xv1 + wv2[e] * v[e];
                        y[e] = ug * fsig(ug) * uv;
                    }
                    if (!(m == 0 && fr < 2)) { u32x2 o; o.x = cvt_pk_bf16(y[0], y[1]); o.y = cvt_pk_bf16(y[2], y[3]); *(u32x2*)(act + (size_t)row * DFF + cl) = o; }
                }
            }
        }
    }
};
__device__ __forceinline__ void phase_fix(const Params& p) {
    const bf16_t* SB = (const bf16_t*)(p.ws + WS_SB); bf16_t* ACT = (bf16_t*)(p.ws + WS_ACT);
    int tid_ = threadIdx.x; asm volatile("" : "+v"(tid_)); const int gt = blockIdx.x * 512 + tid_, ngt = gridDim.x * 512;
    for (int idx = gt; idx < (T / 64) * 704; idx += ngt) {
        const int oct = idx % 704, kb = idx / 704, c0 = 8 * oct, r0 = 64 * kb;
        float wg[3][8], wv[3][8], bg[8], bv[8];
#pragma unroll
        for (int j = 0; j < 3; ++j) {
            const f32x4 a = *(const f32x4*)(p.ffn_conv_w + (size_t)j * 2 * DFF + c0), b = *(const f32x4*)(p.ffn_conv_w + (size_t)j * 2 * DFF + c0 + 4);
            const f32x4 c = *(const f32x4*)(p.ffn_conv_w + (size_t)j * 2 * DFF + DFF + c0), d = *(const f32x4*)(p.ffn_conv_w + (size_t)j * 2 * DFF + DFF + c0 + 4);
            wg[j][0] = a.x; wg[j][1] = a.y; wg[j][2] = a.z; wg[j][3] = a.w; wg[j][4] = b.x; wg[j][5] = b.y; wg[j][6] = b.z; wg[j][7] = b.w;
            wv[j][0] = c.x; wv[j][1] = c.y; wv[j][2] = c.z; wv[j][3] = c.w; wv[j][4] = d.x; wv[j][5] = d.y; wv[j][6] = d.z; wv[j][7] = d.w;
        }
        { const f32x4 a = *(const f32x4*)(p.ffn_conv_b + c0), b = *(const f32x4*)(p.ffn_conv_b + c0 + 4), c = *(const f32x4*)(p.ffn_conv_b + DFF + c0), d = *(const f32x4*)(p.ffn_conv_b + DFF + c0 + 4);
          bg[0] = a.x; bg[1] = a.y; bg[2] = a.z; bg[3] = a.w; bg[4] = b.x; bg[5] = b.y; bg[6] = b.z; bg[7] = b.w; bv[0] = c.x; bv[1] = c.y; bv[2] = c.z; bv[3] = c.w; bv[4] = d.x; bv[5] = d.y; bv[6] = d.z; bv[7] = d.w; }
        float g2[8], g1[8], v2[8], v1[8];
        if ((r0 & (SEQ - 1)) != 0) {
            const bf16_t* pr = SB + ((size_t)(kb - 1) * 4 + 2) * (2 * DFF) + c0;
            unpack8(*(const u32x4*)pr, g2); unpack8(*(const u32x4*)(pr + DFF), v2); unpack8(*(const u32x4*)(pr + 2 * DFF), g1); unpack8(*(const u32x4*)(pr + 2 * DFF + DFF), v1);
        } else {
#pragma unroll
            for (int e = 0; e < 8; ++e) { g2[e] = 0.f; g1[e] = 0.f; v2[e] = 0.f; v1[e] = 0.f; }
        }
#pragma unroll
        for (int rr = 0; rr < 2; ++rr) {
            float g0[8], v0[8], y[8];
            const bf16_t* cr = SB + ((size_t)kb * 4 + rr) * (2 * DFF) + c0;
            unpack8(*(const u32x4*)cr, g0); unpack8(*(const u32x4*)(cr + DFF), v0);
#pragma unroll
            for (int e = 0; e < 8; ++e) {
                const float ug = bg[e] + wg[0][e] * g2[e] + wg[1][e] * g1[e] + wg[2][e] * g0[e];
                const float uv = bv[e] + wv[0][e] * v2[e] + wv[1][e] * v1[e] + wv[2][e] * v0[e];
                y[e] = ug * fsig(ug) * uv; g2[e] = g1[e]; g1[e] = g0[e]; v2[e] = v1[e]; v1[e] = v0[e];
            }
            *(u32x4*)(ACT + (size_t)(r0 + rr) * DFF + c0) = pack8(y);
        }
    }
}

#ifndef REP1
#define REP1 1
#endif
#ifndef REP3
#define REP3 1
#endif
__global__ void __launch_bounds__(512, 2) mega(Params p) {
    extern __shared__ __attribute__((aligned(16))) unsigned char shm[];
    cg::grid_group grid = cg::this_grid();
    bf16_t* H = (bf16_t*)((unsigned char*)p.out + DO_H); bf16_t* WinT = (bf16_t*)((unsigned char*)p.out + DO_WIN);
    bf16_t* H2 = (bf16_t*)(p.ws + WS_H2); bf16_t* ACTb = (bf16_t*)(p.ws + WS_ACT);
    const bf16_t* WoT = (const bf16_t*)(p.ws + WS_WOUT); const bf16_t* WuT = (const bf16_t*)(p.ws + WS_WUP); const bf16_t* WdT = (const bf16_t*)(p.ws + WS_WDN);
#define PH(i) (p.ph_lo <= (i) && (i) < p.ph_hi)
#define SYNC(i) do { if (p.ph_lo <= (i) && (i) + 1 < p.ph_hi) grid.sync(); } while (0)
    if (PH(0)) phase0(p, shm);
    SYNC(0);
    for (int rep = 0; rep < REP1; ++rep) { if (rep) grid.sync();
    if (PH(1)) { Epi1 E{(bf16_t*)(p.ws + WS_AQK), (bf16_t*)(p.ws + WS_VTM), (bf16_t*)(p.ws + WS_GA), (bf16_t*)(p.ws + WS_BQ), (bf16_t*)(p.ws + WS_BK), (bf16_t*)(p.ws + WS_VTD), (bf16_t*)(p.ws + WS_GB)};
        run_gemm_rot(shm, H, WinT, T, 16384, D, E); } }
    SYNC(1);
    if (PH(2)) phase2a(p, shm);
    SYNC(2);
    for (int rep = 0; rep < REP3; ++rep) { if (rep) grid.sync(); if (PH(3)) phase2b(p, shm, rep); }
    SYNC(3);
    if (PH(4)) phase3(p, shm);
    SYNC(4);
    if (PH(5)) { EpiRes E{p.out, p.x, D}; run_gemm(shm, (const bf16_t*)(p.ws + WS_BQ), WoT, T, D, D, E); }
    SYNC(5);
    if (PH(6)) phase5(p);
    SYNC(6);
    if (PH(7)) { EpiUp E{ACTb, (bf16_t*)(p.ws + WS_SB), p.ffn_conv_w, p.ffn_conv_b}; run_gemm(shm, H2, WuT, T, 2 * DFF, D, E); }
    SYNC(7);
    if (PH(8)) phase_fix(p);
    SYNC(8);
    if (PH(9)) { EpiRes E{p.out, p.out, D}; run_gemm(shm, ACTb, WdT, T, D, DFF, E); }
#undef PH
#undef SYNC
}

#ifndef N_LAUNCHES
#define N_LAUNCHES 1
#endif
extern "C" void kernel_launch(void* const* d_in, const int* in_sizes, int n_in, void* d_out, int out_size, void* d_ws, size_t ws_size, hipStream_t stream) {
    static int grid = 0;
    if (grid == 0) {
        if (n_in != 17 || out_size != T * D || ws_size < WS_END) { fprintf(stderr, "kernel_launch: unexpected problem (n_in %d, out %d, ws %zu)\n", n_in, out_size, ws_size); grid = -1; return; }
        int dev = 0, cus = 0, per_cu = 0;
        if (hipGetDevice(&dev) != hipSuccess || hipDeviceGetAttribute(&cus, hipDeviceAttributeMultiprocessorCount, dev) != hipSuccess) { grid = -1; return; }
        if (hipFuncSetAttribute((const void*)mega, hipFuncAttributeMaxDynamicSharedMemorySize, LDS_BYTES) != hipSuccess) { fprintf(stderr, "kernel_launch: hipFuncSetAttribute failed\n"); grid = -1; return; }
        if (hipOccupancyMaxActiveBlocksPerMultiprocessor(&per_cu, (const void*)mega, 512, LDS_BYTES) != hipSuccess || per_cu < 1) { fprintf(stderr, "kernel_launch: occupancy query says %d\n", per_cu); per_cu = 1; }
        (void)hipGetLastError();
        grid = cus * per_cu;
    }
    if (grid < 0) return;
    if (hipMemsetAsync((char*)d_ws + WS_CTL, 0, 4096, stream) != hipSuccess) { fprintf(stderr, "kernel_launch: memset failed\n"); return; }
    Params p{};
    const float** pp = (const float**)&p;
    for (int i = 0; i < 17; ++i) pp[i] = (const float*)d_in[i];
    p.out = (float*)d_out; p.ws = (unsigned char*)d_ws;
    constexpr int NPH = 10;
    for (int li = 0; li < N_LAUNCHES; ++li) {
        p.ph_lo = (N_LAUNCHES == 1) ? 0 : li; p.ph_hi = (N_LAUNCHES == 1) ? NPH : li + 1;
        void* args[] = {&p};
        hipError_t e = hipLaunchCooperativeKernel((const void*)mega, dim3(grid), dim3(512), args, LDS_BYTES, stream);
        if (e != hipSuccess) { fprintf(stderr, "cooperative launch failed: %s (grid %d)\n", hipGetErrorString(e), grid); break; }
    }
}
```

```cpp
#include <hip/hip_runtime.h>
#include <hip/hip_cooperative_groups.h>
#include <cstdio>
#include <cstdint>
namespace cg = cooperative_groups;
namespace pg8 {
#define PG8_LAS __attribute__((address_space(3)))
typedef unsigned short bf16_t;
typedef short bf16x8 __attribute__((ext_vector_type(8)));
typedef float f32x4 __attribute__((ext_vector_type(4)));
typedef unsigned u32x4 __attribute__((ext_vector_type(4)));
constexpr int BM = 256, BK = 64, HALF = 128, HTB = HALF * BK * 2  , STAGE_BYTES = 8 * HTB, NXCD = 8, WGM = 8;

__host__ __device__ __forceinline__ int lds_byte(int r, int c) { const int st = (r >> 4) * 2 + (c >> 5), rr = r & 15, cc = c & 31, ob = rr * 64 + cc * 2; return st * 1024 + (ob ^ (((ob >> 9) & 1) << 5)); }
__host__ __device__ __forceinline__ void stage_rc(int b, int& R, int& C) { const int st = b / 1024, sb = b % 1024, swz = sb ^ (((sb >> 9) & 1) << 5); R = (st >> 1) * 16 + swz / 64; C = (st & 1) * 32 + (swz % 64) / 2; }
__host__ __device__ __forceinline__ int perm32(int rho) { const int n = rho >> 4, i = rho & 15; return 8 * (i >> 2) + 4 * n + (i & 3); }

struct Unit { int pm, pn; };
struct Gemm { const bf16_t* A; const bf16_t* Bt; int M, N, K; };

struct StaticOrder {
    int nM, nN, nwg, G, c;
    __host__ __device__ void init(int M, int N, int G_, int c_) { nM = M / BM; nN = N / BM; nwg = nM * nN; G = G_; c = c_; }
    __host__ __device__ bool next(int i, Unit& u) const {
        const long L = (long)i * G + c; if (L >= nwg) return false;
        int wgid = (int)L; { const int q = nwg / NXCD, r = nwg % NXCD, xcd = wgid % NXCD, off = wgid / NXCD; wgid = (xcd < r ? xcd * (q + 1) : r * (q + 1) + (xcd - r) * q) + off; }
        const int nig = WGM * nN, gid = wgid / nig, fm = gid * WGM, gsz = (nM - fm) < WGM ? (nM - fm) : WGM;
        u.pm = fm + ((wgid % nig) % gsz); u.pn = (wgid % nig) / gsz; return true;
    }
    __device__ __forceinline__ void a_ready(const Unit&) const {}
    __device__ __forceinline__ void done(const Unit&) const {}
};
__device__ __forceinline__ unsigned cvt_pk_bf16(float lo, float hi) { unsigned r; asm volatile("v_cvt_pk_bf16_f32 %0, %1, %2" : "=v"(r) : "v"(lo), "v"(hi)); return r; }
template <class Epi, class Sched, bool ALIGN_EPI = false, bool SP2 = false>
__device__ __forceinline__ void gemm_phase(PG8_LAS unsigned char* lds, const Gemm g, const Sched& S, const Epi& E) {
    int tid_ = threadIdx.x; asm volatile("" : "+v"(tid_)); const int tid = tid_, wid = __builtin_amdgcn_readfirstlane(tid >> 6), lane = tid & 63, wr = wid >> 2, wc = wid & 3, fr = lane & 15, fq = lane >> 4;
    const int K = g.K, nt = K / BK;
    unsigned voffA[2], voffB[2];
#pragma unroll
    for (int i = 0; i < 2; ++i) { int R, C; stage_rc(tid * 16 + i * 8192, R, C); const int Rb = Epi::PERM ? ((R & ~31) + perm32(R & 31)) : R;
        voffA[i] = (unsigned)(R * K + C) * 2u; voffB[i] = (unsigned)(Rb * K + C) * 2u; }
    const size_t kstep = (size_t)(BK * 2);
    const size_t hstep = (size_t)HALF * K * 2;
    const size_t tstep = 2 * hstep;
    const unsigned ldsw = (unsigned)wid * 1024u;
    const int aoff = lds_byte(wr * 64 + fr, fq * 8), boff = lds_byte(wc * 32 + fr, fq * 8);
#define PG8_SA(b, h) (((b) * 2 + (h)) * HTB)
#define PG8_SB(b, h) ((4 + (b) * 2 + (h)) * HTB)
#define PG8_STAGE(bufoff, gbase, voff) do { _Pragma("unroll") for (int _i = 0; _i < 2; ++_i) \
        __builtin_amdgcn_global_load_lds((const unsigned*)((const char*)(gbase) + (voff)[_i]), (PG8_LAS unsigned*)(lds + (bufoff) + ldsw + _i * 8192), 16, 0, 0); } while (0)
#define PG8_LDA(dst, b, h) do { _Pragma("unroll") for (int m = 0; m < 4; ++m) _Pragma("unroll") for (int k = 0; k < 2; ++k) dst[m][k] = *(const PG8_LAS bf16x8*)(lds + PG8_SA(b, h) + aoff + m * 2048 + k * 1024); } while (0)
#define PG8_LDB(dst, b, h) do { _Pragma("unroll") for (int n = 0; n < 2; ++n) _Pragma("unroll") for (int k = 0; k < 2; ++k) dst[n][k] = *(const PG8_LAS bf16x8*)(lds + PG8_SB(b, h) + boff + n * 2048 + k * 1024); } while (0)
#define PG8_MMA(ai, bj, At, Bt) do { __builtin_amdgcn_s_setprio(1); _Pragma("unroll") for (int m = 0; m < 4; ++m) _Pragma("unroll") for (int n = 0; n < 2; ++n) _Pragma("unroll") for (int k = 0; k < 2; ++k) \
        acc[ai][bj][m][n] = __builtin_amdgcn_mfma_f32_16x16x32_bf16(Bt[n][k], At[m][k], acc[ai][bj][m][n], 0, 0, 0); __builtin_amdgcn_s_setprio(0); } while (0)
#define PG8_WAIT_V(n) asm volatile("s_waitcnt vmcnt(" #n ")" ::: "memory")
#define PG8_WAIT_L(n) asm volatile("s_waitcnt lgkmcnt(" #n ")" ::: "memory")
#define PG8_BAR __builtin_amdgcn_s_barrier()
#define PG8_SCHED __builtin_amdgcn_sched_barrier(0)
    Unit cur, nxt; int ui = 0;
    if (!S.next(0, cur)) return;
    f32x4 acc[2][2][4][2];
#pragma unroll
    for (int a = 0; a < 2; ++a)
#pragma unroll
        for (int b = 0; b < 2; ++b)
#pragma unroll
            for (int m = 0; m < 4; ++m)
#pragma unroll
                for (int n = 0; n < 2; ++n) acc[a][b][m][n] = (f32x4){0.f, 0.f, 0.f, 0.f};
    bf16x8 At[4][2], B0[2][2], B1[2][2];
    const char* cA = (const char*)g.A + (size_t)cur.pm * tstep; const char* cB = (const char*)g.Bt + (size_t)cur.pn * tstep;
    S.a_ready(cur);
    if constexpr (SP2) {
        PG8_STAGE(PG8_SB(0, 0), cB, voffB); PG8_STAGE(PG8_SB(0, 1), cB + hstep, voffB); PG8_STAGE(PG8_SA(0, 0), cA, voffA); PG8_STAGE(PG8_SA(0, 1), cA + hstep, voffA);
        if (wr == 1) PG8_BAR;
        PG8_WAIT_V(2); PG8_BAR;
        PG8_STAGE(PG8_SB(1, 0), cB + kstep, voffB); PG8_STAGE(PG8_SA(1, 0), cA + kstep, voffA); PG8_STAGE(PG8_SB(1, 1), cB + hstep + kstep, voffB);
        PG8_WAIT_V(6); PG8_BAR;
    } else {
        PG8_STAGE(PG8_SB(0, 0), cB, voffB); PG8_STAGE(PG8_SA(0, 0), cA, voffA); PG8_STAGE(PG8_SB(0, 1), cB + hstep, voffB); PG8_STAGE(PG8_SA(0, 1), cA + hstep, voffA);
        if (wr == 1) PG8_BAR;
        PG8_WAIT_V(4); PG8_BAR;
        PG8_STAGE(PG8_SB(1, 0), cB + kstep, voffB); PG8_STAGE(PG8_SA(1, 0), cA + kstep, voffA); PG8_STAGE(PG8_SB(1, 1), cB + hstep + kstep, voffB);
        PG8_WAIT_V(6); PG8_BAR;
    }
    for (;;) {
        const bool has_next = S.next(ui + 1, nxt);
        const char* nA = has_next ? (const char*)g.A + (size_t)nxt.pm * tstep : cA; const char* nB = has_next ? (const char*)g.Bt + (size_t)nxt.pn * tstep : cB;
        for (int t = 0; t < nt; t += 2) {
            const bool last = (t == nt - 2);
            const char* a1 = cA + (size_t)(t + 1) * kstep;
            const char* a2 = last ? nA : cA + (size_t)(t + 2) * kstep; const char* b2 = last ? nB : cB + (size_t)(t + 2) * kstep;
            const char* a3 = a2 + kstep; const char* b3 = b2 + kstep;
            if (last && has_next) S.a_ready(nxt);
            if constexpr (SP2) {
            PG8_LDB(B0, 0, 0); PG8_LDB(B1, 0, 1); PG8_SCHED; PG8_LDA(At, 0, 0); PG8_STAGE(PG8_SA(1, 1), a1 + hstep, voffA);
            PG8_WAIT_V(8); PG8_WAIT_L(0); PG8_BAR; PG8_MMA(0, 0, At, B0); PG8_MMA(0, 1, At, B1); PG8_BAR; PG8_SCHED;
            PG8_LDA(At, 0, 1); PG8_STAGE(PG8_SB(0, 0), b2, voffB); PG8_STAGE(PG8_SB(0, 1), b2 + hstep, voffB); PG8_STAGE(PG8_SA(0, 0), a2, voffA);
            PG8_WAIT_V(8); PG8_WAIT_L(0); PG8_BAR; PG8_MMA(1, 0, At, B0); PG8_MMA(1, 1, At, B1); PG8_BAR; PG8_SCHED;
            PG8_LDB(B0, 1, 0); PG8_LDB(B1, 1, 1); PG8_SCHED; PG8_LDA(At, 1, 0); PG8_STAGE(PG8_SA(0, 1), a2 + hstep, voffA);
            PG8_WAIT_V(8); PG8_WAIT_L(0); PG8_BAR; PG8_MMA(0, 0, At, B0); PG8_MMA(0, 1, At, B1); PG8_BAR; PG8_SCHED;
            PG8_LDA(At, 1, 1); PG8_STAGE(PG8_SB(1, 0), b3, voffB); PG8_STAGE(PG8_SB(1, 1), b3 + hstep, voffB); PG8_STAGE(PG8_SA(1, 0), a3, voffA);
            PG8_WAIT_V(8); PG8_WAIT_L(0); PG8_BAR; PG8_MMA(1, 0, At, B0); PG8_MMA(1, 1, At, B1); PG8_BAR; PG8_SCHED;
            } else {
            PG8_LDB(B0, 0, 0); PG8_SCHED; PG8_LDA(At, 0, 0); PG8_STAGE(PG8_SA(1, 1), a1 + hstep, voffA);
            PG8_WAIT_L(8); PG8_BAR; PG8_WAIT_L(0); PG8_MMA(0, 0, At, B0); PG8_BAR; PG8_SCHED;
            PG8_LDB(B1, 0, 1); PG8_STAGE(PG8_SB(0, 0), b2, voffB);
            PG8_BAR; PG8_WAIT_L(0); PG8_MMA(0, 1, At, B1); PG8_BAR;
            PG8_LDA(At, 0, 1); PG8_STAGE(PG8_SA(0, 0), a2, voffA);
            PG8_BAR; PG8_WAIT_L(0); PG8_MMA(1, 0, At, B0); PG8_BAR; PG8_SCHED;
            PG8_STAGE(PG8_SB(0, 1), b2 + hstep, voffB);
            PG8_WAIT_V(6); PG8_BAR; PG8_MMA(1, 1, At, B1); PG8_BAR;
            PG8_LDB(B0, 1, 0); PG8_SCHED; PG8_LDA(At, 1, 0); PG8_STAGE(PG8_SA(0, 1), a2 + hstep, voffA);
            PG8_WAIT_L(8); PG8_BAR; PG8_WAIT_L(0); PG8_MMA(0, 0, At, B0); PG8_BAR; PG8_SCHED;
            PG8_LDB(B1, 1, 1); PG8_STAGE(PG8_SB(1, 0), b3, voffB);
            PG8_BAR; PG8_WAIT_L(0); PG8_MMA(0, 1, At, B1); PG8_BAR;
            PG8_LDA(At, 1, 1); PG8_STAGE(PG8_SA(1, 0), a3, voffA);
            PG8_BAR; PG8_WAIT_L(0); PG8_MMA(1, 0, At, B0); PG8_BAR; PG8_SCHED;
            PG8_STAGE(PG8_SB(1, 1), b3 + hstep, voffB);
            PG8_WAIT_V(6); PG8_BAR; PG8_MMA(1, 1, At, B1); PG8_BAR;
            }
        }
        if constexpr (ALIGN_EPI) { if (wr == 0) PG8_BAR; }
        if constexpr (!Epi::AFTER_DRAIN) { E(acc, cur, wr, wc, fr, fq); S.done(cur); }
        if (!has_next) break;
#pragma unroll
        for (int a = 0; a < 2; ++a)
#pragma unroll
            for (int b = 0; b < 2; ++b)
#pragma unroll
                for (int m = 0; m < 4; ++m)
#pragma unroll
                    for (int n = 0; n < 2; ++n) acc[a][b][m][n] = (f32x4){0.f, 0.f, 0.f, 0.f};
        cur = nxt; cA = nA; cB = nB; ++ui;
        if constexpr (ALIGN_EPI) { if (wr == 1) PG8_BAR; }
    }
    PG8_WAIT_V(0);
    if constexpr (!ALIGN_EPI) { if (wr == 0) PG8_BAR; }
    PG8_BAR;
    if constexpr (Epi::AFTER_DRAIN) { E.fused(acc, cur, wr, wc, fr, fq, lds, wid, lane); S.done(cur); }
#undef PG8_SA
#undef PG8_SB
#undef PG8_STAGE
#undef PG8_LDA
#undef PG8_LDB
#undef PG8_MMA
#undef PG8_WAIT_V
#undef PG8_WAIT_L
#undef PG8_BAR
#undef PG8_SCHED
}
}
using pg8::bf16_t; using pg8::bf16x8; using pg8::f32x4; using pg8::u32x4; using pg8::cvt_pk_bf16;
typedef unsigned u32x2 __attribute__((ext_vector_type(2)));
typedef float f32x16 __attribute__((ext_vector_type(16)));

constexpr int T = 32768, D = 2048, SEQ = 8192, PIN = 16392, DFF = 5632, TH = 16384;
constexpr float EPS = 1e-6f, LOG2E = 1.4426950408889634f;
constexpr size_t MiB = (size_t)1 << 20;
constexpr size_t WS_CTL = 0, WS_GIF = 1 * MiB, WS_KT = 2 * MiB, WS_AQK = 66 * MiB, WS_VTM = 194 * MiB, WS_GA = 322 * MiB, WS_BQ = 450 * MiB, WS_BK = 578 * MiB,
                 WS_VTD = 706 * MiB, WS_GB = 834 * MiB, WS_END = 962 * MiB;
constexpr size_t WS_HM = WS_AQK, WS_H2 = WS_AQK, WS_WOUT = WS_VTM, WS_WUP = WS_VTM + 8 * MiB, WS_WDN = WS_VTM + 52 * MiB, WS_ACT = WS_GA, WS_SB = 674 * MiB;
constexpr size_t DO_H = 0, DO_Q2 = 0, DO_K2 = 64 * MiB, DO_WIN = 128 * MiB, DO_YB = 128 * MiB;
constexpr int LDS_BYTES = 147456;

struct Params {
    const float *x, *norm1_g, *w_in, *if_bias, *qk_conv_w, *qk_conv_b, *mlstm_norm_g, *q_norm_g, *k_norm_g, *diff_lambda, *subln_g, *w_out, *norm2_g, *w_up, *ffn_conv_w, *ffn_conv_b, *w_down;
    float* out; unsigned char* ws; int ph_lo, ph_hi;
};

__device__ __forceinline__ void lds_wait() { asm volatile("s_waitcnt lgkmcnt(0)" ::: "memory"); }
__device__ __forceinline__ float bflo(unsigned u) { return __uint_as_float(u << 16); }
__device__ __forceinline__ float bfhi(unsigned u) { return __uint_as_float(u & 0xffff0000u); }
__device__ __forceinline__ float fsig(float v) { return __builtin_amdgcn_rcpf(1.f + __expf(-v)); }
__device__ __forceinline__ float wave_sum(float v) {
#pragma unroll
    for (int o = 1; o < 64; o <<= 1) v += __shfl_xor(v, o);
    return v;
}
__device__ __forceinline__ void unpack8(u32x4 u, float (&f)[8]) {
    f[0] = bflo(u.x); f[1] = bfhi(u.x); f[2] = bflo(u.y); f[3] = bfhi(u.y); f[4] = bflo(u.z); f[5] = bfhi(u.z); f[6] = bflo(u.w); f[7] = bfhi(u.w);
}
__device__ __forceinline__ u32x4 pack8(const float (&f)[8]) {
    u32x4 o; o.x = cvt_pk_bf16(f[0], f[1]); o.y = cvt_pk_bf16(f[2], f[3]); o.z = cvt_pk_bf16(f[4], f[5]); o.w = cvt_pk_bf16(f[6], f[7]); return o;
}

__device__ __forceinline__ void transpose_item(const float* __restrict__ W, size_t ldw, int K, bf16_t* WT, int k0, int srcn0, int dstn0, float* scr, int lane) {
#pragma unroll 8
    for (int i = 0; i < 32; ++i) { const int kk = 2 * i + (lane >> 5); scr[kk * 33 + (lane & 31)] = W[(size_t)(k0 + kk) * ldw + srcn0 + (lane & 31)]; }
    lds_wait();
    const int c = lane & 7;
#pragma unroll
    for (int j = 0; j < 4; ++j) { const int n = (lane >> 3) + 8 * j; const float* s = scr + (8 * c) * 33 + n;
        u32x4 o; o.x = cvt_pk_bf16(s[0], s[33]); o.y = cvt_pk_bf16(s[66], s[99]); o.z = cvt_pk_bf16(s[132], s[165]); o.w = cvt_pk_bf16(s[198], s[231]);
        *(u32x4*)(WT + (size_t)(dstn0 + n) * K + k0 + 8 * c) = o; }
    lds_wait();
}
__device__ __forceinline__ int win_src(int n) {
    if (n < 4096) return n;
    if (n < 8192) { const int p = (n - 4096) >> 8, j = (n - 4096) & 255; return j < 128 ? 4096 + 128 * p + j : 12296 + 128 * p + (j - 128); }
    if (n < 10240) return 6152 + (n - 8192);
    if (n < 12288) return 8200 + (n - 10240);
    if (n < 14336) return 10248 + (n - 12288);
    return 14344 + (n - 14336);
}
__device__ __forceinline__ void transpose_plain(const float* W, int K, int N, bf16_t* WT, float* scr, int gw, int ngw, int lane) {
    const int nblk = N / 32, nitems = (K / 64) * nblk;
    for (int it = gw; it < nitems; it += ngw) { const int kb = it / nblk, nb = it % nblk; transpose_item(W, (size_t)N, K, WT, 64 * kb, 32 * nb, 32 * nb, scr, lane); }
}

__device__ __forceinline__ void phase0(const Params& p, unsigned char* shm) {
    int tid_ = threadIdx.x; asm volatile("" : "+v"(tid_)); const int tid = tid_, lane = tid & 63, wave = tid >> 6, gw = blockIdx.x * 8 + wave, ngw = gridDim.x * 8;
    float* scr = (float*)(shm + wave * 8448);
    bf16_t* WinT = (bf16_t*)((unsigned char*)p.out + DO_WIN);
    { const int nblk = 16384 / 32, nitems = (D / 64) * nblk;
      for (int it = gw; it < nitems; it += ngw) { const int kb = it / nblk, nb = it % nblk; transpose_item(p.w_in, (size_t)PIN, D, WinT, 64 * kb, win_src(32 * nb), 32 * nb, scr, lane); } }
    float* wifT = (float*)(shm + 69632);
    for (int idx = tid; idx < 8 * D; idx += 512) { const int k = idx >> 3, j = idx & 7; wifT[j * D + k] = p.w_in[(size_t)k * PIN + 6144 + j]; }
    __syncthreads();
    bf16_t* H = (bf16_t*)((unsigned char*)p.out + DO_H);
    float* GIF = (float*)(p.ws + WS_GIF);
    f32x4 g1r[8];
#pragma unroll
    for (int j = 0; j < 8; ++j) g1r[j] = *((const f32x4*)p.norm1_g + lane + 64 * j);
    for (int row = gw; row < T; row += ngw) {
        const f32x4* xr = (const f32x4*)(p.x + (size_t)row * D) + lane;
        f32x4 v[8]; float ss = 0.f;
#pragma unroll
        for (int j = 0; j < 8; ++j) { v[j] = xr[64 * j]; ss += (v[j].x * v[j].x + v[j].y * v[j].y) + (v[j].z * v[j].z + v[j].w * v[j].w); }
        const float rinv = rsqrtf(wave_sum(ss) * (1.f / D) + EPS);
        float ga[8];
#pragma unroll
        for (int j = 0; j < 8; ++j) ga[j] = 0.f;
        u32x2* o8 = (u32x2*)(H + (size_t)row * D) + lane;
#pragma unroll
        for (int j = 0; j < 8; ++j) {
            const f32x4 g = g1r[j];
            f32x4 h; h.x = v[j].x * rinv * g.x; h.y = v[j].y * rinv * g.y; h.z = v[j].z * rinv * g.z; h.w = v[j].w * rinv * g.w;
            u32x2 o; o.x = cvt_pk_bf16(h.x, h.y); o.y = cvt_pk_bf16(h.z, h.w); o8[64 * j] = o;
#pragma unroll
            for (int q = 0; q < 8; ++q) { const f32x4 w = *((const f32x4*)(wifT + q * D) + lane + 64 * j); ga[q] += (h.x * w.x + h.y * w.y) + (h.z * w.z + h.w * w.w); }
        }
#pragma unroll
        for (int q = 0; q < 8; ++q) ga[q] = wave_sum(ga[q]);
        if (lane < 8) {
            float val = 0.f;
#pragma unroll
            for (int q = 0; q < 8; ++q) val = (lane == q) ? ga[q] : val;
            val += p.if_bias[lane];
            if (lane >= 4) val = fminf(val, 0.f) - log1pf(expf(-fabsf(val)));
            GIF[(size_t)row * 8 + lane] = val;
        }
    }
}

#ifndef GEMM_ALIGN
#define GEMM_ALIGN true
#endif
#ifndef GEMM_SP2
#define GEMM_SP2 true
#endif
struct Epi1 {
    static constexpr bool PERM = true, AFTER_DRAIN = false;
    bf16_t *aqk, *vtm, *ga, *bq, *bk, *vtd, *gb;
    __device__ __forceinline__ void operator()(const f32x4 (&acc)[2][2][4][2], const pg8::Unit& u, int wr, int wc, int fr, int fq) const {
        const int pn = u.pn, row0 = u.pm * 256 + wr * 64 + fr, cw = wc * 32 + 8 * fq;
        if (pn >= 16 && pn < 32) {
            const int cb = 128 * (pn - 16) + cw;
#pragma unroll
            for (int ai = 0; ai < 2; ++ai)
#pragma unroll
                for (int m = 0; m < 4; ++m) {
                    const size_t row = (size_t)(row0 + ai * 128 + m * 16);
                    float f[8];
#pragma unroll
                    for (int j = 0; j < 4; ++j) { f[j] = fsig(acc[ai][0][m][0][j]) * fsig(acc[ai][1][m][0][j]); f[4 + j] = fsig(acc[ai][0][m][1][j]) * fsig(acc[ai][1][m][1][j]); }
                    *(u32x4*)(ga + row * D + cb) = pack8(f);
                }
            return;
        }
        bf16_t* dst; int col0; int mode;
        if (pn < 8) { dst = aqk; col0 = 256 * pn; mode = 0; }
        else if (pn < 16) { dst = vtm; col0 = 256 * (pn - 8); mode = 1; }
        else if (pn < 40) { dst = bq; col0 = 256 * (pn - 32); mode = 0; }
        else if (pn < 48) { dst = bk; col0 = 256 * (pn - 40); mode = 0; }
        else if (pn < 56) { dst = vtd; col0 = 256 * (pn - 48); mode = 3; }
        else { dst = gb; col0 = 256 * (pn - 56); mode = 2; }
#pragma unroll
        for (int ai = 0; ai < 2; ++ai)
#pragma unroll
            for (int m = 0; m < 4; ++m) {
                const int row = row0 + ai * 128 + m * 16;
#pragma unroll
                for (int bj = 0; bj < 2; ++bj) {
                    const int col = col0 + bj * 128 + cw;
                    float f[8];
#pragma unroll
                    for (int j = 0; j < 4; ++j) { f[j] = acc[ai][bj][m][0][j]; f[4 + j] = acc[ai][bj][m][1][j]; }
                    if (mode == 2) {
#pragma unroll
                        for (int j = 0; j < 8; ++j) f[j] = fsig(f[j]);
                    }
                    const u32x4 w = pack8(f);
                    if (mode == 3) {
                        bf16_t* d = dst + (((size_t)((row >> 13) * 8 + (col >> 8)) * 256 + ((row & (SEQ - 1)) >> 5)) * 256 + (col & 255)) * 32 + (row & 31);
                        d[0] = (bf16_t)(w.x & 0xffff); d[32] = (bf16_t)(w.x >> 16); d[64] = (bf16_t)(w.y & 0xffff); d[96] = (bf16_t)(w.y >> 16);
                        d[128] = (bf16_t)(w.z & 0xffff); d[160] = (bf16_t)(w.z >> 16); d[192] = (bf16_t)(w.w & 0xffff); d[224] = (bf16_t)(w.w >> 16);
                    } else if (mode == 1) {
                        bf16_t* d = dst + ((size_t)((row >> 13) * D + col)) * SEQ + (row & (SEQ - 1));
                        d[0 * (size_t)SEQ] = (bf16_t)(w.x & 0xffff); d[1 * (size_t)SEQ] = (bf16_t)(w.x >> 16); d[2 * (size_t)SEQ] = (bf16_t)(w.y & 0xffff); d[3 * (size_t)SEQ] = (bf16_t)(w.y >> 16);
                        d[4 * (size_t)SEQ] = (bf16_t)(w.z & 0xffff); d[5 * (size_t)SEQ] = (bf16_t)(w.z >> 16); d[6 * (size_t)SEQ] = (bf16_t)(w.w & 0xffff); d[7 * (size_t)SEQ] = (bf16_t)(w.w >> 16);
                    } else {
                        *(u32x4*)(dst + (size_t)row * D + col) = w;
                    }
                }
            }
    }
};
struct EpiRes {
    static constexpr bool PERM = false, AFTER_DRAIN = false;
    float* C; const float* R; int ldc;
    __device__ __forceinline__ void operator()(const f32x4 (&acc)[2][2][4][2], const pg8::Unit& u, int wr, int wc, int fr, int fq) const {
        const int row0 = u.pm * 256 + wr * 64 + fr, col0 = u.pn * 256 + wc * 32 + 4 * fq;
#pragma unroll
        for (int ai = 0; ai < 2; ++ai)
#pragma unroll
            for (int m = 0; m < 4; ++m) {
                const size_t off = (size_t)(row0 + ai * 128 + m * 16) * ldc + col0;
#pragma unroll
                for (int bj = 0; bj < 2; ++bj)
#pragma unroll
                    for (int n = 0; n < 2; ++n) { const f32x4 r = *(const f32x4*)(R + off + bj * 128 + n * 16); *(f32x4*)(C + off + bj * 128 + n * 16) = acc[ai][bj][m][n] + r; }
            }
    }
};
struct EpiB {
    static constexpr bool PERM = true, AFTER_DRAIN = false;
    bf16_t* O; int ldc;
    __device__ __forceinline__ void operator()(const f32x4 (&acc)[2][2][4][2], const pg8::Unit& u, int wr, int wc, int fr, int fq) const {
        const int row0 = u.pm * 256 + wr * 64 + fr, col0 = u.pn * 256 + wc * 32 + 8 * fq;
#pragma unroll
        for (int ai = 0; ai < 2; ++ai)
#pragma unroll
            for (int m = 0; m < 4; ++m) {
                bf16_t* rowp = O + (size_t)(row0 + ai * 128 + m * 16) * ldc + col0;
#pragma unroll
                for (int bj = 0; bj < 2; ++bj) {
                    u32x4 w; w.x = cvt_pk_bf16(acc[ai][bj][m][0][0], acc[ai][bj][m][0][1]); w.y = cvt_pk_bf16(acc[ai][bj][m][0][2], acc[ai][bj][m][0][3]);
                    w.z = cvt_pk_bf16(acc[ai][bj][m][1][0], acc[ai][bj][m][1][1]); w.w = cvt_pk_bf16(acc[ai][bj][m][1][2], acc[ai][bj][m][1][3]);
                    *(u32x4*)(rowp + bj * 128) = w;
                }
            }
    }
};
struct RotOrder : pg8::StaticOrder {
    int rot;
    __device__ __forceinline__ bool next(int i, pg8::Unit& u) const { const bool ok = pg8::StaticOrder::next(i, u); if (ok) { u.pn += rot; if (u.pn >= nN) u.pn -= nN; } return ok; }
};
template <class Epi> __device__ __forceinline__ void run_gemm_rot(unsigned char* shm, const bf16_t* A, const bf16_t* Bt, int M, int N, int K, const Epi& E) {
    pg8::Gemm g{A, Bt, M, N, K};
    RotOrder S; S.init(M, N, (int)gridDim.x, (int)blockIdx.x); S.rot = ((int)blockIdx.x & 7) * (N / 256 / 8);
    pg8::gemm_phase<Epi, RotOrder, GEMM_ALIGN, GEMM_SP2>((PG8_LAS unsigned char*)shm, g, S, E);
}
template <class Epi> __device__ __forceinline__ void run_gemm(unsigned char* shm, const bf16_t* A, const bf16_t* Bt, int M, int N, int K, const Epi& E) {
    pg8::Gemm g{A, Bt, M, N, K};
    pg8::StaticOrder S; S.init(M, N, (int)gridDim.x, (int)blockIdx.x);
    pg8::gemm_phase<Epi, pg8::StaticOrder, GEMM_ALIGN, GEMM_SP2>((PG8_LAS unsigned char*)shm, g, S, E);
}

__device__ __forceinline__ void phase2a(const Params& p, unsigned char* shm) {
    int tid_ = threadIdx.x; asm volatile("" : "+v"(tid_)); const int tid = tid_, lane = tid & 63, wave = tid >> 6;
    const bf16_t* AQK = (const bf16_t*)(p.ws + WS_AQK);
    bf16_t* Q2 = (bf16_t*)((unsigned char*)p.out + DO_Q2); bf16_t* K2 = (bf16_t*)((unsigned char*)p.out + DO_K2); bf16_t* KT = (bf16_t*)(p.ws + WS_KT);
    bf16_t* tl = (bf16_t*)shm;
    const int nwc = gridDim.x >> 5, cgp = blockIdx.x & 31, oct = tid & 7, rg = tid >> 3, c0 = 64 * cgp + 8 * oct;
    float w[4][8], bias[8];
#pragma unroll
    for (int j = 0; j < 4; ++j) { const f32x4 a = *(const f32x4*)(p.qk_conv_w + j * D + c0), b = *(const f32x4*)(p.qk_conv_w + j * D + c0 + 4);
        w[j][0] = a.x; w[j][1] = a.y; w[j][2] = a.z; w[j][3] = a.w; w[j][4] = b.x; w[j][5] = b.y; w[j][6] = b.z; w[j][7] = b.w; }
    { const f32x4 a = *(const f32x4*)(p.qk_conv_b + c0), b = *(const f32x4*)(p.qk_conv_b + c0 + 4);
      bias[0] = a.x; bias[1] = a.y; bias[2] = a.z; bias[3] = a.w; bias[4] = b.x; bias[5] = b.y; bias[6] = b.z; bias[7] = b.w; }
    for (int ch = (int)(blockIdx.x >> 5); ch < 256 && (int)(blockIdx.x >> 5) < nwc; ch += nwc) {
        const int t0 = ch * 128;
        float in[5][8];
        const int rl0 = 2 * rg;
#pragma unroll
        for (int k = 0; k < 5; ++k) {
            const int rl = rl0 - 3 + k; const int sp = (t0 & (SEQ - 1)) + rl;
            if (sp >= 0) { const u32x4 u = *(const u32x4*)(AQK + (size_t)(t0 + rl) * D + c0); unpack8(u, in[k]); }
            else {
#pragma unroll
                for (int e = 0; e < 8; ++e) in[k][e] = 0.f; }
        }
        const bool isq = cgp < 16;
#pragma unroll
        for (int rr = 0; rr < 2; ++rr) {
            float y[8];
#pragma unroll
            for (int e = 0; e < 8; ++e) { float a = bias[e]; a += w[0][e] * in[rr][e]; a += w[1][e] * in[rr + 1][e]; a += w[2][e] * in[rr + 2][e]; a += w[3][e] * in[rr + 3][e];
                a = a * fsig(a); y[e] = isq ? a * 0.0625f : a; }
            const u32x4 o = pack8(y);
            const size_t row = (size_t)(t0 + rl0 + rr);
            if (isq) *(u32x4*)(Q2 + row * 1024 + c0) = o;
            else {
                *(u32x4*)(K2 + row * 1024 + (c0 - 1024)) = o;
            }
        }
    }
    {
        bf16_t* BQ = (bf16_t*)(p.ws + WS_BQ); bf16_t* BK = (bf16_t*)(p.ws + WS_BK);
        const int e16 = lane & 15, sub = lane >> 4;
        const float qs = 0.08838834764831845f * LOG2E;
        const f32x4 gq0 = *(const f32x4*)(p.q_norm_g + 8 * e16), gq1 = *(const f32x4*)(p.q_norm_g + 8 * e16 + 4);
        const f32x4 gk0 = *(const f32x4*)(p.k_norm_g + 8 * e16), gk1 = *(const f32x4*)(p.k_norm_g + 8 * e16 + 4);
        const int gwv = blockIdx.x * 8 + wave, ngw = gridDim.x * 8;
        for (int it = gwv; it < T * 16 / 4; it += ngw) {
            const int gid = it * 4 + sub, t = gid >> 4, grp = 16 + (gid & 15);
            const bool isq = false;
            bf16_t* ptr = (isq ? BQ : BK) + (size_t)t * D + 128 * (grp & 15) + 8 * e16;
            float f[8]; unpack8(*(const u32x4*)ptr, f);
            float ss = 0.f;
#pragma unroll
            for (int e = 0; e < 8; ++e) ss += f[e] * f[e];
            ss += __shfl_xor(ss, 1); ss += __shfl_xor(ss, 2); ss += __shfl_xor(ss, 4); ss += __shfl_xor(ss, 8);
            const float rinv = rsqrtf(ss * (1.f / 128.f) + EPS) * (isq ? qs : 1.f);
            const f32x4 g0 = isq ? gq0 : gk0, g1 = isq ? gq1 : gk1;
            f[0] *= rinv * g0.x; f[1] *= rinv * g0.y; f[2] *= rinv * g0.z; f[3] *= rinv * g0.w; f[4] *= rinv * g1.x; f[5] *= rinv * g1.y; f[6] *= rinv * g1.z; f[7] *= rinv * g1.w;
            *(u32x4*)ptr = pack8(f);
        }
    }
}

constexpr int ML_KL = 0, ML_CT = 67584, ML_VT = 101376, ML_A = 118784, ML_MM = 119296, ML_BB = 119808, ML_WS = 120320, ML_N = 120832, ML_MISC = 121856;
typedef short s16x4 __attribute__((ext_vector_type(4)));
#define ML_SB __builtin_amdgcn_sched_barrier(0)
#define ML_MFMA(a_, b_, c_) __builtin_amdgcn_mfma_f32_16x16x32_bf16(a_, b_, c_, 0, 0, 0)
__device__ __forceinline__ void ml_chain2(const unsigned char* baseA, const unsigned char* baseB, const bf16x8 (&qf)[8], f32x4& SA, f32x4& SB) {
    bf16x8 f0 = *(const bf16x8*)(baseA), f1 = *(const bf16x8*)(baseB), f2 = *(const bf16x8*)(baseA + 16), f3 = *(const bf16x8*)(baseB + 16);
    ML_SB;
#pragma unroll
    for (int ks = 0; ks < 8; ks += 2) {
        SA = ML_MFMA(f0, qf[ks], SA); if (ks + 2 < 8) f0 = *(const bf16x8*)(baseA + 16 * (ks + 2)); ML_SB;
        SB = ML_MFMA(f1, qf[ks], SB); if (ks + 2 < 8) f1 = *(const bf16x8*)(baseB + 16 * (ks + 2)); ML_SB;
        SA = ML_MFMA(f2, qf[ks + 1], SA); if (ks + 3 < 8) f2 = *(const bf16x8*)(baseA + 16 * (ks + 3)); ML_SB;
        SB = ML_MFMA(f3, qf[ks + 1], SB); if (ks + 3 < 8) f3 = *(const bf16x8*)(baseB + 16 * (ks + 3)); ML_SB;
    }
}
__device__ __forceinline__ void mlstm_item(const Params& p, unsigned char* shm, int item) {
    int tid_ = threadIdx.x; asm volatile("" : "+v"(tid_)); const int tid = tid_, lane = tid & 63, w = __builtin_amdgcn_readfirstlane(tid >> 6), l15 = lane & 15, qq = lane >> 4;
    const int sl = item & 7, hA = (item >> 3) & 3, b = item >> 5;
    const int wq = w < 4 ? w : 11 - w;
    const bf16_t* Q2 = (const bf16_t*)((const unsigned char*)p.out + DO_Q2); const bf16_t* K2 = (const bf16_t*)((const unsigned char*)p.out + DO_K2);
    const bf16_t* VTM = (const bf16_t*)(p.ws + WS_VTM); const float* GIF = (const float*)(p.ws + WS_GIF);
    bf16_t* HM = (bf16_t*)(p.ws + WS_HM);
    float* sA = (float*)(shm + ML_A); float* sMM = (float*)(shm + ML_MM); float* sBB = (float*)(shm + ML_BB); float* sWS = (float*)(shm + ML_WS); float* sN = (float*)(shm + ML_N); float* sMisc = (float*)(shm + ML_MISC);
    f32x4 Cacc[2][4], Nacc[2];
#pragma unroll
    for (int a = 0; a < 2; ++a) { Nacc[a] = (f32x4){0.f, 0.f, 0.f, 0.f};
#pragma unroll
        for (int c = 0; c < 4; ++c) Cacc[a][c] = (f32x4){0.f, 0.f, 0.f, 0.f}; }
    float m_st = 0.f;
    const bf16_t* vtrow0 = VTM + ((size_t)((b * 4 + hA) * 512 + 64 * sl)) * SEQ;
    const size_t tb = (size_t)b * SEQ;
    u32x4 stK[8], stV[2]; float gli0 = 0.f, gli1 = 0.f, glf0 = 0.f, glf1 = 0.f; bf16x8 qf[8];
    const int krow_s = tid >> 2, kpart = tid & 3, vdv = tid >> 3, vpart = tid & 7;
#define ML_LOAD_STAGE(c_) do { const size_t t0_ = tb + 128 * (c_); \
        { const bf16_t* src = K2 + (t0_ + krow_s) * 1024 + hA * 256 + kpart * 64; _Pragma("unroll") for (int e = 0; e < 8; ++e) stK[e] = *(const u32x4*)(src + 8 * e); } \
        { const bf16_t* src = vtrow0 + (size_t)vdv * SEQ + 128 * (c_) + vpart * 16; stV[0] = *(const u32x4*)src; stV[1] = *(const u32x4*)(src + 8); } \
        if (w == 0) { gli0 = GIF[(t0_ + 2 * lane) * 8 + hA]; gli1 = GIF[(t0_ + 2 * lane + 1) * 8 + hA]; glf0 = GIF[(t0_ + 2 * lane) * 8 + 4 + hA]; glf1 = GIF[(t0_ + 2 * lane + 1) * 8 + 4 + hA]; } } while (0)
#define ML_LOAD_Q(c_) do { const bf16_t* qp = Q2 + (tb + 128 * (c_) + 16 * wq + l15) * 1024 + hA * 256 + 64 * qq; _Pragma("unroll") for (int ks = 0; ks < 8; ++ks) qf[ks] = *(const bf16x8*)(qp + 8 * ks); } while (0)
#define ML_WRITE_STAGE() do { \
        { unsigned char* dst = shm + ML_KL + krow_s * 528 + kpart * 128; _Pragma("unroll") for (int e = 0; e < 8; ++e) *(u32x4*)(dst + 16 * e) = stK[e]; } \
        { unsigned char* dst = shm + ML_VT + vdv * 272 + vpart * 32; *(u32x4*)dst = stV[0]; *(u32x4*)(dst + 16) = stV[1]; } \
        _Pragma("unroll") for (int dkb = 0; dkb < 2; ++dkb) { \
            _Pragma("unroll") for (int dvb = 0; dvb < 4; ++dvb) { u32x2 o; o.x = cvt_pk_bf16(Cacc[dkb][dvb][0], Cacc[dkb][dvb][1]); o.y = cvt_pk_bf16(Cacc[dkb][dvb][2], Cacc[dkb][dvb][3]); \
                *(u32x2*)(shm + ML_CT + (16 * dvb + l15) * 528 + (32 * w + 16 * dkb + 4 * qq) * 2) = o; } \
            if (l15 == 0) *(f32x4*)(sN + 32 * w + 16 * dkb + 4 * qq) = Nacc[dkb]; } \
        if (w == 0) { \
            float cs = glf0 + glf1; \
            _Pragma("unroll") for (int o = 1; o < 64; o <<= 1) { const float v = __shfl_up(cs, o); if (lane >= o) cs += v; } \
            const float b1 = cs, b0 = cs - glf1; const float a0 = gli0 - b0, a1 = gli1 - b1; \
            float pmx = fmaxf(a0, a1); \
            _Pragma("unroll") for (int o = 1; o < 64; o <<= 1) { const float v = __shfl_up(pmx, o); if (lane >= o) pmx = fmaxf(pmx, v); } \
            float ex = __shfl_up(pmx, 1); if (lane == 0) ex = -3.0e38f; \
            const float pm0 = fmaxf(ex, a0), pm1 = pmx; const float mm0 = fmaxf(pm0, m_st), mm1 = fmaxf(pm1, m_st); \
            const float mml = __shfl(mm1, 63), bl = __shfl(b1, 63); \
            sA[2 * lane] = a0; sA[2 * lane + 1] = a1; sMM[2 * lane] = mm0; sMM[2 * lane + 1] = mm1; sBB[2 * lane] = b0; sBB[2 * lane + 1] = b1; \
            sWS[2 * lane] = __expf(a0 - mml); sWS[2 * lane + 1] = __expf(a1 - mml); \
            if (lane == 0) { sMisc[0] = bl; sMisc[1] = mml; } } } while (0)
    ML_LOAD_STAGE(0); ML_LOAD_Q(0);
    ML_WRITE_STAGE();
    for (int c = 0; c < 64; ++c) {
        __syncthreads();
        if (c + 1 < 64) ML_LOAD_STAGE(c + 1);
        const size_t t0 = tb + 128 * c;
        const int tl = 16 * wq + l15;
        const float mm_t = sMM[tl], b_t = sBB[tl], gi = __expf(m_st - mm_t);
        bf16x8 pf[4]; float den = 0.f;
#pragma unroll
        for (int a = 0; a < 4; ++a) {
            pf[a] = (bf16x8){0, 0, 0, 0, 0, 0, 0, 0};
            if (2 * a <= wq) {
                f32x4 S0 = (f32x4){0.f, 0.f, 0.f, 0.f}, S1 = (f32x4){0.f, 0.f, 0.f, 0.f};
                const unsigned char* kp = shm + ML_KL + (32 * a + 8 * (l15 >> 2) + (l15 & 3)) * 528 + 128 * qq;
                ml_chain2(kp, kp + 4 * 528, qf, S0, S1);
                const int key0 = 32 * a + 8 * qq;
                const f32x4 av0 = *(const f32x4*)(sA + key0), av1 = *(const f32x4*)(sA + key0 + 4);
                float pv[8];
#pragma unroll
                for (int i = 0; i < 4; ++i) { pv[i] = (key0 + i <= tl) ? S0[i] * __expf(av0[i] - mm_t) : 0.f; pv[4 + i] = (key0 + 4 + i <= tl) ? S1[i] * __expf(av1[i] - mm_t) : 0.f; den += pv[i] + pv[4 + i]; }
                pf[a] = __builtin_bit_cast(bf16x8, pack8(pv));
            }
        }
        den += __shfl_xor(den, 16); den += __shfl_xor(den, 32);
        f32x4 num[4];
        { const unsigned char* cp = shm + ML_CT + l15 * 528 + 128 * qq;
          f32x4 n0 = (f32x4){0.f, 0.f, 0.f, 0.f}, n1 = n0, n2 = n0, n3 = n0;
          ml_chain2(cp, cp + 16 * 528, qf, n0, n1); ml_chain2(cp + 32 * 528, cp + 48 * 528, qf, n2, n3);
          num[0] = n0 * gi; num[1] = n1 * gi; num[2] = n2 * gi; num[3] = n3 * gi; }
        float qn = 0.f;
#pragma unroll
        for (int ks = 0; ks < 8; ++ks) {
            float qv[8]; unpack8(__builtin_bit_cast(u32x4, qf[ks]), qv);
            const f32x4 n0 = *(const f32x4*)(sN + 64 * qq + 8 * ks), n1 = *(const f32x4*)(sN + 64 * qq + 8 * ks + 4);
            qn += (qv[0] * n0.x + qv[1] * n0.y) + (qv[2] * n0.z + qv[3] * n0.w) + (qv[4] * n1.x + qv[5] * n1.y) + (qv[6] * n1.z + qv[7] * n1.w);
        }
        qn += __shfl_xor(qn, 16); qn += __shfl_xor(qn, 32);
        den += gi * qn;
        ML_SB;
        if (c + 1 < 64) ML_LOAD_Q(c + 1);
        ML_SB;
#pragma unroll
        for (int a = 0; a < 4; ++a) {
            if (2 * a <= wq) {
                const unsigned char* vp = shm + ML_VT + l15 * 272 + (32 * a + 8 * qq) * 2;
                const bf16x8 v0 = *(const bf16x8*)(vp), v1 = *(const bf16x8*)(vp + 16 * 272), v2 = *(const bf16x8*)(vp + 32 * 272), v3 = *(const bf16x8*)(vp + 48 * 272);
                ML_SB;
                num[0] = ML_MFMA(v0, pf[a], num[0]); num[1] = ML_MFMA(v1, pf[a], num[1]); num[2] = ML_MFMA(v2, pf[a], num[2]); num[3] = ML_MFMA(v3, pf[a], num[3]);
            }
        }
        { const float dn = __builtin_amdgcn_rcpf(fmaxf(fabsf(den), __expf(-(b_t + mm_t))));
          bf16_t* hp = HM + (t0 + tl) * D + hA * 512 + 64 * sl + 4 * qq;
#pragma unroll
          for (int dvb = 0; dvb < 4; ++dvb) { u32x2 o; o.x = cvt_pk_bf16(num[dvb][0] * dn, num[dvb][1] * dn); o.y = cvt_pk_bf16(num[dvb][2] * dn, num[dvb][3] * dn); *(u32x2*)(hp + 16 * dvb) = o; } }
        const float b_last = sMisc[0], mm_last = sMisc[1], decay = __expf(m_st - mm_last);
#pragma unroll
        for (int dkb = 0; dkb < 2; ++dkb) { Nacc[dkb] = Nacc[dkb] * decay;
#pragma unroll
            for (int dvb = 0; dvb < 4; ++dvb) Cacc[dkb][dvb] = Cacc[dkb][dvb] * decay; }
#pragma unroll
        for (int a = 0; a < 4; ++a) {
            const f32x4 w0 = *(const f32x4*)(sWS + 32 * a + 8 * qq), w1 = *(const f32x4*)(sWS + 32 * a + 8 * qq + 4);
            const unsigned char* tp = shm + ML_KL + (32 * a + 8 * qq + (l15 >> 2)) * 528 + (32 * w + 4 * (l15 & 3)) * 2;
            const s16x4 t00 = __builtin_amdgcn_ds_read_tr16_b64_v4i16((PG8_LAS s16x4*)(tp)), t01 = __builtin_amdgcn_ds_read_tr16_b64_v4i16((PG8_LAS s16x4*)(tp + 4 * 528));
            const s16x4 t10 = __builtin_amdgcn_ds_read_tr16_b64_v4i16((PG8_LAS s16x4*)(tp + 32)), t11 = __builtin_amdgcn_ds_read_tr16_b64_v4i16((PG8_LAS s16x4*)(tp + 32 + 4 * 528));
            const unsigned char* vp = shm + ML_VT + l15 * 272 + (32 * a + 8 * qq) * 2;
            const u32x4 r0 = *(const u32x4*)(vp), r1 = *(const u32x4*)(vp + 16 * 272), r2 = *(const u32x4*)(vp + 32 * 272), r3 = *(const u32x4*)(vp + 48 * 272);
            ML_SB;
            bf16x8 kt0, kt1;
            kt0[0] = t00[0]; kt0[1] = t00[1]; kt0[2] = t00[2]; kt0[3] = t00[3]; kt0[4] = t01[0]; kt0[5] = t01[1]; kt0[6] = t01[2]; kt0[7] = t01[3];
            kt1[0] = t10[0]; kt1[1] = t10[1]; kt1[2] = t10[2]; kt1[3] = t10[3]; kt1[4] = t11[0]; kt1[5] = t11[1]; kt1[6] = t11[2]; kt1[7] = t11[3];
            float wsv[8] = {w0.x, w0.y, w0.z, w0.w, w1.x, w1.y, w1.z, w1.w};
            float zf[8];
#pragma unroll
            for (int e = 0; e < 8; ++e) zf[e] = (l15 == 0) ? wsv[e] : 0.f;
            const bf16x8 wsf = __builtin_bit_cast(bf16x8, pack8(zf));
            Nacc[0] = ML_MFMA(kt0, wsf, Nacc[0]); Nacc[1] = ML_MFMA(kt1, wsf, Nacc[1]);
            const u32x4 rr[4] = {r0, r1, r2, r3};
#pragma unroll
            for (int dvb = 0; dvb < 4; ++dvb) {
                float vv[8]; unpack8(rr[dvb], vv);
#pragma unroll
                for (int e = 0; e < 8; ++e) vv[e] *= wsv[e];
                const bf16x8 wv = __builtin_bit_cast(bf16x8, pack8(vv));
                Cacc[0][dvb] = ML_MFMA(kt0, wv, Cacc[0][dvb]); Cacc[1][dvb] = ML_MFMA(kt1, wv, Cacc[1][dvb]);
            }
        }
        m_st = b_last + mm_last;
        __syncthreads();
        if (c + 1 < 64) ML_WRITE_STAGE();
    }
#undef ML_LOAD_STAGE
#undef ML_LOAD_Q
#undef ML_WRITE_STAGE
}
#undef ML_SB
#undef ML_MFMA

constexpr int AT_V = 16384, AT_BUF = 32768;
__device__ __forceinline__ void attn_item(const Params& p, unsigned char* shm, int b, int h, int qb, float lam, float M2) {
    int tid_ = threadIdx.x; asm volatile("" : "+v"(tid_)); const int tid = tid_, lane = tid & 63, wave = __builtin_amdgcn_readfirstlane(tid >> 6), c = wave & 1, g = wave >> 1, r = lane & 31, hh = lane >> 5;
    const bf16_t* BQ = (const bf16_t*)(p.ws + WS_BQ); const bf16_t* BK = (const bf16_t*)(p.ws + WS_BK); const bf16_t* VTD = (const bf16_t*)(p.ws + WS_VTD); const bf16_t* GB = (const bf16_t*)(p.ws + WS_GB);
    bf16_t* YB = (bf16_t*)((unsigned char*)p.out + DO_YB);
    float* cmb = (float*)shm;
    const int tq = qb * 128 + 32 * g + r; const size_t rowq = (size_t)b * SEQ + tq;
    bf16x8 qf[8];
    { const bf16_t* qp = BQ + rowq * D + h * 256 + c * 128 + 64 * hh;
#pragma unroll
      for (int ks = 0; ks < 8; ++ks) qf[ks] = *(const bf16x8*)(qp + 8 * ks); }
    {
        float ss = 0.f;
#pragma unroll
        for (int ks = 0; ks < 8; ++ks) { float v[8]; unpack8(__builtin_bit_cast(u32x4, qf[ks]), v);
#pragma unroll
            for (int e = 0; e < 8; ++e) ss += v[e] * v[e]; }
        ss += __shfl_xor(ss, 32);
        const float rq = rsqrtf(ss * (1.f / 128.f) + EPS) * (0.08838834764831845f * LOG2E);
#pragma unroll
        for (int ks = 0; ks < 8; ++ks) { float v[8]; unpack8(__builtin_bit_cast(u32x4, qf[ks]), v);
            const f32x4 g0 = *(const f32x4*)(p.q_norm_g + 64 * hh + 8 * ks), g1 = *(const f32x4*)(p.q_norm_g + 64 * hh + 8 * ks + 4);
            v[0] *= rq * g0.x; v[1] *= rq * g0.y; v[2] *= rq * g0.z; v[3] *= rq * g0.w; v[4] *= rq * g1.x; v[5] *= rq * g1.y; v[6] *= rq * g1.z; v[7] *= rq * g1.w;
            qf[ks] = __builtin_bit_cast(bf16x8, pack8(v)); }
    }
    f32x16 O[8];
#pragma unroll
    for (int db = 0; db < 8; ++db)
#pragma unroll
        for (int i = 0; i < 16; ++i) O[db][i] = 0.f;
    float lsum = 0.f;
    const float slope2 = exp2f(-(float)(h + 1)) * LOG2E;
    const int ntile_w = qb * 4 + g + 1, ntile = qb * 4 + 4;
    int kt0 = (int)ceilf(((float)(qb * 128 - 31) - (150.f + 2.f * M2) / slope2) * (1.f / 32.f)); kt0 = kt0 < 0 ? 0 : kt0;
    const int keyperm = (r & 19) | ((r & 4) << 1) | ((r & 8) >> 1);
    const char* kgb = (const char*)(BK + ((size_t)b * SEQ) * D + h * 256);
    const char* vgb = (const char*)(VTD + ((size_t)(b * 8 + h) * 256) * 8192);
#define AT_ISSUE(kt_, dst_) do { const char* kb_ = kgb + (size_t)(32 * (kt_)) * (D * 2); const char* vb_ = vgb + (size_t)(kt_) * 16384; \
        int ln_ = lane; asm volatile("" : "+v"(ln_)); unsigned kgo[2], vgo[2];   \
        _Pragma("unroll") for (int j = 0; j < 2; ++j) { const int R = 8 * wave + 4 * j + (ln_ >> 4); kgo[j] = (unsigned)((R & 31) * D + (R >> 5) * 128 + 8 * ((ln_ & 15) ^ (R & 15))) * 2u; \
            const int dv = 32 * wave + 16 * j + (ln_ >> 2); vgo[j] = (unsigned)(dv * 32 + 8 * ((ln_ & 3) ^ ((dv >> 2) & 3))) * 2u; } \
        _Pragma("unroll") for (int j = 0; j < 2; ++j) __builtin_amdgcn_global_load_lds((const unsigned*)(kb_ + kgo[j]), (PG8_LAS unsigned*)((dst_) + (2 * wave + j) * 1024), 16, 0, 0); \
        _Pragma("unroll") for (int j = 0; j < 2; ++j) __builtin_amdgcn_global_load_lds((const unsigned*)(vb_ + vgo[j]), (PG8_LAS unsigned*)((dst_) + AT_V + (2 * wave + j) * 1024), 16, 0, 0); } while (0)
    const int krow = (c * 32 + keyperm) * 256, kx = keyperm & 15;
    const int vrow = AT_V + r * 64, vf_ = hh ^ ((r >> 2) & 3);
    __syncthreads();
    const int kt0e = kt0 & ~1, n64 = (ntile - kt0e) >> 1;
    AT_ISSUE(kt0e, shm); AT_ISSUE(kt0e + 1, shm + AT_BUF);
    asm volatile("s_waitcnt vmcnt(0)" ::: "memory");
    __builtin_amdgcn_s_barrier(); asm volatile("" ::: "memory");
    for (int it = 0; it < n64; ++it) {
      unsigned char* slot = shm + (it & 1) * (2 * AT_BUF);
      if (it + 1 < n64) { unsigned char* ns = shm + ((it & 1) ^ 1) * (2 * AT_BUF); AT_ISSUE(kt0e + 2 * it + 2, ns); AT_ISSUE(kt0e + 2 * it + 3, ns + AT_BUF); }
#pragma unroll
      for (int u = 0; u < 2; ++u) {
        const int kt = kt0e + 2 * it + u;
        const int s0 = 32 * kt;
        unsigned char* buf = slot + u * AT_BUF;
        if (kt < ntile_w) {
#define AT_KF(ks_) (*(const bf16x8*)(buf + krow + 16 * ((8 * hh + (ks_)) ^ kx)))
#define AT_VF(i_) (*(const bf16x8*)(buf + vrow + ((i_) & 7) * 2048 + 16 * ((2 * ((i_) >> 3)) ^ vf_)))
#define AT_SB __builtin_amdgcn_sched_barrier(0)
            const float base = slope2 * (float)(s0 + 8 * hh - tq) - M2;
            f32x16 S;
#pragma unroll
            for (int i = 0; i < 16; ++i) S[i] = fmaf(slope2, (float)((i & 3) + 4 * ((i >> 2) & 1) + 16 * (i >> 3)), base);
            bf16x8 f0 = AT_KF(0), f1 = AT_KF(1), f2 = AT_KF(2), f3 = AT_KF(3);
            AT_SB;
            S = __builtin_amdgcn_mfma_f32_32x32x16_bf16(f0, qf[0], S, 0, 0, 0); f0 = AT_KF(4); AT_SB;
            S = __builtin_amdgcn_mfma_f32_32x32x16_bf16(f1, qf[1], S, 0, 0, 0); f1 = AT_KF(5); AT_SB;
            S = __builtin_amdgcn_mfma_f32_32x32x16_bf16(f2, qf[2], S, 0, 0, 0); f2 = AT_KF(6); AT_SB;
            S = __builtin_amdgcn_mfma_f32_32x32x16_bf16(f3, qf[3], S, 0, 0, 0); f3 = AT_KF(7); AT_SB;
            S = __builtin_amdgcn_mfma_f32_32x32x16_bf16(f0, qf[4], S, 0, 0, 0); f0 = AT_VF(0); AT_SB;
            S = __builtin_amdgcn_mfma_f32_32x32x16_bf16(f1, qf[5], S, 0, 0, 0); f1 = AT_VF(1); AT_SB;
            S = __builtin_amdgcn_mfma_f32_32x32x16_bf16(f2, qf[6], S, 0, 0, 0); f2 = AT_VF(2); AT_SB;
            S = __builtin_amdgcn_mfma_f32_32x32x16_bf16(f3, qf[7], S, 0, 0, 0); f3 = AT_VF(3); AT_SB;
            float pv[16];
#pragma unroll
            for (int i = 0; i < 16; ++i) pv[i] = __builtin_amdgcn_exp2f(S[i]);
            if (kt == ntile_w - 1) {
#pragma unroll
                for (int i = 0; i < 16; ++i) { const int key = s0 + (i & 3) + 4 * ((i >> 2) & 1) + 8 * hh + 16 * (i >> 3); pv[i] = (key <= tq) ? pv[i] : 0.f; }
            }
#pragma unroll
            for (int i = 0; i < 16; ++i) lsum += pv[i];
            bf16x8 pf[2];
#pragma unroll
            for (int k2 = 0; k2 < 2; ++k2) { u32x4 u; u.x = cvt_pk_bf16(pv[8 * k2 + 0], pv[8 * k2 + 1]); u.y = cvt_pk_bf16(pv[8 * k2 + 2], pv[8 * k2 + 3]); u.z = cvt_pk_bf16(pv[8 * k2 + 4], pv[8 * k2 + 5]); u.w = cvt_pk_bf16(pv[8 * k2 + 6], pv[8 * k2 + 7]);
                pf[k2] = __builtin_bit_cast(bf16x8, u); }
            AT_SB;
#define AT_PV(i_, f_) do { O[(i_) & 7] = __builtin_amdgcn_mfma_f32_32x32x16_bf16(f_, pf[(i_) >> 3], O[(i_) & 7], 0, 0, 0); if ((i_) + 4 < 16) f_ = AT_VF((i_) + 4); AT_SB; } while (0)
            AT_PV(0, f0); AT_PV(1, f1); AT_PV(2, f2); AT_PV(3, f3); AT_PV(4, f0); AT_PV(5, f1); AT_PV(6, f2); AT_PV(7, f3);
            AT_PV(8, f0); AT_PV(9, f1); AT_PV(10, f2); AT_PV(11, f3); AT_PV(12, f0); AT_PV(13, f1); AT_PV(14, f2); AT_PV(15, f3);
#undef AT_PV
#undef AT_KF
#undef AT_VF
#undef AT_SB
        }
      }
      asm volatile("s_waitcnt vmcnt(0)" ::: "memory");
      asm volatile("s_waitcnt lgkmcnt(0)" ::: "memory");
      __builtin_amdgcn_s_barrier(); asm volatile("" ::: "memory");
    }
#undef AT_ISSUE
    const float ltot = lsum + __shfl_xor(lsum, 32);
    const float inv = 1.f / ltot;
    if (c == 1) {
#pragma unroll
        for (int db = 0; db < 8; ++db)
#pragma unroll
            for (int i = 0; i < 16; ++i) { const int dv = 32 * db + (i & 3) + 8 * (i >> 2) + 4 * hh; cmb[(g * 256 + dv) * 32 + r] = O[db][i] * inv; }
    }
    __syncthreads();
    if (c == 0) {
        float ss = 0.f;
#pragma unroll
        for (int db = 0; db < 8; ++db)
#pragma unroll
            for (int i = 0; i < 16; ++i) { const int dv = 32 * db + (i & 3) + 8 * (i >> 2) + 4 * hh; const float o = O[db][i] * inv - lam * cmb[(g * 256 + dv) * 32 + r]; O[db][i] = o; ss += o * o; }
        ss += __shfl_xor(ss, 32);
        const float rinv = rsqrtf(ss * (1.f / 256.f) + EPS) * 0.8f;
#pragma unroll
        for (int db = 0; db < 8; ++db)
#pragma unroll
            for (int ig = 0; ig < 4; ++ig) {
                const int dv0 = 32 * db + 8 * ig + 4 * hh; const size_t off = rowq * D + h * 256 + dv0;
                const u32x2 gbu = *(const u32x2*)(GB + off); const f32x4 sg = *(const f32x4*)(p.subln_g + dv0);
                u32x2 o; o.x = cvt_pk_bf16(O[db][4 * ig + 0] * rinv * sg.x * bflo(gbu.x), O[db][4 * ig + 1] * rinv * sg.y * bfhi(gbu.x));
                o.y = cvt_pk_bf16(O[db][4 * ig + 2] * rinv * sg.z * bflo(gbu.y), O[db][4 * ig + 3] * rinv * sg.w * bfhi(gbu.y));
                *(u32x2*)(YB + off) = o;
            }
    }
}

__device__ __forceinline__ void phase2b(const Params& p, unsigned char* shm, int rep) {
    int tid_ = threadIdx.x; asm volatile("" : "+v"(tid_)); const int tid = tid_, lane = tid & 63;
    if (blockIdx.x < 128) { const int xcd = blockIdx.x & 7, idx = blockIdx.x >> 3; mlstm_item(p, shm, (xcd * 2 + (idx >> 3)) * 8 + (idx & 7)); }
    float lam, M2;
    { const float a0 = p.diff_lambda[lane] * p.diff_lambda[128 + lane] + p.diff_lambda[64 + lane] * p.diff_lambda[192 + lane];
      const float a1 = p.diff_lambda[256 + lane] * p.diff_lambda[384 + lane] + p.diff_lambda[320 + lane] * p.diff_lambda[448 + lane];
      lam = expf(wave_sum(a0)) - expf(wave_sum(a1)) + 0.2f;
      float mq = fmaxf(fabsf(p.q_norm_g[lane]), fabsf(p.q_norm_g[64 + lane])), mk = fmaxf(fabsf(p.k_norm_g[lane]), fabsf(p.k_norm_g[64 + lane]));
#pragma unroll
      for (int o = 1; o < 64; o <<= 1) { mq = fmaxf(mq, __shfl_xor(mq, o)); mk = fmaxf(mk, __shfl_xor(mk, o)); }
      M2 = 128.f * mq * mk * 0.08838834764831845f * LOG2E * 1.02f;
      lam = __uint_as_float(__builtin_amdgcn_readfirstlane(__float_as_uint(lam))); M2 = __uint_as_float(__builtin_amdgcn_readfirstlane(__float_as_uint(M2))); }
    unsigned* ctr = (unsigned*)(p.ws + WS_CTL) + 128 * rep;
    int* sItem = (int*)(shm + 147456 - 64);
    const int myx = blockIdx.x & 7;
    for (;;) {
        __syncthreads();
        if (tid == 0) { int it = -1;
            for (int k = 0; k < 8; ++k) { const int q = (myx + k) & 7; const unsigned v = atomicAdd(ctr + 16 * q, 1u); if (v < 256u) { it = q * 256 + (int)v; break; } }
            *sItem = it; }
        __syncthreads();
        const int item = *sItem;
        if (item < 0) break;
        const int q = item >> 8, v = item & 255, b = v >> 6, qb = 63 - (v & 63);
        const int h = (b == 0) ? q : (b == 1) ? 7 - q : (b == 2) ? ((q + 4) & 7) : ((3 - q) & 7);
        attn_item(p, shm, b, h, qb, lam, M2);
    }
}

__device__ __forceinline__ void phase3(const Params& p, unsigned char* shm) {
    int tid_ = threadIdx.x; asm volatile("" : "+v"(tid_)); const int tid = tid_, lane = tid & 63, wave = tid >> 6, gw = blockIdx.x * 8 + wave, ngw = gridDim.x * 8;
    float* scr = (float*)(shm + wave * 8448);
    transpose_plain(p.w_out, D, D, (bf16_t*)(p.ws + WS_WOUT), scr, gw, ngw, lane);
    { const int nblk = 2 * DFF / 32, nitems = (D / 64) * nblk; bf16_t* WuT = (bf16_t*)(p.ws + WS_WUP);
      for (int it = gw; it < nitems; it += ngw) { const int kb = it / nblk, nb = it % nblk, n = 32 * nb, pt = n >> 8, j = n & 255;
          transpose_item(p.w_up, (size_t)(2 * DFF), D, WuT, 64 * kb, j < 128 ? 128 * pt + j : DFF + 128 * pt + (j - 128), n, scr, lane); } }
    transpose_plain(p.w_down, DFF, D, (bf16_t*)(p.ws + WS_WDN), scr, gw, ngw, lane);
    const bf16_t* HM = (const bf16_t*)(p.ws + WS_HM); const bf16_t* GA = (const bf16_t*)(p.ws + WS_GA); bf16_t* Y = (bf16_t*)(p.ws + WS_BQ); const bf16_t* YBp = (const bf16_t*)((const unsigned char*)p.out + DO_YB);
    const f32x4 mg0 = *(const f32x4*)(p.mlstm_norm_g + (gw & 3) * 512 + 8 * lane), mg1 = *(const f32x4*)(p.mlstm_norm_g + (gw & 3) * 512 + 8 * lane + 4);
    for (int it = gw; it < T * 4; it += ngw) {
        const size_t off = (size_t)(it >> 2) * D + (it & 3) * 512 + 8 * lane;
        float hm[8], ga[8], yb[8]; unpack8(*(const u32x4*)(HM + off), hm); unpack8(*(const u32x4*)(GA + off), ga); unpack8(*(const u32x4*)(YBp + off), yb);
        float ss = 0.f;
#pragma unroll
        for (int e = 0; e < 8; ++e) ss += hm[e] * hm[e];
        const float rinv = rsqrtf(wave_sum(ss) * (1.f / 512.f) + EPS);
        const bool same = (ngw & 3) == 0;
        const f32x4 g0 = same ? mg0 : *(const f32x4*)(p.mlstm_norm_g + (it & 3) * 512 + 8 * lane), g1 = same ? mg1 : *(const f32x4*)(p.mlstm_norm_g + (it & 3) * 512 + 8 * lane + 4);
        float y[8];
        y[0] = ga[0] * hm[0] * rinv * g0.x + yb[0]; y[1] = ga[1] * hm[1] * rinv * g0.y + yb[1]; y[2] = ga[2] * hm[2] * rinv * g0.z + yb[2]; y[3] = ga[3] * hm[3] * rinv * g0.w + yb[3];
        y[4] = ga[4] * hm[4] * rinv * g1.x + yb[4]; y[5] = ga[5] * hm[5] * rinv * g1.y + yb[5]; y[6] = ga[6] * hm[6] * rinv * g1.z + yb[6]; y[7] = ga[7] * hm[7] * rinv * g1.w + yb[7];
        *(u32x4*)(Y + off) = pack8(y);
    }
}
__device__ __forceinline__ void phase5(const Params& p) {
    int tid_ = threadIdx.x; asm volatile("" : "+v"(tid_)); const int tid = tid_, lane = tid & 63, wave = tid >> 6, gw = blockIdx.x * 8 + wave, ngw = gridDim.x * 8;
    bf16_t* H2 = (bf16_t*)(p.ws + WS_H2);
    f32x4 g2r[8];
#pragma unroll
    for (int j = 0; j < 8; ++j) g2r[j] = *((const f32x4*)p.norm2_g + lane + 64 * j);
    for (int row = gw; row < T; row += ngw) {
        const f32x4* xr = (const f32x4*)(p.out + (size_t)row * D) + lane;
        f32x4 v[8]; float ss = 0.f;
#pragma unroll
        for (int j = 0; j < 8; ++j) { v[j] = xr[64 * j]; ss += (v[j].x * v[j].x + v[j].y * v[j].y) + (v[j].z * v[j].z + v[j].w * v[j].w); }
        const float rinv = rsqrtf(wave_sum(ss) * (1.f / D) + EPS);
        u32x2* o8 = (u32x2*)(H2 + (size_t)row * D) + lane;
#pragma unroll
        for (int j = 0; j < 8; ++j) { const f32x4 g = g2r[j];
            u32x2 o; o.x = cvt_pk_bf16(v[j].x * rinv * g.x, v[j].y * rinv * g.y); o.y = cvt_pk_bf16(v[j].z * rinv * g.z, v[j].w * rinv * g.w); o8[64 * j] = o; }
    }
}
__device__ __forceinline__ float dpp_ror1(float v) { return __int_as_float(__builtin_amdgcn_update_dpp(0, __float_as_int(v), 0x121, 0xf, 0xf, false)); }
__device__ __forceinline__ float dpp_ror2(float v) { return __int_as_float(__builtin_amdgcn_update_dpp(0, __float_as_int(v), 0x122, 0xf, 0xf, false)); }
struct EpiUp {
    static constexpr bool PERM = true, AFTER_DRAIN = false;
    bf16_t* act; bf16_t* sb; const float* cw; const float* cb;
    __device__ __forceinline__ void operator()(const f32x4 (&acc)[2][2][4][2], const pg8::Unit& u, int wr, int wc, int fr_in, int fq_in) const {
        int fr = fr_in, fq = fq_in; asm volatile("" : "+v"(fr), "+v"(fq));
        const int row0 = u.pm * 256 + wr * 64 + fr;
#pragma unroll
        for (int n = 0; n < 2; ++n) {
            const int cl = u.pn * 128 + wc * 32 + 8 * fq + 4 * n;
            const f32x4 wg0 = *(const f32x4*)(cw + cl), wg1 = *(const f32x4*)(cw + (size_t)2 * DFF + cl), wg2 = *(const f32x4*)(cw + (size_t)4 * DFF + cl);
            const f32x4 wv0 = *(const f32x4*)(cw + DFF + cl), wv1 = *(const f32x4*)(cw + (size_t)3 * DFF + cl), wv2 = *(const f32x4*)(cw + (size_t)5 * DFF + cl);
            const f32x4 bg = *(const f32x4*)(cb + cl), bv = *(const f32x4*)(cb + DFF + cl);
#pragma unroll
            for (int ai = 0; ai < 2; ++ai) {
#pragma unroll
                for (int m = 0; m < 4; ++m) {
                    const int row = row0 + ai * 128 + m * 16;
                    const f32x4 g = acc[ai][0][m][n], v = acc[ai][1][m][n];
                    const f32x4 gp = acc[ai][0][m > 0 ? m - 1 : 0][n], vp = acc[ai][1][m > 0 ? m - 1 : 0][n];
                    if ((m == 0 && fr < 2) || (m == 3 && fr >= 14)) {
                        const int slot = (m == 0) ? fr : fr - 12;
                        bf16_t* d = sb + ((size_t)(row >> 6) * 4 + slot) * (2 * DFF) + cl;
                        u32x2 og, ov; og.x = cvt_pk_bf16(g[0], g[1]); og.y = cvt_pk_bf16(g[2], g[3]); ov.x = cvt_pk_bf16(v[0], v[1]); ov.y = cvt_pk_bf16(v[2], v[3]);
                        *(u32x2*)d = og; *(u32x2*)(d + DFF) = ov;
                    }
                    f32x4 y;
#pragma unroll
                    for (int e = 0; e < 4; ++e) {
                        const float xg1 = dpp_ror1(fr == 15 ? gp[e] : g[e]), xg2 = dpp_ror2(fr >= 14 ? gp[e] : g[e]);
                        const float xv1 = dpp_ror1(fr == 15 ? vp[e] : v[e]), xv2 = dpp_ror2(fr >= 14 ? vp[e] : v[e]);
                        const float ug = bg[e] + wg0[e] * xg2 + wg1[e] * xg1 + wg2[e] * g[e];
                        const float uv = bv[e] + wv0[e] * xv2 + wv1[e] * xv1 + wv2[e] * v[e];
                        y[e] = ug * fsig(ug) * uv;
                    }
                    if (!(m == 0 && fr < 2)) { u32x2 o; o.x = cvt_pk_bf16(y[0], y[1]); o.y = cvt_pk_bf16(y[2], y[3]); *(u32x2*)(act + (size_t)row * DFF + cl) = o; }
                }
            }
        }
    }
};
__device__ __forceinline__ void phase_fix(const Params& p) {
    const bf16_t* SB = (const bf16_t*)(p.ws + WS_SB); bf16_t* ACT = (bf16_t*)(p.ws + WS_ACT);
    int tid_ = threadIdx.x; asm volatile("" : "+v"(tid_)); const int gt = blockIdx.x * 512 + tid_, ngt = gridDim.x * 512;
    for (int idx = gt; idx < (T / 64) * 704; idx += ngt) {
        const int oct = idx % 704, kb = idx / 704, c0 = 8 * oct, r0 = 64 * kb;
        float wg[3][8], wv[3][8], bg[8], bv[8];
#pragma unroll
        for (int j = 0; j < 3; ++j) {
            const f32x4 a = *(const f32x4*)(p.ffn_conv_w + (size_t)j * 2 * DFF + c0), b = *(const f32x4*)(p.ffn_conv_w + (size_t)j * 2 * DFF + c0 + 4);
            const f32x4 c = *(const f32x4*)(p.ffn_conv_w + (size_t)j * 2 * DFF + DFF + c0), d = *(const f32x4*)(p.ffn_conv_w + (size_t)j * 2 * DFF + DFF + c0 + 4);
            wg[j][0] = a.x; wg[j][1] = a.y; wg[j][2] = a.z; wg[j][3] = a.w; wg[j][4] = b.x; wg[j][5] = b.y; wg[j][6] = b.z; wg[j][7] = b.w;
            wv[j][0] = c.x; wv[j][1] = c.y; wv[j][2] = c.z; wv[j][3] = c.w; wv[j][4] = d.x; wv[j][5] = d.y; wv[j][6] = d.z; wv[j][7] = d.w;
        }
        { const f32x4 a = *(const f32x4*)(p.ffn_conv_b + c0), b = *(const f32x4*)(p.ffn_conv_b + c0 + 4), c = *(const f32x4*)(p.ffn_conv_b + DFF + c0), d = *(const f32x4*)(p.ffn_conv_b + DFF + c0 + 4);
          bg[0] = a.x; bg[1] = a.y; bg[2] = a.z; bg[3] = a.w; bg[4] = b.x; bg[5] = b.y; bg[6] = b.z; bg[7] = b.w; bv[0] = c.x; bv[1] = c.y; bv[2] = c.z; bv[3] = c.w; bv[4] = d.x; bv[5] = d.y; bv[6] = d.z; bv[7] = d.w; }
        float g2[8], g1[8], v2[8], v1[8];
        if ((r0 & (SEQ - 1)) != 0) {
            const bf16_t* pr = SB + ((size_t)(kb - 1) * 4 + 2) * (2 * DFF) + c0;
            unpack8(*(const u32x4*)pr, g2); unpack8(*(const u32x4*)(pr + DFF), v2); unpack8(*(const u32x4*)(pr + 2 * DFF), g1); unpack8(*(const u32x4*)(pr + 2 * DFF + DFF), v1);
        } else {
#pragma unroll
            for (int e = 0; e < 8; ++e) { g2[e] = 0.f; g1[e] = 0.f; v2[e] = 0.f; v1[e] = 0.f; }
        }
#pragma unroll
        for (int rr = 0; rr < 2; ++rr) {
            float g0[8], v0[8], y[8];
            const bf16_t* cr = SB + ((size_t)kb * 4 + rr) * (2 * DFF) + c0;
            unpack8(*(const u32x4*)cr, g0); unpack8(*(const u32x4*)(cr + DFF), v0);
#pragma unroll
            for (int e = 0; e < 8; ++e) {
                const float ug = bg[e] + wg[0][e] * g2[e] + wg[1][e] * g1[e] + wg[2][e] * g0[e];
                const float uv = bv[e] + wv[0][e] * v2[e] + wv[1][e] * v1[e] + wv[2][e] * v0[e];
                y[e] = ug * fsig(ug) * uv; g2[e] = g1[e]; g1[e] = g0[e]; v2[e] = v1[e]; v1[e] = v0[e];
            }
            *(u32x4*)(ACT + (size_t)(r0 + rr) * DFF + c0) = pack8(y);
        }
    }
}

#ifndef REP1
#define REP1 1
#endif
#ifndef REP3
#define REP3 1
#endif
__global__ void __launch_bounds__(512, 2) mega(Params p) {
    extern __shared__ __attribute__((aligned(16))) unsigned char shm[];
    cg::grid_group grid = cg::this_grid();
    bf16_t* H = (bf16_t*)((unsigned char*)p.out + DO_H); bf16_t* WinT = (bf16_t*)((unsigned char*)p.out + DO_WIN);
    bf16_t* H2 = (bf16_t*)(p.ws + WS_H2); bf16_t* ACTb = (bf16_t*)(p.ws + WS_ACT);
    const bf16_t* WoT = (const bf16_t*)(p.ws + WS_WOUT); const bf16_t* WuT = (const bf16_t*)(p.ws + WS_WUP); const bf16_t* WdT = (const bf16_t*)(p.ws + WS_WDN);
#define PH(i) (p.ph_lo <= (i) && (i) < p.ph_hi)
#define SYNC(i) do { if (p.ph_lo <= (i) && (i) + 1 < p.ph_hi) grid.sync(); } while (0)
    if (PH(0)) phase0(p, shm);
    SYNC(0);
    for (int rep = 0; rep < REP1; ++rep) { if (rep) grid.sync();
    if (PH(1)) { Epi1 E{(bf16_t*)(p.ws + WS_AQK), (bf16_t*)(p.ws + WS_VTM), (bf16_t*)(p.ws + WS_GA), (bf16_t*)(p.ws + WS_BQ), (bf16_t*)(p.ws + WS_BK), (bf16_t*)(p.ws + WS_VTD), (bf16_t*)(p.ws + WS_GB)};
        run_gemm_rot(shm, H, WinT, T, 16384, D, E); } }
    SYNC(1);
    if (PH(2)) phase2a(p, shm);
    SYNC(2);
    for (int rep = 0; rep < REP3; ++rep) { if (rep) grid.sync(); if (PH(3)) phase2b(p, shm, rep); }
    SYNC(3);
    if (PH(4)) phase3(p, shm);
    SYNC(4);
    if (PH(5)) { EpiRes E{p.out, p.x, D}; run_gemm(shm, (const bf16_t*)(p.ws + WS_BQ), WoT, T, D, D, E); }
    SYNC(5);
    if (PH(6)) phase5(p);
    SYNC(6);
    if (PH(7)) { EpiUp E{ACTb, (bf16_t*)(p.ws + WS_SB), p.ffn_conv_w, p.ffn_conv_b}; run_gemm(shm, H2, WuT, T, 2 * DFF, D, E); }
    SYNC(7);
    if (PH(8)) phase_fix(p);
    SYNC(8);
    if (PH(9)) { EpiRes E{p.out, p.out, D}; run_gemm(shm, ACTb, WdT, T, D, DFF, E); }
#undef PH
#undef SYNC
}

#ifndef N_LAUNCHES
#define N_LAUNCHES 1
#endif
extern "C" void kernel_launch(void* const* d_in, const int* in_sizes, int n_in, void* d_out, int out_size, void* d_ws, size_t ws_size, hipStream_t stream) {
    static int grid = 0;
    if (grid == 0) {
        if (n_in != 17 || out_size != T * D || ws_size < WS_END) { fprintf(stderr, "kernel_launch: unexpected problem (n_in %d, out %d, ws %zu)\n", n_in, out_size, ws_size); grid = -1; return; }
        int dev = 0, cus = 0, per_cu = 0;
        if (hipGetDevice(&dev) != hipSuccess || hipDeviceGetAttribute(&cus, hipDeviceAttributeMultiprocessorCount, dev) != hipSuccess) { grid = -1; return; }
        if (hipFuncSetAttribute((const void*)mega, hipFuncAttributeMaxDynamicSharedMemorySize, LDS_BYTES) != hipSuccess) { fprintf(stderr, "kernel_launch: hipFuncSetAttribute failed\n"); grid = -1; return; }
        if (hipOccupancyMaxActiveBlocksPerMultiprocessor(&per_cu, (const void*)mega, 512, LDS_BYTES) != hipSuccess || per_cu < 1) { fprintf(stderr, "kernel_launch: occupancy query says %d\n", per_cu); per_cu = 1; }
        (void)hipGetLastError();
        grid = cus * per_cu;
    }
    if (grid < 0) return;
    if (hipMemsetAsync((char*)d_ws + WS_CTL, 0, 4096, stream) != hipSuccess) { fprintf(stderr, "kernel_launch: memset failed\n"); return; }
    Params p{};
    const float** pp = (const float**)&p;
    for (int i = 0; i < 17; ++i) pp[i] = (const float*)d_in[i];
    p.out = (float*)d_out; p.ws = (unsigned char*)d_ws;
    constexpr int NPH = 10;
    for (int li = 0; li < N_LAUNCHES; ++li) {
        p.ph_lo = (N_LAUNCHES == 1) ? 0 : li; p.ph_hi = (N_LAUNCHES == 1) ? NPH : li + 1;
        void* args[] = {&p};
        hipError_t e = hipLaunchCooperativeKernel((const void*)mega, dim3(grid), dim3(512), args, LDS_BYTES, stream);
        if (e != hipSuccess) { fprintf(stderr, "cooperative launch failed: %s (grid %d)\n", hipGetErrorString(e), grid); break; }
    }
}
```
